# Optimizing an MI355X kernel written in HIP

```python
import jax, jax.numpy as jnp
from jax import lax
import numpy as np

D_MODEL = 1024
BATCH = 32
SEQ = 256
DEPTH = 2
DEC_BATCH = 8
DEC_SEQ = 4096
PAST_LEN = 512

GRID_W = 64
HEAD_DIM = 64
N_RWKV = 4
N_NA = 6
N_MLA = 6
D_RWKV = N_RWKV * HEAD_DIM
D_NA = N_NA * HEAD_DIM
MLA_NOPE = 64
MLA_ROPE = 32
MLA_V = 64
D_MLA = N_MLA * MLA_V
D_MIX = D_RWKV + D_NA + D_MLA
MLA_Q_RANK = 256
MLA_KV_RANK = 128
LORA_W = 64
LORA_A = 64
NA_ROWS = 8
NA_COLS = 16
Q_BLOCK = 128
ROPE_BASE = 10000.0
EPS = 1e-6
GN_EPS = 64e-5
NEG_INF = -1e30
MLA_SCALE = (MLA_NOPE + MLA_ROPE) ** -0.5
PROJ_SPLITS = (D_RWKV, D_RWKV, D_RWKV, LORA_W, LORA_A, D_RWKV,
               D_NA, D_NA, D_NA, D_NA,
               MLA_Q_RANK, MLA_KV_RANK, MLA_ROPE, D_MLA)
D_PROJ = sum(PROJ_SPLITS)
SPLIT_POINTS = tuple(int(s) for s in np.cumsum(PROJ_SPLITS)[:-1])

kernel_name = 'hybrid_rwkv7_natten_mla_diffusion_step'


def rms_norm(x, g, eps=EPS):
    xf = x.astype(jnp.float32)
    y = xf * lax.rsqrt(jnp.mean(xf * xf, -1, keepdims=True) + eps)
    return (y * g).astype(x.dtype)


def heads(x, h):
    return x.reshape(x.shape[:-1] + (h, -1))


def centred_conv(x, w):
    xp = jnp.pad(x, ((0, 0), (1, 1), (0, 0)))
    return xp[:, :-2] * w[0] + xp[:, 1:-1] * w[1] + xp[:, 2:] * w[2]


def axial_rope(x):
    T = x.shape[1]
    t = jnp.arange(T)
    n_freq = MLA_ROPE // 4
    inv = jnp.power(ROPE_BASE, -jnp.arange(n_freq, dtype=jnp.float32) / n_freq)
    ang = jnp.concatenate([(t // GRID_W).astype(jnp.float32)[:, None] * inv,
                           (t % GRID_W).astype(jnp.float32)[:, None] * inv], -1)
    cos = jnp.cos(ang)[None, :, None, :]
    sin = jnp.sin(ang)[None, :, None, :]
    x1 = x[..., :MLA_ROPE // 2].astype(jnp.float32)
    x2 = x[..., MLA_ROPE // 2:].astype(jnp.float32)
    return jnp.concatenate([x1 * cos - x2 * sin, x2 * cos + x1 * sin], -1).astype(x.dtype)


def blocked_attention(q, k, v, scale):
    B, T, H, dk = q.shape
    nb = T // Q_BLOCK
    qb = q.reshape(B, nb, Q_BLOCK, H, dk).transpose(1, 0, 2, 3, 4)

    def one(qi):
        s = jnp.einsum('bqhd,bkhd->bhqk', qi, k).astype(jnp.float32) * scale
        p = jax.nn.softmax(s, -1).astype(v.dtype)
        return jnp.einsum('bhqk,bkhd->bqhd', p, v)

    o = lax.map(one, qb)
    return o.transpose(1, 0, 2, 3, 4).reshape(B, T, H, v.shape[-1])


def neighbourhood_attention(q, k, v, k_ctx, v_ctx, rpb):
    B, T, H, dh = q.shape
    rows = T // GRID_W
    kr = min(NA_ROWS, rows)
    qc = np.arange(GRID_W)
    cs = np.clip(qc - NA_COLS // 2, 0, GRID_W - NA_COLS)
    col_mask = (qc[None, :] >= cs[:, None]) & (qc[None, :] < cs[:, None] + NA_COLS)
    dc_idx = np.clip(qc[None, :] - qc[:, None], -(NA_COLS - 1), NA_COLS - 1) + NA_COLS - 1
    rpb_c = rpb[:, :, dc_idx]
    scale = dh ** -0.5
    k_g = k.reshape(B, rows, GRID_W, H, dh)
    v_g = v.reshape(B, rows, GRID_W, H, dh)
    q_rows = q.reshape(B, rows, GRID_W, H, dh).transpose(1, 0, 2, 3, 4)

    def row_block(args):
        r, q_r = args
        rs = jnp.clip(r - kr // 2, 0, rows - kr)
        k_b = lax.dynamic_slice_in_dim(k_g, rs, kr, axis=1)
        v_b = lax.dynamic_slice_in_dim(v_g, rs, kr, axis=1)
        dr_idx = rs + jnp.arange(kr) - r + NA_ROWS - 1
        bias = jnp.take(rpb_c, dr_idx, axis=1).transpose(0, 2, 1, 3)
        s_loc = jnp.einsum('bqhd,bjkhd->bhqjk', q_r, k_b).astype(jnp.float32) * scale + bias.astype(jnp.float32)
        s_loc = jnp.where(col_mask[:, None, :], s_loc, NEG_INF).reshape(B, H, GRID_W, kr * GRID_W)
        s_ctx = jnp.einsum('bqhd,bchd->bhqc', q_r, k_ctx).astype(jnp.float32) * scale
        p = jax.nn.softmax(jnp.concatenate([s_loc, s_ctx], -1), -1).astype(v.dtype)
        p_loc = p[..., :kr * GRID_W].reshape(B, H, GRID_W, kr, GRID_W)
        return (jnp.einsum('bhqjk,bjkhd->bqhd', p_loc, v_b)
                + jnp.einsum('bhqc,bchd->bqhd', p[..., kr * GRID_W:], v_ctx))

    o = lax.map(row_block, (jnp.arange(rows), q_rows))
    return o.transpose(1, 0, 2, 3, 4).reshape(B, T, H * dh)


def both_dirs(x):
    return jnp.stack([x, jnp.flip(x, 1)], 2)


def per_dir(x):
    return jnp.stack([x[:, :, 0], jnp.flip(x[:, :, 1], 1)], 2)


def rwkv_step(S, inp):
    r, w, k, v, kk, a = inp
    sa = jnp.einsum('bdhvk,bdhk->bdhv', S, -kk)
    S = S * w[..., None, :] + sa[..., :, None] * (kk * a)[..., None, :] + v[..., :, None] * k[..., None, :]
    return S, jnp.einsum('bdhvk,bdhk->bdhv', S, r)


def rwkv_mixer(r, k, v, wd, ad, g, s0, l, P):
    B, T, C = r.shape
    f32 = jnp.float32
    w_log = -jax.nn.softplus(-(P['rwkv_w0'][l] + jnp.einsum('btl,dlc->btdc', jnp.tanh(wd), P['rwkv_w_up'][l]))) - 0.5
    decay = jnp.exp(-jnp.exp(w_log.astype(f32)))
    a = jax.nn.sigmoid(P['rwkv_a0'][l] + jnp.einsum('btl,dlc->btdc', ad, P['rwkv_a_up'][l]))
    kk = heads((k * P['rwkv_k_k'][l]).astype(f32), N_RWKV)
    kk = kk / jnp.maximum(jnp.sqrt(jnp.sum(kk * kk, -1, keepdims=True)), 1e-12)
    k_d = k[:, :, None, :] * (1 + (a - 1) * P['rwkv_k_a'][l])
    hd = lambda z: z.reshape(B, T, 2, N_RWKV, HEAD_DIM)
    r_h, v_h = heads(r, N_RWKV), heads(v, N_RWKV)
    k_dh, a_h, w_h = hd(k_d), hd(a), hd(decay)
    seq = tuple(jnp.moveaxis(z.astype(f32), 1, 0) for z in
                (both_dirs(r_h), per_dir(w_h), per_dir(k_dh), both_dirs(v_h), both_dirs(kk), per_dir(a_h)))
    s_fin, ys = lax.scan(rwkv_step, s0.astype(f32), seq)
    ys = jnp.moveaxis(ys, 0, 1)
    o = ys[:, :, 0] + jnp.flip(ys[:, :, 1], 1)
    mu = jnp.mean(o, -1, keepdims=True)
    var = jnp.mean(jnp.square(o - mu), -1, keepdims=True)
    o = ((o - mu) * lax.rsqrt(var + GN_EPS)).reshape(B, T, C) * P['rwkv_ln_w'][l] + P['rwkv_ln_b'][l]
    coef = jnp.sum(jnp.sum(r_h[:, :, None] * k_dh * P['rwkv_r_k'][l], -1, keepdims=True), 2)
    o = o + (coef * v_h).reshape(B, T, C)
    return o.astype(r.dtype) * jax.nn.silu(g), s_fin


def mla_q(cq, l, P, rope):
    q = heads(rms_norm(cq, P['mla_cq_norm'][l]) @ P['mla_w_uq'][l], N_MLA)
    q = rms_norm(q, P['mla_q_norm'][l])
    if rope:
        q = jnp.concatenate([q[..., :MLA_NOPE], axial_rope(q[..., MLA_NOPE:])], -1)
    return q


def mla_kv(ckv_n, krope, l, P, rope):
    B, T, _ = ckv_n.shape
    k_nope = heads(ckv_n @ P['mla_w_uk'][l], N_MLA)
    k_r = jnp.broadcast_to(krope[:, :, None, :], (B, T, N_MLA, MLA_ROPE))
    k = rms_norm(jnp.concatenate([k_nope, k_r], -1), P['mla_k_norm'][l])
    if rope:
        k = jnp.concatenate([k[..., :MLA_NOPE], axial_rope(k[..., MLA_NOPE:])], -1)
    v = heads(ckv_n @ P['mla_w_uv'][l], N_MLA)
    return k, v


def split_proj(x, cond, l, P):
    mod = jax.nn.silu(cond) @ P['w_mod'][l] + P['b_mod'][l]
    shift, scale, gate = jnp.split(mod, 3, -1)
    h = rms_norm(x, P['norm_w'][l]) * (1 + scale) + shift
    return jnp.split(h @ P['w_in'][l], SPLIT_POINTS, -1), gate


def context_layer(x, c_ctx, l, P):
    B, L, _ = x.shape
    (r, k, v, wd, ad, g_r, q_n, k_n, v_n, g_n, cq, ckv, krope, g_m), gate = split_proj(x, c_ctx, l, P)
    r, k, v = jnp.split(centred_conv(jnp.concatenate([r, k, v], -1), P['rwkv_conv'][l]), 3, -1)
    s0 = jnp.zeros((B, 2, N_RWKV, HEAD_DIM, HEAD_DIM), jnp.float32)
    o_r, s_fin = rwkv_mixer(r, k, v, wd, ad, g_r, s0, l, P)
    qn = rms_norm(heads(q_n, N_NA), P['na_q_norm'][l])
    kn = rms_norm(heads(k_n, N_NA), P['na_k_norm'][l])
    vn = heads(v_n, N_NA)
    o_n = blocked_attention(qn, kn, vn, HEAD_DIM ** -0.5).reshape(B, L, D_NA) * jax.nn.silu(g_n)
    ckv_n = rms_norm(ckv, P['mla_ckv_norm'][l])
    qm = mla_q(cq, l, P, False)
    km, vm = mla_kv(ckv_n, krope, l, P, False)
    o_m = blocked_attention(qm, km, vm, MLA_SCALE).reshape(B, L, D_MLA) * jax.nn.silu(g_m)
    y = x + gate * (jnp.concatenate([o_r, o_n, o_m], -1) @ P['w_out'][l])
    return y, (s_fin, kn, vn, ckv_n, krope)


def latent_layer(x, c, s0, k_ctx, v_ctx, ckv_ctx, krope_ctx, l, P):
    B, T, _ = x.shape
    (r, k, v, wd, ad, g_r, q_n, k_n, v_n, g_n, cq, ckv, krope, g_m), gate = split_proj(x, c[:, None, :], l, P)
    r, k, v = jnp.split(centred_conv(jnp.concatenate([r, k, v], -1), P['rwkv_conv'][l]), 3, -1)
    o_r, _ = rwkv_mixer(r, k, v, wd, ad, g_r, s0, l, P)
    qn = rms_norm(heads(q_n, N_NA), P['na_q_norm'][l])
    kn = rms_norm(heads(k_n, N_NA), P['na_k_norm'][l])
    vn = heads(v_n, N_NA)
    o_n = neighbourhood_attention(qn, kn, vn, k_ctx, v_ctx, P['na_rpb'][l]) * jax.nn.silu(g_n)
    ckv_n = rms_norm(ckv, P['mla_ckv_norm'][l])
    qm = mla_q(cq, l, P, True)
    km, vm = mla_kv(ckv_n, krope, l, P, True)
    kc, vc = mla_kv(ckv_ctx, krope_ctx, l, P, False)
    o_m = blocked_attention(qm, jnp.concatenate([kc, km], 1), jnp.concatenate([vc, vm], 1), MLA_SCALE)
    o_m = o_m.reshape(B, T, D_MLA) * jax.nn.silu(g_m)
    return x + gate * (jnp.concatenate([o_r, o_n, o_m], -1) @ P['w_out'][l])


def setup_inputs(seed: int = 0) -> dict:
    key = jax.random.key(seed)
    ks = iter(jax.random.split(key, 48))
    nrm = lambda shape, s=1.0: s * jax.random.normal(next(ks), shape, jnp.float32)
    inp = {}
    inp['x_prompt'] = nrm((BATCH, SEQ, D_MODEL))
    inp['x_sample'] = nrm((DEC_BATCH, DEC_SEQ, D_MODEL))
    inp['state_rwkv'] = nrm((DEC_BATCH, DEPTH, 2, N_RWKV, HEAD_DIM, HEAD_DIM), 0.5)
    inp['cache_na_k'] = nrm((DEC_BATCH, DEPTH, PAST_LEN, N_NA, HEAD_DIM))
    inp['cache_na_v'] = nrm((DEC_BATCH, DEPTH, PAST_LEN, N_NA, HEAD_DIM))
    inp['cache_mla_ckv'] = nrm((DEC_BATCH, DEPTH, PAST_LEN, MLA_KV_RANK))
    inp['cache_mla_krope'] = nrm((DEC_BATCH, DEPTH, PAST_LEN, MLA_ROPE))
    inp['c'] = nrm((DEC_BATCH, D_MODEL))
    inp['c_ctx'] = nrm((D_MODEL,))
    inp['w_mod'] = nrm((DEPTH, D_MODEL, 3 * D_MODEL), 0.5 * D_MODEL ** -0.5)
    inp['b_mod'] = nrm((DEPTH, 3 * D_MODEL), 0.02)
    inp['norm_w'] = 1.0 + nrm((DEPTH, D_MODEL), 0.02)
    inp['w_in'] = nrm((DEPTH, D_MODEL, D_PROJ), D_MODEL ** -0.5)
    inp['w_out'] = nrm((DEPTH, D_MIX, D_MODEL), D_MIX ** -0.5)
    inp['rwkv_conv'] = jnp.array([0.25, 1.0, 0.25], jnp.float32)[None, :, None] + nrm((DEPTH, 3, 3 * D_RWKV), 0.05)
    inp['rwkv_w0'] = -0.5 + nrm((DEPTH, 2, D_RWKV), 0.5)
    inp['rwkv_w_up'] = nrm((DEPTH, 2, LORA_W, D_RWKV), 0.5 * LORA_W ** -0.5)
    inp['rwkv_a0'] = nrm((DEPTH, 2, D_RWKV), 0.5)
    inp['rwkv_a_up'] = nrm((DEPTH, 2, LORA_A, D_RWKV), 0.5 * LORA_A ** -0.5)
    inp['rwkv_k_k'] = 0.85 + nrm((DEPTH, D_RWKV), 0.05)
    inp['rwkv_k_a'] = 1.0 + nrm((DEPTH, D_RWKV), 0.05)
    inp['rwkv_r_k'] = nrm((DEPTH, N_RWKV, HEAD_DIM), 0.1)
    inp['rwkv_ln_w'] = 1.0 + nrm((DEPTH, D_RWKV), 0.02)
    inp['rwkv_ln_b'] = nrm((DEPTH, D_RWKV), 0.02)
    inp['na_q_norm'] = 1.0 + nrm((DEPTH, HEAD_DIM), 0.02)
    inp['na_k_norm'] = 1.0 + nrm((DEPTH, HEAD_DIM), 0.02)
    inp['na_rpb'] = nrm((DEPTH, N_NA, 2 * NA_ROWS - 1, 2 * NA_COLS - 1), 0.5)
    inp['mla_cq_norm'] = 1.0 + nrm((DEPTH, MLA_Q_RANK), 0.02)
    inp['mla_ckv_norm'] = 1.0 + nrm((DEPTH, MLA_KV_RANK), 0.02)
    inp['mla_w_uq'] = nrm((DEPTH, MLA_Q_RANK, N_MLA * (MLA_NOPE + MLA_ROPE)), MLA_Q_RANK ** -0.5)
    inp['mla_w_uk'] = nrm((DEPTH, MLA_KV_RANK, N_MLA * MLA_NOPE), MLA_KV_RANK ** -0.5)
    inp['mla_w_uv'] = nrm((DEPTH, MLA_KV_RANK, N_MLA * MLA_V), MLA_KV_RANK ** -0.5)
    inp['mla_q_norm'] = 1.0 + nrm((DEPTH, MLA_NOPE + MLA_ROPE), 0.02)
    inp['mla_k_norm'] = 1.0 + nrm((DEPTH, MLA_NOPE + MLA_ROPE), 0.02)
    return inp


def reference(x_prompt, x_sample, state_rwkv, cache_na_k, cache_na_v, cache_mla_ckv, cache_mla_krope,
              c, c_ctx, w_mod, b_mod, norm_w, w_in, w_out, rwkv_conv, rwkv_w0, rwkv_w_up, rwkv_a0,
              rwkv_a_up, rwkv_k_k, rwkv_k_a, rwkv_r_k, rwkv_ln_w, rwkv_ln_b, na_q_norm, na_k_norm, na_rpb,
              mla_cq_norm, mla_ckv_norm, mla_w_uq, mla_w_uk, mla_w_uv, mla_q_norm, mla_k_norm):
    P = dict(w_mod=w_mod, b_mod=b_mod, norm_w=norm_w, w_in=w_in, w_out=w_out, rwkv_conv=rwkv_conv,
             rwkv_w0=rwkv_w0, rwkv_w_up=rwkv_w_up, rwkv_a0=rwkv_a0, rwkv_a_up=rwkv_a_up,
             rwkv_k_k=rwkv_k_k, rwkv_k_a=rwkv_k_a, rwkv_r_k=rwkv_r_k, rwkv_ln_w=rwkv_ln_w,
             rwkv_ln_b=rwkv_ln_b, na_q_norm=na_q_norm, na_k_norm=na_k_norm, na_rpb=na_rpb,
             mla_cq_norm=mla_cq_norm, mla_ckv_norm=mla_ckv_norm, mla_w_uq=mla_w_uq,
             mla_w_uk=mla_w_uk, mla_w_uv=mla_w_uv, mla_q_norm=mla_q_norm, mla_k_norm=mla_k_norm)
    xp = x_prompt
    st = []
    for l in range(DEPTH):
        xp, s_l = context_layer(xp, c_ctx, l, P)
        st.append(s_l)
    new_state_rwkv = jnp.stack([s[0] for s in st], 1).astype(x_prompt.dtype)
    new_cache_na_k = jnp.stack([s[1] for s in st], 1)
    new_cache_na_v = jnp.stack([s[2] for s in st], 1)
    new_cache_mla_ckv = jnp.stack([s[3] for s in st], 1)
    new_cache_mla_krope = jnp.stack([s[4] for s in st], 1)
    xs = x_sample
    for l in range(DEPTH):
        xs = latent_layer(xs, c, state_rwkv[:, l], cache_na_k[:, l], cache_na_v[:, l],
                          cache_mla_ckv[:, l], cache_mla_krope[:, l], l, P)
    return (xp, xs, new_state_rwkv, new_cache_na_k, new_cache_na_v, new_cache_mla_ckv, new_cache_mla_krope)
```

```cpp
#include <hip/hip_runtime.h>
#include <cstdio>
#include <cstdint>

#ifndef PROBE_DUP
#define PROBE_DUP 0
#endif
#ifndef MK_ONE_LAUNCH
#define MK_ONE_LAUNCH 1
#endif

#define GAS __attribute__((address_space(1)))
#define LAS __attribute__((address_space(3)))
typedef unsigned short bf16;
typedef short bf16x8 __attribute__((ext_vector_type(8)));
typedef short s16x4 __attribute__((ext_vector_type(4)));
typedef float f32x2 __attribute__((ext_vector_type(2)));
typedef float f32x4 __attribute__((ext_vector_type(4)));
typedef float f32x16 __attribute__((ext_vector_type(16)));
typedef unsigned u32x2 __attribute__((ext_vector_type(2)));
typedef unsigned u32x4 __attribute__((ext_vector_type(4)));
typedef __bf16 bf16x2_t __attribute__((ext_vector_type(2)));

constexpr int DM = 1024;
constexpr int NTC = 8192, NTL = 32768, NTOK = 40960;
constexpr int TC = 256, TL = 4096;
constexpr int NPROJ = 3584;
constexpr int LDA = 3072, LDB = 512;
constexpr int CA_GR = 0, CA_GN = 256, CA_GM = 640, CA_R = 1024, CA_K = 1280, CA_V = 1536, CA_QN = 1792, CA_KN = 2176, CA_VN = 2560, CA_WD = 2944, CA_AD = 3008;
constexpr int CB_CQ = 0, CB_CKV = 256, CB_KR = 384;
constexpr float LOG2E = 1.4426950408889634f;
constexpr float EPS = 1e-6f, GN_EPS = 64e-5f;
constexpr float MLA_SCALE = 0.10206207261596575f;
constexpr int SCAN_L = 256;
constexpr int NCHUNK_L = TL / SCAN_L;

constexpr size_t MiB = 1u << 20;
constexpr size_t WS_CTL = 0, CTL_ZERO_BYTES = 1 * MiB;
constexpr size_t WS_MOD = 1 * MiB;
constexpr size_t WS_S1T = WS_MOD + 256 * 1024;
constexpr size_t WS_C1 = WS_MOD + 320 * 1024;
constexpr size_t WS_WIN = 2 * MiB;
constexpr size_t WS_WOUT = 16 * MiB;
constexpr size_t WS_WUQ = 20 * MiB;
constexpr size_t WS_WUKV = 21 * MiB;
constexpr size_t WS_LORA = 21 * MiB + 512 * 1024;
constexpr size_t WS_NACK = 22 * MiB, WS_NACV = 28 * MiB;
constexpr size_t WS_CK = 34 * MiB, WS_CV = 39 * MiB;
constexpr size_t WS_CC = 42 * MiB;
constexpr size_t WS_Q = 44 * MiB;
constexpr size_t WS_Y = 90 * MiB;
constexpr size_t WS_PART = WS_Y;
constexpr size_t WS_H = 130 * MiB;
constexpr size_t WS_MK = WS_H, WS_MV = WS_H + 45 * MiB;
constexpr size_t WS_PB = 210 * MiB;
constexpr size_t WS_SCAN = WS_PB;
constexpr size_t WS_PA = 250 * MiB;
constexpr size_t WS_S1 = WS_PB + 28 * MiB;
constexpr size_t WS_YPB = WS_PB + 29 * MiB;
constexpr size_t WS_YPA = 490 * MiB;
constexpr size_t WS_END = 512 * MiB;

constexpr size_t OUT_Y = 0, OUT_STATE = 41943040, OUT_NAK = 44040192, OUT_NAV = 50331648, OUT_CKV = 56623104, OUT_KROPE = 58720256;

struct Args { const float* in[34]; float* out; unsigned char* ws; int ph_lo, ph_hi; };
typedef const __attribute__((address_space(4))) Args CArgs;

__device__ __forceinline__ float bf2f(unsigned short b) { return __uint_as_float(((unsigned)b) << 16); }
__device__ __forceinline__ unsigned pk2(float lo, float hi) { f32x2 v = {lo, hi}; bf16x2_t b = __builtin_convertvector(v, bf16x2_t); return __builtin_bit_cast(unsigned, b); }
__device__ __forceinline__ float lo_f(unsigned u) { return __uint_as_float(u << 16); }
__device__ __forceinline__ float hi_f(unsigned u) { return __uint_as_float(u & 0xffff0000u); }
__device__ __forceinline__ int crow(int r, int hi) { return (r & 3) + 8 * (r >> 2) + 4 * hi; }
__device__ __forceinline__ float rcp_f(float x) { return __builtin_amdgcn_rcpf(x); }
__device__ __forceinline__ float silu_f(float x) { return x * rcp_f(1.f + __expf(-x)); }
__device__ __forceinline__ float sigmoid_f(float x) { return rcp_f(1.f + __expf(-x)); }
template <int CTRL> __device__ __forceinline__ float dpp_f(float x) { return __int_as_float(__builtin_amdgcn_update_dpp(0, __float_as_int(x), CTRL, 0xf, 0xf, true)); }
__device__ __forceinline__ float row16_sum(float x) { x += dpp_f<0xB1>(x); x += dpp_f<0x4E>(x); x += dpp_f<0x141>(x); x += dpp_f<0x140>(x); return x; }
__device__ __forceinline__ float xor32_sum(float x) { const auto r = __builtin_amdgcn_permlane32_swap(__float_as_uint(x), __float_as_uint(x), false, false); return __uint_as_float(r[0]) + __uint_as_float(r[1]); }
__device__ __forceinline__ float xor32_max(float x) { const auto r = __builtin_amdgcn_permlane32_swap(__float_as_uint(x), __float_as_uint(x), false, false); return fmaxf(__uint_as_float(r[0]), __uint_as_float(r[1])); }
__device__ __forceinline__ float wave64_sum(float x) { x = row16_sum(x); const auto r = __builtin_amdgcn_permlane16_swap(__float_as_uint(x), __float_as_uint(x), false, false); x = __uint_as_float(r[0]) + __uint_as_float(r[1]); return xor32_sum(x); }
__device__ __forceinline__ float ss8(bf16x8 v) { float s = 0.f;
#pragma unroll
    for (int j = 0; j < 8; ++j) { const float f = bf2f((unsigned short)v[j]); s += f * f; } return s; }
#define LDS_WAIT() asm volatile("s_waitcnt lgkmcnt(0)" ::: "memory")
#define VM_WAIT() asm volatile("s_waitcnt vmcnt(0)" ::: "memory")

__device__ __forceinline__ const float* x_row0(CArgs& a, int tok) { return tok < NTC ? a.in[0] + (size_t)tok * DM : a.in[1] + (size_t)(tok - NTC) * DM; }
__device__ __forceinline__ int mod_idx(int tok) { return tok < NTC ? 0 : 1 + ((tok - NTC) >> 12); }

namespace pg8 {
#define PG8_LAS __attribute__((address_space(3)))
typedef unsigned short bf16_t;
typedef short bf16x8 __attribute__((ext_vector_type(8)));
typedef float f32x4 __attribute__((ext_vector_type(4)));
typedef unsigned u32x4 __attribute__((ext_vector_type(4)));
constexpr int BM = 256, BK = 64, HALF = 128, HTB = HALF * BK * 2  , STAGE_BYTES = 8 * HTB, NXCD = 8, WGM = 8;

__host__ __device__ __forceinline__ int lds_byte(int r, int c) { const int st = (r >> 4) * 2 + (c >> 5), rr = r & 15, cc = c & 31, ob = rr * 64 + cc * 2; return st * 1024 + (ob ^ (((ob >> 9) & 1) << 5)); }
__host__ __device__ __forceinline__ void stage_rc(int b, int& R, int& C) { const int st = b / 1024, sb = b % 1024, swz = sb ^ (((sb >> 9) & 1) << 5); R = (st >> 1) * 16 + swz / 64; C = (st & 1) * 32 + (swz % 64) / 2; }
__host__ __device__ __forceinline__ int perm32(int rho) { const int n = rho >> 4, i = rho & 15; return 8 * (i >> 2) + 4 * n + (i & 3); }

struct Unit { int pm, pn, bh; };
struct Gemm { const bf16_t* A; const bf16_t* Bt; int M, N, K, lda; };

struct StaticOrder {
    int nM, nN, nwg, G, c;
    __host__ __device__ void init(int M, int N, int G_, int c_) { nM = M / BM; nN = N / BM; nwg = nM * nN; G = G_; c = c_; }
    __host__ __device__ __forceinline__ bool next(int i, Unit& u) const {
        u.bh = 0;
        const long L = (long)i * G + c; if (L >= nwg) return false;
        int wgid = (int)L; { const int q = nwg / NXCD, r = nwg % NXCD, xcd = wgid % NXCD, off = wgid / NXCD; wgid = (xcd < r ? xcd * (q + 1) : r * (q + 1) + (xcd - r) * q) + off; }
        const int nig = WGM * nN, gid = wgid / nig, fm = gid * WGM, gsz = (nM - fm) < WGM ? (nM - fm) : WGM;
        u.pm = fm + ((wgid % nig) % gsz); u.pn = (wgid % nig) / gsz; return true;
    }
    __device__ __forceinline__ void a_ready(const Unit&) const {}
    __device__ __forceinline__ void done(const Unit&) const {}
};

struct HalfOrder {
    int c;
    __host__ __device__ __forceinline__ bool next(int i, Unit& u) const {
        if (i > 2) return false;
        if (i == 2) { const int x = c % NXCD, j = c / NXCD; u.pm = 128 + 4 * x + (j & 3); u.pn = (j >> 2) & 3; u.bh = 1 + (j >> 4); return true; }
        const int L = i * 256 + c; const int wgid = (L % NXCD) * 64 + L / NXCD;
        u.pm = (wgid / 32) * WGM + (wgid % 32) % WGM; u.pn = (wgid % 32) / WGM; u.bh = 0; return true;
    }
    __device__ __forceinline__ void a_ready(const Unit&) const {}
    __device__ __forceinline__ void done(const Unit&) const {}
};
__device__ __forceinline__ unsigned cvt_pk_bf16(float lo, float hi) { unsigned r; asm volatile("v_cvt_pk_bf16_f32 %0, %1, %2" : "=v"(r) : "v"(lo), "v"(hi)); return r; }
struct EpiOut {
    static constexpr bool PERM = false, AFTER_DRAIN = false, PREFETCH = false;
    const float* x0; const float* x1; float* out; const float* mod;
#if PROBE_DUP == 26
    int live;
#endif
    __device__ __forceinline__ void operator()(const f32x4 (&acc)[2][2][4][2], const Unit& u, int wr, int wc, int fr, int fq) const {
#if PROBE_DUP == 26
        if (!live) return;
#endif
        const int rowt = u.pm * BM;
        const int mi = rowt < 8192 ? 0 : 1 + ((rowt - 8192) >> 12);
        const float* gate = mod + mi * 3072 + 2048;
        const int col0 = u.pn * BM + (u.bh == 2 ? HALF : 0) + wc * 32 + 4 * fq;
        const int nbj = u.bh ? 1 : 2;
        f32x4 gv[2][2];
#pragma unroll
        for (int bj = 0; bj < 2; ++bj)
#pragma unroll
            for (int n = 0; n < 2; ++n) gv[bj][n] = *(const f32x4*)(gate + col0 + bj * HALF + n * 16);
#pragma unroll
        for (int ai = 0; ai < 2; ++ai)
#pragma unroll
            for (int m = 0; m < 4; ++m) { const int row = rowt + ai * HALF + wr * 64 + m * 16 + fr;
                const float* xr = row < 8192 ? x0 + (size_t)row * 1024 : x1 + (size_t)(row - 8192) * 1024;
                float* orow = out + (size_t)row * 1024;
#pragma unroll
                for (int bj = 0; bj < 2; ++bj) { if (bj < nbj) {
#pragma unroll
                    for (int n = 0; n < 2; ++n) { const int c = col0 + bj * HALF + n * 16; const f32x4 xv = *(const f32x4*)(xr + c);
                        *(f32x4*)(orow + c) = xv + gv[bj][n] * acc[ai][bj][m][n]; } } } }
    }
};


__device__ __forceinline__ float fq_sum(float x) { const auto r = __builtin_amdgcn_permlane16_swap(__float_as_uint(x), __float_as_uint(x), false, false); x = __uint_as_float(r[0]) + __uint_as_float(r[1]);
    const auto q = __builtin_amdgcn_permlane32_swap(__float_as_uint(x), __float_as_uint(x), false, false); return __uint_as_float(q[0]) + __uint_as_float(q[1]); }
struct EpiOut0 {
    static constexpr bool PERM = true, AFTER_DRAIN = false;
    const float* x0; const float* x1; float* out; const float* mod;
    const float* s1; bf16_t* H; float* part;
    __device__ __forceinline__ void operator()(const f32x4 (&acc)[2][2][4][2], const Unit& u, int wr, int wc, int fr, int fq) const {
        const int rowt = u.pm * BM;
        const int mi = rowt < 8192 ? 0 : 1 + ((rowt - 8192) >> 12);
        const int colb = u.pn * BM + (u.bh == 2 ? HALF : 0) + wc * 32 + 8 * fq;
        const int nbj = u.bh ? 1 : 2;
        const float* gate = mod + mi * 3072 + 2048 + colb; const float* sv = s1 + mi * 1024 + colb;
        f32x4 gv[2][2];
#pragma unroll
        for (int bj = 0; bj < 2; ++bj) { if (bj < nbj) {
#pragma unroll
            for (int n = 0; n < 2; ++n) gv[bj][n] = *(const f32x4*)(gate + bj * HALF + 4 * n); } }
        const int slot = u.pn * 8 + (u.bh == 2 ? 4 : 0) + wc;
        float* pslot = part + (size_t)slot * 40960;
#pragma unroll
        for (int ai = 0; ai < 2; ++ai)
#pragma unroll
            for (int m = 0; m < 4; ++m) { const int row = rowt + ai * HALF + wr * 64 + m * 16 + fr;
                const float* xr = (row < 8192 ? x0 + (size_t)row * 1024 : x1 + (size_t)(row - 8192) * 1024) + colb;
                float* orow = out + (size_t)row * 1024 + colb; bf16_t* hrow = H + (size_t)row * 1024 + colb;
                float s = 0.f;
#pragma unroll
                for (int bj = 0; bj < 2; ++bj) { if (bj < nbj) {
                    const f32x4 y0 = *(const f32x4*)(xr + bj * HALF) + gv[bj][0] * acc[ai][bj][m][0], y1 = *(const f32x4*)(xr + bj * HALF + 4) + gv[bj][1] * acc[ai][bj][m][1];
                    *(f32x4*)(orow + bj * HALF) = y0; *(f32x4*)(orow + bj * HALF + 4) = y1;
                    s += ((y0[0] * y0[0] + y0[1] * y0[1]) + (y0[2] * y0[2] + y0[3] * y0[3])) + ((y1[0] * y1[0] + y1[1] * y1[1]) + (y1[2] * y1[2] + y1[3] * y1[3]));
                    const f32x4 a0 = y0 * *(const f32x4*)(sv + bj * HALF), a1 = y1 * *(const f32x4*)(sv + bj * HALF + 4);
                    u32x4 w; w.x = cvt_pk_bf16(a0[0], a0[1]); w.y = cvt_pk_bf16(a0[2], a0[3]); w.z = cvt_pk_bf16(a1[0], a1[1]); w.w = cvt_pk_bf16(a1[2], a1[3]);
                    *(u32x4*)(hrow + bj * HALF) = w; } }
                const float t = fq_sum(s);
                if (fq == 0) { pslot[row] = t; if (u.bh == 0) pslot[4 * 40960 + row] = 0.f; } }
    }
};
template <bool L1>
struct EpiProjT {
    static constexpr bool PERM = true, AFTER_DRAIN = false;
    CArgs* ap; PG8_LAS const float* T; int l;
    __device__ __forceinline__ void operator()(const f32x4 (&acc)[2][2][4][2], const Unit& u, int wr, int wc, int fr, int fq) const {
        CArgs* ap_ = ap; asm volatile("" : "+s"(ap_)); CArgs& a = *ap_;
        bf16_t* PA = (bf16_t*)(a.ws + WS_PA); bf16_t* PB = (bf16_t*)(a.ws + WS_PB); const float* c1 = (const float*)(a.ws + WS_C1);
        const float* qw = a.in[24] + l * 64; const float* kw = a.in[25] + l * 64; float* nak = a.out + OUT_NAK; float* nav = a.out + OUT_NAV;
        const int rowt = u.pm * BM; const int row0 = rowt + wr * 64 + fr;
        const int col0 = wc * 32 + 8 * fq;
        f32x4 cv[2][2]; const PG8_LAS float* rs = T;
        if constexpr (L1) {
            const int mi = rowt < 8192 ? 0 : 1 + ((rowt - 8192) >> 12);
            const PG8_LAS int* Tp = (const PG8_LAS int*)T;
            const int j = (u.pm == Tp[1]) ? 1 : ((u.pm == Tp[2]) ? 2 : ((u.pm == Tp[3]) ? 3 : 0));
            rs = T + 64 + 256 * j + wr * 64 + fr;
            const float* cp = c1 + mi * 3584 + u.pn * 256 + col0;
#pragma unroll
            for (int bj = 0; bj < 2; ++bj)
#pragma unroll
                for (int n = 0; n < 2; ++n) cv[bj][n] = *(const f32x4*)(cp + bj * HALF + 4 * n);
        }
        const bool ctx = rowt < 8192;
        if (u.pn >= 7 && u.pn <= 9) {
            const int hq = 4 * (u.pn - 7) + wc; const bool isq = hq < 6;
            const float* gwp = (isq ? qw : kw) + 8 * fq; const float sc0 = isq ? 0.125f * 1.4426950408889634f : 1.0f;
            f32x4 gv[2][2];
#pragma unroll
            for (int bj = 0; bj < 2; ++bj)
#pragma unroll
                for (int n = 0; n < 2; ++n) gv[bj][n] = *(const f32x4*)(gwp + 32 * bj + 4 * n) * sc0;
            const int ncol = 1792 + 64 * hq + 8 * fq;
#pragma unroll
            for (int ai = 0; ai < 2; ++ai)
#pragma unroll
                for (int m = 0; m < 4; ++m) { const int row = row0 + ai * HALF + m * 16;
                    f32x4 v[2][2]; float ss = 0.f;
#pragma unroll
                    for (int bj = 0; bj < 2; ++bj)
#pragma unroll
                        for (int n = 0; n < 2; ++n) { f32x4 x = acc[ai][bj][m][n]; if constexpr (L1) x = x * rs[ai * HALF + m * 16] + cv[bj][n];
                            v[bj][n] = x; ss += (x[0] * x[0] + x[1] * x[1]) + (x[2] * x[2] + x[3] * x[3]); }
                    ss = fq_sum(ss);
                    const float r = __builtin_amdgcn_rsqf(ss * (1.f / 64.f) + 1e-6f);
                    bf16_t* rowp = PA + (size_t)row * 3072 + ncol;
                    float* kc = nak + ((size_t)((row >> 8) * 2 + l) * 256 + (row & 255)) * 384 + (hq - 6) * 64 + 8 * fq;
#pragma unroll
                    for (int bj = 0; bj < 2; ++bj) { const f32x4 o0 = v[bj][0] * r * gv[bj][0], o1 = v[bj][1] * r * gv[bj][1];
                        u32x4 w; w.x = cvt_pk_bf16(o0[0], o0[1]); w.y = cvt_pk_bf16(o0[2], o0[3]); w.z = cvt_pk_bf16(o1[0], o1[1]); w.w = cvt_pk_bf16(o1[2], o1[3]);
                        *(u32x4*)(rowp + 32 * bj) = w;
                        if (ctx && !isq) { *(f32x4*)(kc + 32 * bj) = o0; *(f32x4*)(kc + 32 * bj + 4) = o1; } } }
            return;
        }
        bf16_t* base; int ldc;
        if (u.pn < 12) { base = PA + u.pn * 256; ldc = 3072; } else { base = PB + (u.pn - 12) * 256; ldc = 512; }
        const bool vtile = ctx && (u.pn == 10 || u.pn == 11);
        const bool wdt = u.pn == 11 && wc < 2;
#pragma unroll
        for (int ai = 0; ai < 2; ++ai)
#pragma unroll
            for (int m = 0; m < 4; ++m) { const int row = row0 + ai * HALF + m * 16; bf16_t* rowp = base + (size_t)row * ldc + col0;
                float* vc = nav + ((size_t)((row >> 8) * 2 + l) * 256 + (row & 255)) * 384 + (u.pn - 10) * 256 + col0;
#pragma unroll
                for (int bj = 0; bj < 2; ++bj) { f32x4 v0 = acc[ai][bj][m][0], v1 = acc[ai][bj][m][1];
                    if constexpr (L1) { const float r = rs[ai * HALF + m * 16]; v0 = v0 * r + cv[bj][0]; v1 = v1 * r + cv[bj][1]; }
                    if (wdt && bj == 1) {
#pragma unroll
                        for (int i = 0; i < 4; ++i) { v0[i] = 1.f - 2.f * __builtin_amdgcn_rcpf(1.f + __expf(2.f * v0[i])); v1[i] = 1.f - 2.f * __builtin_amdgcn_rcpf(1.f + __expf(2.f * v1[i])); } }
                    u32x4 w; w.x = cvt_pk_bf16(v0[0], v0[1]); w.y = cvt_pk_bf16(v0[2], v0[3]); w.z = cvt_pk_bf16(v1[0], v1[1]); w.w = cvt_pk_bf16(v1[2], v1[3]);
                    *(u32x4*)(rowp + bj * HALF) = w;
                    if (vtile && (u.pn == 10 || bj == 0)) { *(f32x4*)(vc + bj * HALF) = v0; *(f32x4*)(vc + bj * HALF + 4) = v1; } } }
    }
};
template <class Epi, class Sched, bool ALIGN_EPI = false, bool SP2 = false>
__device__ __forceinline__ void gemm_phase(PG8_LAS unsigned char* lds, const Gemm g, const Sched& S, const Epi& E) {
    int tid_ = threadIdx.x; asm volatile("" : "+v"(tid_));
    const int tid = tid_, wid = __builtin_amdgcn_readfirstlane(tid >> 6), lane = tid & 63, wr = wid >> 2, wc = wid & 3, fr = lane & 15, fq = lane >> 4;
    const int K = g.K, nt = K / BK;
    unsigned voffA[2], voffB[2];
#pragma unroll
    for (int i = 0; i < 2; ++i) { int R, C; stage_rc(tid * 16 + i * 8192, R, C); const int Rb = Epi::PERM ? ((R & ~31) + perm32(R & 31)) : R;
        voffA[i] = (unsigned)(R * g.lda + C) * 2u; voffB[i] = (unsigned)(Rb * K + C) * 2u; }
    const size_t kstep = (size_t)(BK * 2);
    const size_t hstepA = (size_t)HALF * g.lda * 2, hstepB = (size_t)HALF * K * 2;
    const size_t tstepA = 2 * hstepA, tstepB = 2 * hstepB;
    const unsigned ldsw = (unsigned)wid * 1024u;
    const int aoff = lds_byte(wr * 64 + fr, fq * 8), boff = lds_byte(wc * 32 + fr, fq * 8);
#define PG8_SA(b, h) (((b) * 2 + (h)) * HTB)
#define PG8_SB(b, h) ((4 + (b) * 2 + (h)) * HTB)
#define PG8_STAGE(bufoff, gbase, voff) do { _Pragma("unroll") for (int _i = 0; _i < 2; ++_i) \
        __builtin_amdgcn_global_load_lds((const unsigned*)((const char*)(gbase) + (voff)[_i]), (PG8_LAS unsigned*)(lds + (bufoff) + ldsw + _i * 8192), 16, 0, 0); } while (0)
#define PG8_LDA(dst, b, h) do { _Pragma("unroll") for (int m = 0; m < 4; ++m) _Pragma("unroll") for (int k = 0; k < 2; ++k) dst[m][k] = *(const PG8_LAS bf16x8*)(lds + PG8_SA(b, h) + aoff + m * 2048 + k * 1024); } while (0)
#define PG8_LDB(dst, b, h) do { _Pragma("unroll") for (int n = 0; n < 2; ++n) _Pragma("unroll") for (int k = 0; k < 2; ++k) dst[n][k] = *(const PG8_LAS bf16x8*)(lds + PG8_SB(b, h) + boff + n * 2048 + k * 1024); } while (0)
#define PG8_MMA(ai, bj, At, Bt) do { __builtin_amdgcn_s_setprio(1); _Pragma("unroll") for (int m = 0; m < 4; ++m) _Pragma("unroll") for (int n = 0; n < 2; ++n) _Pragma("unroll") for (int k = 0; k < 2; ++k) \
        acc[ai][bj][m][n] = __builtin_amdgcn_mfma_f32_16x16x32_bf16(Bt[n][k], At[m][k], acc[ai][bj][m][n], 0, 0, 0); __builtin_amdgcn_s_setprio(0); } while (0)
#define PG8_WAIT_V(n) asm volatile("s_waitcnt vmcnt(" #n ")" ::: "memory")
#define PG8_WAIT_L(n) asm volatile("s_waitcnt lgkmcnt(" #n ")" ::: "memory")
#define PG8_BAR __builtin_amdgcn_s_barrier()
#define PG8_SCHED __builtin_amdgcn_sched_barrier(0)
    Unit cur, nxt; int ui = 0;
    if (!S.next(0, cur)) return;
    f32x4 acc[2][2][4][2];
#pragma unroll
    for (int a = 0; a < 2; ++a)
#pragma unroll
        for (int b = 0; b < 2; ++b)
#pragma unroll
            for (int m = 0; m < 4; ++m)
#pragma unroll
                for (int n = 0; n < 2; ++n) acc[a][b][m][n] = (f32x4){0.f, 0.f, 0.f, 0.f};
    bf16x8 At[4][2], B0[2][2], B1[2][2];
    const char* cA = (const char*)g.A + (size_t)cur.pm * tstepA; const char* cB = (const char*)g.Bt + (size_t)cur.pn * tstepB + (cur.bh == 2 ? hstepB : (size_t)0);
    S.a_ready(cur);
    if constexpr (SP2) {
        PG8_STAGE(PG8_SB(0, 0), cB, voffB); PG8_STAGE(PG8_SB(0, 1), cB + hstepB, voffB); PG8_STAGE(PG8_SA(0, 0), cA, voffA); PG8_STAGE(PG8_SA(0, 1), cA + hstepA, voffA);
        if (wr == 1) PG8_BAR;
        PG8_WAIT_V(2); PG8_BAR;
        PG8_STAGE(PG8_SB(1, 0), cB + kstep, voffB); PG8_STAGE(PG8_SA(1, 0), cA + kstep, voffA); PG8_STAGE(PG8_SB(1, 1), cB + hstepB + kstep, voffB);
        PG8_WAIT_V(6); PG8_BAR;
    } else {
        PG8_STAGE(PG8_SB(0, 0), cB, voffB); PG8_STAGE(PG8_SA(0, 0), cA, voffA); PG8_STAGE(PG8_SB(0, 1), cB + hstepB, voffB); PG8_STAGE(PG8_SA(0, 1), cA + hstepA, voffA);
        if (wr == 1) PG8_BAR;
        PG8_WAIT_V(4); PG8_BAR;
        PG8_STAGE(PG8_SB(1, 0), cB + kstep, voffB); PG8_STAGE(PG8_SA(1, 0), cA + kstep, voffA); PG8_STAGE(PG8_SB(1, 1), cB + hstepB + kstep, voffB);
        PG8_WAIT_V(6); PG8_BAR;
    }
    for (;;) {
        const bool has_next = S.next(ui + 1, nxt);
        const char* nA = has_next ? (const char*)g.A + (size_t)nxt.pm * tstepA : cA; const char* nB = has_next ? (const char*)g.Bt + (size_t)nxt.pn * tstepB + (nxt.bh == 2 ? hstepB : (size_t)0) : cB;
        const bool full = cur.bh == 0;
        for (int t = 0; t < nt; t += 2) {
            const bool last = (t == nt - 2);
            const char* a1 = cA + (size_t)(t + 1) * kstep;
            const char* a2 = last ? nA : cA + (size_t)(t + 2) * kstep; const char* b2 = last ? nB : cB + (size_t)(t + 2) * kstep;
            const char* a3 = a2 + kstep; const char* b3 = b2 + kstep;
            if (last && has_next) S.a_ready(nxt);
            if constexpr (SP2) {
            PG8_LDB(B0, 0, 0); PG8_LDB(B1, 0, 1); PG8_SCHED; PG8_LDA(At, 0, 0); PG8_STAGE(PG8_SA(1, 1), a1 + hstepA, voffA);
            PG8_WAIT_V(8); PG8_WAIT_L(0); PG8_BAR; PG8_MMA(0, 0, At, B0); if (full) PG8_MMA(0, 1, At, B1); PG8_BAR; PG8_SCHED;
            PG8_LDA(At, 0, 1); PG8_STAGE(PG8_SB(0, 0), b2, voffB); PG8_STAGE(PG8_SB(0, 1), b2 + hstepB, voffB); PG8_STAGE(PG8_SA(0, 0), a2, voffA);
            PG8_WAIT_V(8); PG8_WAIT_L(0); PG8_BAR; PG8_MMA(1, 0, At, B0); if (full) PG8_MMA(1, 1, At, B1); PG8_BAR; PG8_SCHED;
            PG8_LDB(B0, 1, 0); PG8_LDB(B1, 1, 1); PG8_SCHED; PG8_LDA(At, 1, 0); PG8_STAGE(PG8_SA(0, 1), a2 + hstepA, voffA);
            PG8_WAIT_V(8); PG8_WAIT_L(0); PG8_BAR; PG8_MMA(0, 0, At, B0); if (full) PG8_MMA(0, 1, At, B1); PG8_BAR; PG8_SCHED;
            PG8_LDA(At, 1, 1); PG8_STAGE(PG8_SB(1, 0), b3, voffB); PG8_STAGE(PG8_SB(1, 1), b3 + hstepB, voffB); PG8_STAGE(PG8_SA(1, 0), a3, voffA);
            PG8_WAIT_V(8); PG8_WAIT_L(0); PG8_BAR; PG8_MMA(1, 0, At, B0); if (full) PG8_MMA(1, 1, At, B1); PG8_BAR; PG8_SCHED;
            } else {
            PG8_LDB(B0, 0, 0); PG8_SCHED; PG8_LDA(At, 0, 0); PG8_STAGE(PG8_SA(1, 1), a1 + hstepA, voffA);
            PG8_WAIT_L(8); PG8_BAR; PG8_WAIT_L(0); PG8_MMA(0, 0, At, B0); PG8_BAR; PG8_SCHED;
            PG8_LDB(B1, 0, 1); PG8_STAGE(PG8_SB(0, 0), b2, voffB);
            PG8_BAR; PG8_WAIT_L(0); PG8_MMA(0, 1, At, B1); PG8_BAR;
            PG8_LDA(At, 0, 1); PG8_STAGE(PG8_SA(0, 0), a2, voffA);
            PG8_BAR; PG8_WAIT_L(0); PG8_MMA(1, 0, At, B0); PG8_BAR; PG8_SCHED;
            PG8_STAGE(PG8_SB(0, 1), b2 + hstepB, voffB);
            PG8_WAIT_V(6); PG8_BAR; PG8_MMA(1, 1, At, B1); PG8_BAR;
            PG8_LDB(B0, 1, 0); PG8_SCHED; PG8_LDA(At, 1, 0); PG8_STAGE(PG8_SA(0, 1), a2 + hstepA, voffA);
            PG8_WAIT_L(8); PG8_BAR; PG8_WAIT_L(0); PG8_MMA(0, 0, At, B0); PG8_BAR; PG8_SCHED;
            PG8_LDB(B1, 1, 1); PG8_STAGE(PG8_SB(1, 0), b3, voffB);
            PG8_BAR; PG8_WAIT_L(0); PG8_MMA(0, 1, At, B1); PG8_BAR;
            PG8_LDA(At, 1, 1); PG8_STAGE(PG8_SA(1, 0), a3, voffA);
            PG8_BAR; PG8_WAIT_L(0); PG8_MMA(1, 0, At, B0); PG8_BAR; PG8_SCHED;
            PG8_STAGE(PG8_SB(1, 1), b3 + hstepB, voffB);
            PG8_WAIT_V(6); PG8_BAR; PG8_MMA(1, 1, At, B1); PG8_BAR;
            }
        }
        if constexpr (ALIGN_EPI) { if (wr == 0) PG8_BAR; }
        if constexpr (!Epi::AFTER_DRAIN) { E(acc, cur, wr, wc, fr, fq); S.done(cur); }
        if (!has_next) break;
#pragma unroll
        for (int a = 0; a < 2; ++a)
#pragma unroll
            for (int b = 0; b < 2; ++b)
#pragma unroll
                for (int m = 0; m < 4; ++m)
#pragma unroll
                    for (int n = 0; n < 2; ++n) acc[a][b][m][n] = (f32x4){0.f, 0.f, 0.f, 0.f};
        cur = nxt; cA = nA; cB = nB; ++ui;
        if constexpr (ALIGN_EPI) { if (wr == 1) PG8_BAR; }
    }
    PG8_WAIT_V(0);
    if constexpr (!ALIGN_EPI) { if (wr == 0) PG8_BAR; }
    PG8_BAR;
    if constexpr (Epi::AFTER_DRAIN) { E.fused(acc, cur, wr, wc, fr, fq, lds, wid, lane); S.done(cur); }
#undef PG8_SA
#undef PG8_SB
#undef PG8_STAGE
#undef PG8_LDA
#undef PG8_LDB
#undef PG8_MMA
#undef PG8_WAIT_V
#undef PG8_WAIT_L
#undef PG8_BAR
#undef PG8_SCHED
}
}
#define XB_TMO      128
#define XB_XCNT(j)  (256  + 64 * (j))
#define XB_XSUB(j)  (1280 + 64 * (j))
#define XB_XGEN(j)  (2304 + 64 * (j))
#define XB_TOP      3328
#define XB_TOPGEN   3392
#define XCD_BAR_WORDS 3456
#define XB_SPIN_CAP (1u << 18)

__device__ __forceinline__ unsigned xb_ld(unsigned* p)              { return __hip_atomic_load(p, __ATOMIC_RELAXED, __HIP_MEMORY_SCOPE_AGENT); }
__device__ __forceinline__ unsigned xb_add(unsigned* p, unsigned v) { return __hip_atomic_fetch_add(p, v, __ATOMIC_RELAXED, __HIP_MEMORY_SCOPE_AGENT); }
__device__ __forceinline__ unsigned xb_xcc_id() { return (unsigned)__builtin_amdgcn_s_getreg((3 << 11) | 20) & 0xFu; }
#define XB_SPIN(cond, bar) do { unsigned _sp = 0; while (cond) { __builtin_amdgcn_s_sleep(1); \
    if ((++_sp & 255u) == 0u) { if (xb_ld(&(bar)[XB_TMO])) break; if (_sp > XB_SPIN_CAP) { atomicAdd(&(bar)[XB_TMO], 1u); break; } } } } while (0)

struct XcdBarrier {
    unsigned* bar; unsigned x;
    volatile LAS unsigned* st;
};

__device__ __forceinline__ XcdBarrier xcd_barrier_post(unsigned* bar, volatile LAS unsigned* st) {
    XcdBarrier b; b.bar = bar; b.x = xb_xcc_id(); b.st = st;
    if (threadIdx.x == 0) (void)xb_add(&bar[XB_XCNT(b.x)], 1u);
    return b;
}
__device__ __forceinline__ void xcd_barrier_complete(unsigned* bar, unsigned x, unsigned& nloc, unsigned& nx) {
    const unsigned G = gridDim.x * gridDim.y * gridDim.z;
    unsigned sum, cnt, mine, sp = 0u;
    for (;;) {
        sum = 0u; cnt = 0u; mine = 0u;
#pragma unroll
        for (unsigned j = 0; j < 16; ++j) { const unsigned c = xb_ld(&bar[XB_XCNT(j)]); sum += c; cnt += (c > 0u) ? 1u : 0u; mine = (j == x) ? c : mine; }
        if (sum == G) break;
        __builtin_amdgcn_s_sleep(1);
        if ((++sp & 255u) == 0u) { if (xb_ld(&bar[XB_TMO])) break; if (sp > XB_SPIN_CAP) { atomicAdd(&bar[XB_TMO], 1u); break; } }
    }
    nloc = mine > 0u ? mine : 1u; nx = cnt > 0u ? cnt : 1u;
}

__device__ __forceinline__ void xcd_barrier(const XcdBarrier& b) {
    asm volatile("s_waitcnt vmcnt(0)" ::: "memory");
    __syncthreads();
    if (threadIdx.x == 0) {
        unsigned* bar = b.bar;
        __builtin_amdgcn_s_waitcnt(0);
        unsigned nloc = b.st[0], nx = b.st[1];
        if (nloc == 0u) { xcd_barrier_complete(bar, b.x, nloc, nx); b.st[0] = nloc; b.st[1] = nx; }
        const unsigned old = xb_add(&bar[XB_XSUB(b.x)], 1u);
        const unsigned gen = old / nloc;
        if (old + 1u == (gen + 1u) * nloc) {
            __builtin_amdgcn_fence(__ATOMIC_RELEASE, "agent");
            asm volatile("s_waitcnt vmcnt(0)" ::: "memory");
            const unsigned og = xb_add(&bar[XB_TOP], 1u);
            const unsigned tg = og / nx;
            if (og + 1u == (tg + 1u) * nx) xb_add(&bar[XB_TOPGEN], 1u);
            else XB_SPIN(xb_ld(&bar[XB_TOPGEN]) == tg, bar);
            __builtin_amdgcn_fence(__ATOMIC_ACQUIRE, "agent");
            xb_add(&bar[XB_XGEN(b.x)], 1u);
            asm volatile("s_waitcnt vmcnt(0)" ::: "memory");
        } else {
            XB_SPIN(xb_ld(&bar[XB_XGEN(b.x)]) == gen, bar);
            __builtin_amdgcn_fence(__ATOMIC_ACQUIRE, "agent");
            asm volatile("s_waitcnt vmcnt(0)" ::: "memory");
        }
    }
    __syncthreads();
}


__device__ __forceinline__ int win_src_col(int n) {
    if (n < 256) return 896 + n;
    if (n < 640) return 2304 + (n - 256);
    if (n < 1024) return 3104 + (n - 640);
    if (n < 1280) return n - 1024;
    if (n < 1536) return 256 + (n - 1280);
    if (n < 1792) return 512 + (n - 1536);
    if (n < 2176) return 1152 + (n - 1792);
    if (n < 2560) return 1536 + (n - 2176);
    if (n < 2944) return 1920 + (n - 2560);
    if (n < 3008) return 768 + (n - 2944);
    if (n < 3072) return 832 + (n - 3008);
    if (n < 3328) return 2688 + (n - 3072);
    if (n < 3456) return 2944 + (n - 3328);
    if (n < 3488) return 3072 + (n - 3456);
    return -1;
}
__device__ __forceinline__ int win_blk(int nb) { const int tile = nb >> 3, d = nb & 7; return (tile >= 7 && tile <= 9) ? tile * 8 + 2 * (d & 3) + (d >> 2) : nb; }
__device__ __forceinline__ void p0_tr_item(const float* W, int ldw, int src_n0, int K, bf16* WT, int dst_row0, int k0, const float* kscale, LAS float* scr, int lane) {
#pragma unroll 8
    for (int i = 0; i < 32; ++i) { const int kk = 2 * i + (lane >> 5);
        float v = src_n0 >= 0 ? W[(size_t)(k0 + kk) * ldw + src_n0 + (lane & 31)] : 0.f;
        if (kscale) v *= kscale[k0 + kk];
        scr[kk * 33 + (lane & 31)] = v; }
    LDS_WAIT(); asm volatile("" ::: "memory");
    const int c = lane & 7;
#pragma unroll
    for (int j = 0; j < 4; ++j) { const int n = (lane >> 3) + 8 * j; const LAS float* s = scr + (8 * c) * 33 + n;
        u32x4 o; o.x = pk2(s[0 * 33], s[1 * 33]); o.y = pk2(s[2 * 33], s[3 * 33]); o.z = pk2(s[4 * 33], s[5 * 33]); o.w = pk2(s[6 * 33], s[7 * 33]);
        *(u32x4*)(WT + (size_t)(dst_row0 + n) * K + k0 + 8 * c) = o; }
    LDS_WAIT(); asm volatile("" ::: "memory");
}

__device__ __forceinline__ void phase_p0a(CArgs& a, LAS unsigned char* lds, int vcu, int G, int tid, int wave, int lane) {
    unsigned char* ws = a.ws;
    if (vcu < 96) {
        const int l = vcu / 48, n0 = (vcu % 48) * 64;
        LAS float* tab = (LAS float*)lds;
        LAS float* red = tab + 9216;
        for (int i = tid; i < 9216; i += 512) { const int j = i >> 10, k = i & 1023; const float c = j == 0 ? a.in[8][k] : a.in[7][(j - 1) * 1024 + k]; tab[i] = silu_f(c); }
        __syncthreads();
        float acc[9];
#pragma unroll
        for (int j = 0; j < 9; ++j) acc[j] = 0.f;
        const float* wm = a.in[9] + (size_t)l * 1024 * 3072 + n0 + lane;
        for (int kk = 0; kk < 128; ++kk) { const int k = wave * 128 + kk; const float wv = wm[(size_t)k * 3072];
#pragma unroll
            for (int j = 0; j < 9; ++j) acc[j] += tab[j * 1024 + k] * wv; }
#pragma unroll
        for (int j = 0; j < 9; ++j) red[(wave * 9 + j) * 64 + lane] = acc[j];
        __syncthreads();
        float* mod = (float*)(ws + WS_MOD);
        for (int i = tid; i < 576; i += 512) { const int j = i >> 6, ln = i & 63; float s = 0.f;
#pragma unroll
            for (int w = 0; w < 8; ++w) s += red[(w * 9 + j) * 64 + ln];
            mod[(size_t)(l * 9 + j) * 3072 + n0 + ln] = s + a.in[10][l * 3072 + n0 + ln]; }
        __syncthreads();
    }
    LAS float* scr = (LAS float*)(lds + 57344 + wave * 8704);
    const int gw = vcu * 8 + wave, NGW = G * 8;
    bf16* WIN = (bf16*)(ws + WS_WIN); bf16* WOUT = (bf16*)(ws + WS_WOUT); bf16* WUQ = (bf16*)(ws + WS_WUQ); bf16* WUKV = (bf16*)(ws + WS_WUKV); bf16* LORA = (bf16*)(ws + WS_LORA);
    for (int it = gw; it < 4912; it += NGW) {
        int r = it;
        if (r < 3584) { const int l = r / 1792, q = r % 1792, kb = q / 112, nb = q % 112;
            p0_tr_item(a.in[12] + (size_t)l * 1024 * 3488, 3488, win_src_col(32 * win_blk(nb)), 1024, WIN + (size_t)l * 3584 * 1024, 32 * nb, 64 * kb, nullptr, scr, lane); continue; } r -= 3584;
        if (r < 1024) { const int l = r / 512, q = r % 512, kb = q / 32, nb = q % 32;
            p0_tr_item(a.in[13] + (size_t)l * 1024 * 1024, 1024, 32 * nb, 1024, WOUT + (size_t)l * 1024 * 1024, 32 * nb, 64 * kb, nullptr, scr, lane); continue; } r -= 1024;
        if (r < 144) { const int l = r / 72, q = r % 72, kb = q / 18, nb = q % 18;
            p0_tr_item(a.in[29] + (size_t)l * 256 * 576, 576, 32 * nb, 256, WUQ + (size_t)l * 576 * 256, 32 * nb, 64 * kb, a.in[27] + l * 256, scr, lane); continue; } r -= 144;
        if (r < 48) { const int l = r / 24, q = r % 24, kb = q / 12, nb = q % 12;
            p0_tr_item(a.in[30] + (size_t)l * 128 * 384, 384, 32 * nb, 128, WUKV + (size_t)l * 768 * 128, 32 * nb, 64 * kb, nullptr, scr, lane); continue; } r -= 48;
        if (r < 48) { const int l = r / 24, q = r % 24, kb = q / 12, nb = q % 12;
            p0_tr_item(a.in[31] + (size_t)l * 128 * 384, 384, 32 * nb, 128, WUKV + (size_t)l * 768 * 128, 384 + 32 * nb, 64 * kb, nullptr, scr, lane); continue; } r -= 48;
        { const int which = r / 32, q = r % 32, ld = q / 8, nb = q % 8;
          const int l = ld >> 1, d = ld & 1;
          p0_tr_item(a.in[which ? 18 : 16] + (size_t)ld * 64 * 256, 256, 32 * nb, 64, LORA + (size_t)(((l * 2 + which) * 2 + d) * 256) * 64, 32 * nb, 0, nullptr, scr, lane); }
    }
    {
        const size_t gt = (size_t)vcu * 512 + tid, NT = (size_t)G * 512;
        for (int w = 0; w < 2; ++w) { const float* src = a.in[3 + w]; bf16* dst = (bf16*)(ws + (w ? WS_NACV : WS_NACK));
            for (size_t c = gt; c < 393216; c += NT) { const f32x4 v0 = *(const f32x4*)(src + c * 8), v1 = *(const f32x4*)(src + c * 8 + 4);
                u32x4 o; o.x = pk2(v0[0], v0[1]); o.y = pk2(v0[2], v0[3]); o.z = pk2(v1[0], v1[1]); o.w = pk2(v1[2], v1[3]); *(u32x4*)(dst + c * 8) = o; } }
    }
}

__device__ __forceinline__ void phase_norm(CArgs& a, int l, int vcu, int G, int wave, int lane) {
    const int gw = vcu * 8 + wave, NGW = G * 8;
    const float* mod = (const float*)(a.ws + WS_MOD) + (size_t)l * 9 * 3072;
    const float* nw = a.in[11] + l * 1024;
    bf16* H = (bf16*)(a.ws + WS_H);
    for (int tok = gw; tok < NTOK; tok += NGW) {
        const float* xr = (l == 0) ? x_row0(a, tok) : a.out + OUT_Y + (size_t)tok * DM;
        const float* md = mod + mod_idx(tok) * 3072;
        f32x4 v[4]; float s = 0.f;
#pragma unroll
        for (int j = 0; j < 4; ++j) { v[j] = *(const f32x4*)(xr + 4 * lane + 256 * j); s += (v[j][0] * v[j][0] + v[j][1] * v[j][1]) + (v[j][2] * v[j][2] + v[j][3] * v[j][3]); }
        s = wave64_sum(s);
        const float rstd = __builtin_amdgcn_rsqf(s * (1.f / 1024.f) + EPS);
#pragma unroll
        for (int j = 0; j < 4; ++j) { const int c = 4 * lane + 256 * j;
            const f32x4 g = *(const f32x4*)(nw + c), sh = *(const f32x4*)(md + c), sc = *(const f32x4*)(md + 1024 + c);
            f32x4 o = ((v[j] * rstd) * g) * (sc + 1.0f) + sh;
            u32x2 w; w.x = pk2(o[0], o[1]); w.y = pk2(o[2], o[3]);
            *(u32x2*)(H + (size_t)tok * DM + c) = w; }
    }
}

__device__ __forceinline__ void phase_l1_tables(CArgs& a, int vcu, int G, int tid, int wave, int lane) {
    const float* mod1 = (const float*)(a.ws + WS_MOD) + (size_t)9 * 3072;
    const float* nw1 = a.in[11] + 1024;
    float* S1 = (float*)(a.ws + WS_S1T); float* C1 = (float*)(a.ws + WS_C1);
    for (int i = vcu * 512 + tid; i < 9216; i += G * 512) { const int b = i >> 10, k = i & 1023; S1[i] = nw1[k] * (1.0f + mod1[b * 3072 + 1024 + k]); }
    const bf16* W1 = (const bf16*)(a.ws + WS_WIN) + (size_t)NPROJ * DM;
    for (int n = vcu * 8 + wave; n < NPROJ; n += G * 8) {
        const bf16x8 w0 = *(const bf16x8*)(W1 + (size_t)n * DM + 16 * lane), w1 = *(const bf16x8*)(W1 + (size_t)n * DM + 16 * lane + 8);
        float wf[16];
#pragma unroll
        for (int q = 0; q < 8; ++q) { wf[q] = bf2f((unsigned short)w0[q]); wf[8 + q] = bf2f((unsigned short)w1[q]); }
#pragma unroll 1
        for (int b = 0; b < 9; ++b) { const float* sh = mod1 + b * 3072 + 16 * lane; float s = 0.f;
#pragma unroll
            for (int q = 0; q < 4; ++q) { const f32x4 v = *(const f32x4*)(sh + 4 * q); s += (v[0] * wf[4 * q] + v[1] * wf[4 * q + 1]) + (v[2] * wf[4 * q + 2] + v[3] * wf[4 * q + 3]); }
            s = wave64_sum(s);
            if (lane == 0) C1[b * NPROJ + n] = s; }
    }
}

__device__ __forceinline__ bf16x8 ld8(const bf16* p) { return *(const bf16x8*)p; }
__device__ __forceinline__ f32x16 mfma32(bf16x8 x, bf16x8 y, f32x16 c) { return __builtin_amdgcn_mfma_f32_32x32x16_bf16(x, y, c, 0, 0, 0); }
__device__ __forceinline__ bf16x8 pack8(const float* f) { u32x4 w; w.x = pk2(f[0], f[1]); w.y = pk2(f[2], f[3]); w.z = pk2(f[4], f[5]); w.w = pk2(f[6], f[7]); return __builtin_bit_cast(bf16x8, w); }
__device__ __forceinline__ void st4bf(bf16* p, float x0, float x1, float x2, float x3) { u32x2 w; w.x = pk2(x0, x1); w.y = pk2(x2, x3); *(u32x2*)p = w; }

__device__ __forceinline__ void rope_tables(float (&cs)[8], float (&sn)[8], bool latent, int tok, int hi) {
    if (latent) { const int tp = (tok - NTC) & 4095; const float prow = (float)(tp >> 6), pcol = (float)(tp & 63);
#pragma unroll
        for (int r = 0; r < 8; ++r) { const float f = (float)((r & 3) + 4 * hi); const float inv = __builtin_amdgcn_exp2f(-f * 1.6609640474436812f);
            float rev = (r < 4 ? prow : pcol) * inv * 0.15915494309189535f; rev = rev - floorf(rev);
            cs[r] = __builtin_amdgcn_cosf(rev); sn[r] = __builtin_amdgcn_sinf(rev); } }
    else {
#pragma unroll
        for (int r = 0; r < 8; ++r) { cs[r] = 1.f; sn[r] = 0.f; } }
}
__device__ __forceinline__ void st32blk(bf16* rowp, const float* v, int hi) {
#pragma unroll
    for (int k = 0; k < 4; k += 2) {
        u32x2 A, B; A.x = pk2(v[4 * k], v[4 * k + 1]); A.y = pk2(v[4 * k + 2], v[4 * k + 3]); B.x = pk2(v[4 * k + 4], v[4 * k + 5]); B.y = pk2(v[4 * k + 6], v[4 * k + 7]);
        const auto r0 = __builtin_amdgcn_permlane32_swap(A.x, B.x, false, false); const auto r1 = __builtin_amdgcn_permlane32_swap(A.y, B.y, false, false);
        u32x4 w; w.x = r0[0]; w.y = r1[0]; w.z = r0[1]; w.w = r1[1];
        *(u32x4*)(rowp + 8 * k + 8 * hi) = w;
    }
}
constexpr int P2_RQ = 528, P2_RKV = 272;
__device__ __forceinline__ void p2_q_job(CArgs& a, int l, LAS unsigned char* lds, int tile, int hp, int tid) {
    asm volatile("" : "+v"(tid));
    const int lane = tid & 63, wave = __builtin_amdgcn_readfirstlane(tid >> 6), r32 = lane & 31, hi = lane >> 5;
    const bf16* Wuq = (const bf16*)(a.ws + WS_WUQ) + (size_t)l * 576 * 256;
    const bool latent = tile >= NTC / 256;
    const unsigned tok = tile * 256 + wave * 32 + r32;
    const bf16* PB = (const bf16*)(a.ws + WS_PB);
    bf16x8 xq[16]; float ss = 0.f;
    { const bf16* pp = PB + tok * LDB + CB_CQ + 8 * hi;
#pragma unroll
      for (int s = 0; s < 16; ++s) { xq[s] = ld8(pp + 16 * s); ss += ss8(xq[s]); } }
    ss = xor32_sum(ss);
    const float rstd_cq = __builtin_amdgcn_rsqf(ss * (1.f / 256.f) + EPS);
    const float* qn = a.in[32] + l * 96;
    bf16* Qrow = (bf16*)(a.ws + WS_Q) + (size_t)tok * 576;
    bf16x8 wreg[6];
    const int wrow = tid >> 5, wc = tid & 31;
    unsigned wso = wrow * 256 + wc * 8; asm volatile("" : "+v"(wso));
#pragma unroll
    for (int i = 0; i < 6; ++i) wreg[i] = ld8(Wuq + ((2 * hp) * 96 + 16 * i) * 256 + wso);
#pragma unroll 1
    for (int hh = 0; hh < 2; ++hh) {
        const int head = 2 * hp + hh;
        __syncthreads();
#pragma unroll
        for (int i = 0; i < 6; ++i) *(LAS bf16x8*)(lds + (wrow + 16 * i) * P2_RQ + wc * 16) = wreg[i];
        if (hh == 0) {
#pragma unroll
            for (int i = 0; i < 6; ++i) wreg[i] = ld8(Wuq + ((2 * hp + 1) * 96 + 16 * i) * 256 + wso);
        }
        __syncthreads();
        f32x16 acc[3];
#pragma unroll
        for (int b = 0; b < 3; ++b) { acc[b] = (f32x16){};
            LAS const unsigned char* wl = lds + (32 * b + r32) * P2_RQ + 16 * hi;
#pragma unroll
            for (int s = 0; s < 16; ++s) acc[b] = mfma32(*(LAS const bf16x8*)(wl + 32 * s), xq[s], acc[b]); }
        float q2 = 0.f;
#pragma unroll
        for (int b = 0; b < 3; ++b)
#pragma unroll
            for (int r = 0; r < 16; ++r) q2 += acc[b][r] * acc[b][r];
        q2 = xor32_sum(q2) * (rstd_cq * rstd_cq);
        const float rq = (__builtin_amdgcn_rsqf(q2 * (1.f / 96.f) + EPS)) * (MLA_SCALE * LOG2E) * rstd_cq;
#pragma unroll
        for (int b = 0; b < 3; ++b)
#pragma unroll
            for (int g = 0; g < 4; ++g) { const f32x4 w4 = *(const f32x4*)(qn + b * 32 + 8 * g + 4 * hi);
#pragma unroll
                for (int i = 0; i < 4; ++i) acc[b][4 * g + i] *= rq * w4[i]; }
        { int tk = (int)tok; asm volatile("" : "+v"(tk)); float cs[8], sn[8]; rope_tables(cs, sn, latent, tk, hi);
#pragma unroll
          for (int r = 0; r < 8; ++r) { const float x1 = acc[2][r], x2 = acc[2][r + 8]; acc[2][r] = x1 * cs[r] - x2 * sn[r]; acc[2][r + 8] = x2 * cs[r] + x1 * sn[r]; } }
#pragma unroll
        for (int b = 0; b < 3; ++b) { float v[16];
#pragma unroll
            for (int r = 0; r < 16; ++r) v[r] = acc[b][r];
            st32blk(Qrow + head * 96 + b * 32, v, hi); }
    }
}
__device__ __forceinline__ void p2_kv_job(CArgs& a, int l, LAS unsigned char* lds, int tile, int part, int tid) {
    asm volatile("" : "+v"(tid));
    const int lane = tid & 63, wave = __builtin_amdgcn_readfirstlane(tid >> 6), r32 = lane & 31, hi = lane >> 5;
    unsigned char* ws = a.ws;
    const bf16* Wukv = (const bf16*)(ws + WS_WUKV) + (size_t)l * 768 * 128;
    const bool is_cc = tile >= 160;
    const bool latent = !is_cc && tile >= NTC / 256;
    const bool context = !is_cc && !latent;
    const unsigned tok = (is_cc ? (tile - 160) * 256 : tile * 256) + wave * 32 + r32;
    { const int rb = part < 2 ? 192 * part : 384 + 192 * (part - 2); const int wrow = tid >> 4, wc = tid & 15;
      bf16x8 wreg[6];
      unsigned wso = wrow * 128 + wc * 8; asm volatile("" : "+v"(wso));
#pragma unroll
      for (int i = 0; i < 6; ++i) wreg[i] = ld8(Wukv + (rb + 32 * i) * 128 + wso);
      __syncthreads();
#pragma unroll
      for (int i = 0; i < 6; ++i) *(LAS bf16x8*)(lds + (wrow + 32 * i) * P2_RKV + wc * 16) = wreg[i]; }
    bf16* Kd = (bf16*)(ws + (is_cc ? WS_CK : WS_MK)) + (size_t)tok * 576; bf16* Vd = (bf16*)(ws + (is_cc ? WS_CV : WS_MV)) + (size_t)tok * 384;
    bf16x8 xk[8]; float kr[16]; float kr2 = 0.f;
    if (!is_cc) {
        const bf16* PB = (const bf16*)(ws + WS_PB);
        const unsigned pbo = tok * LDB + 8 * hi;
        float ss = 0.f;
        { const bf16* pp = PB + pbo + CB_CKV;
#pragma unroll
          for (int s = 0; s < 8; ++s) { xk[s] = ld8(pp + 16 * s); ss += ss8(xk[s]); } }
        ss = xor32_sum(ss);
        const float rstd = __builtin_amdgcn_rsqf(ss * (1.f / 128.f) + EPS);
        const float* gk = a.in[28] + l * 128;
        const unsigned cb = tok >> 8, ct = tok & 255;
        float* ckv_out = a.out + OUT_CKV; const unsigned co = ((cb * 2 + l) * 256 + ct) * 128 + 8 * hi;
        const bool wr_cache = context && part == 0;
#pragma unroll
        for (int s = 0; s < 8; ++s) { float f[8];
            const f32x4 g0 = *(const f32x4*)(gk + 16 * s + 8 * hi), g1 = *(const f32x4*)(gk + 16 * s + 8 * hi + 4);
#pragma unroll
            for (int j = 0; j < 8; ++j) f[j] = bf2f((unsigned short)xk[s][j]) * rstd * (j < 4 ? g0[j & 3] : g1[j & 3]);
            if (wr_cache) { *(f32x4*)(ckv_out + co + 16 * s) = (f32x4){f[0], f[1], f[2], f[3]}; *(f32x4*)(ckv_out + co + (16 * s + 4)) = (f32x4){f[4], f[5], f[6], f[7]}; }
            xk[s] = pack8(f); }
        float* kr_out = a.out + OUT_KROPE; const unsigned kro = ((cb * 2 + l) * 256 + ct) * 32 + 4 * hi;
#pragma unroll
        for (int g = 0; g < 4; ++g) { const u32x2 w = *(const u32x2*)(PB + pbo + (CB_KR + 8 * g) - 4 * hi);
            kr[4 * g] = lo_f(w.x); kr[4 * g + 1] = hi_f(w.x); kr[4 * g + 2] = lo_f(w.y); kr[4 * g + 3] = hi_f(w.y);
            if (wr_cache) *(f32x4*)(kr_out + kro + 8 * g) = (f32x4){kr[4 * g], kr[4 * g + 1], kr[4 * g + 2], kr[4 * g + 3]}; }
    } else {
        const unsigned b = tok >> 9, p = tok & 511;
        const float* src = a.in[5]; const unsigned so = ((b * 2 + l) * 512 + p) * 128 + 8 * hi;
#pragma unroll
        for (int s = 0; s < 8; ++s) { const f32x4 v0 = *(const f32x4*)(src + so + 16 * s), v1 = *(const f32x4*)(src + so + (16 * s + 4));
            float f[8] = {v0[0], v0[1], v0[2], v0[3], v1[0], v1[1], v1[2], v1[3]}; xk[s] = pack8(f); }
        const float* ksrc = a.in[6]; const unsigned kso = ((b * 2 + l) * 512 + p) * 32 + 4 * hi;
#pragma unroll
        for (int g = 0; g < 4; ++g) { const f32x4 v = *(const f32x4*)(ksrc + kso + 8 * g); kr[4 * g] = v[0]; kr[4 * g + 1] = v[1]; kr[4 * g + 2] = v[2]; kr[4 * g + 3] = v[3]; }
    }
#pragma unroll
    for (int r = 0; r < 16; ++r) kr2 += kr[r] * kr[r];
    kr2 = xor32_sum(kr2);
    const float* kn = a.in[33] + l * 96;
    __syncthreads();
    if (part < 2) {
#pragma unroll 1
        for (int hh = 0; hh < 3; ++hh) {
            const int head = 3 * part + hh;
            f32x16 acc[2];
#pragma unroll
            for (int b = 0; b < 2; ++b) { acc[b] = (f32x16){};
                LAS const unsigned char* wl = lds + (64 * hh + 32 * b + r32) * P2_RKV + 16 * hi;
#pragma unroll
                for (int s = 0; s < 8; ++s) acc[b] = mfma32(*(LAS const bf16x8*)(wl + 32 * s), xk[s], acc[b]); }
            float k2 = 0.f;
#pragma unroll
            for (int b = 0; b < 2; ++b)
#pragma unroll
                for (int r = 0; r < 16; ++r) k2 += acc[b][r] * acc[b][r];
            k2 = xor32_sum(k2);
            const float rk = __builtin_amdgcn_rsqf((k2 + kr2) * (1.f / 96.f) + EPS);
#pragma unroll
            for (int b = 0; b < 2; ++b) { float v[16];
#pragma unroll
                for (int g = 0; g < 4; ++g) { const f32x4 w4 = *(const f32x4*)(kn + b * 32 + 8 * g + 4 * hi);
#pragma unroll
                    for (int i = 0; i < 4; ++i) v[4 * g + i] = acc[b][4 * g + i] * rk * w4[i]; }
                st32blk(Kd + head * 96 + b * 32, v, hi); }
            float kv[16];
#pragma unroll
            for (int g = 0; g < 4; ++g) { const f32x4 w4 = *(const f32x4*)(kn + 64 + 8 * g + 4 * hi);
#pragma unroll
                for (int i = 0; i < 4; ++i) kv[4 * g + i] = kr[4 * g + i] * rk * w4[i]; }
            { int tk = (int)tok; asm volatile("" : "+v"(tk)); float cs[8], sn[8]; rope_tables(cs, sn, latent, tk, hi);
#pragma unroll
              for (int r = 0; r < 8; ++r) { const float x1 = kv[r], x2 = kv[r + 8]; kv[r] = x1 * cs[r] - x2 * sn[r]; kv[r + 8] = x2 * cs[r] + x1 * sn[r]; } }
            st32blk(Kd + head * 96 + 64, kv, hi);
        }
    } else {
#pragma unroll 1
        for (int nb = 0; nb < 6; ++nb) {
            f32x16 acc = (f32x16){};
            LAS const unsigned char* wl = lds + (32 * nb + r32) * P2_RKV + 16 * hi;
#pragma unroll
            for (int s = 0; s < 8; ++s) acc = mfma32(*(LAS const bf16x8*)(wl + 32 * s), xk[s], acc);
            float v[16];
#pragma unroll
            for (int r = 0; r < 16; ++r) v[r] = acc[r];
            st32blk(Vd + 192 * (part - 2) + nb * 32, v, hi);
        }
    }
}

__device__ __forceinline__ void p2_na_token(CArgs& a, int l, int tok, int lane) {
    asm volatile("" : "+v"(lane));
    bf16* row = (bf16*)(a.ws + WS_PA) + (size_t)tok * LDA;
    const bool context = tok < NTC;
    const int cb = tok >> 8, ct = tok & 255;
    float* nak = a.out + OUT_NAK + ((size_t)(cb * 2 + l) * 256 + ct) * 384;
    float* nav = a.out + OUT_NAV + ((size_t)(cb * 2 + l) * 256 + ct) * 384;
    const float* qw = a.in[24] + l * 64; const float* kw = a.in[25] + l * 64;
#pragma unroll
    for (int i = 0; i < 3; ++i) {
        const int e = 4 * lane + 256 * i;
        const u32x2 w = *(const u32x2*)(row + CA_QN + e);
        float f[4] = {lo_f(w.x), hi_f(w.x), lo_f(w.y), hi_f(w.y)};
        float s = (f[0] * f[0] + f[1] * f[1]) + (f[2] * f[2] + f[3] * f[3]);
        s = row16_sum(s);
        const float rs = __builtin_amdgcn_rsqf(s * (1.f / 64.f) + EPS);
        const bool isq = e < 384; const int d = e & 63;
        const float* gw = isq ? qw : kw; const float sc = isq ? rs * (0.125f * LOG2E) : rs;
        float o[4];
#pragma unroll
        for (int j = 0; j < 4; ++j) o[j] = f[j] * sc * gw[d + j];
        st4bf(row + CA_QN + e, o[0], o[1], o[2], o[3]);
        if (context && !isq) *(f32x4*)(nak + (e - 384)) = (f32x4){o[0], o[1], o[2], o[3]};
    }
    if (context) {
#pragma unroll
        for (int i = 0; i < 2; ++i) { const int e = 4 * lane + 256 * i;
            if (e < 384) { const u32x2 w = *(const u32x2*)(row + CA_VN + e); *(f32x4*)(nav + e) = (f32x4){lo_f(w.x), hi_f(w.x), lo_f(w.y), hi_f(w.y)}; } }
    }
}

__device__ __forceinline__ void phase_p2(CArgs& a, int l, LAS unsigned char* lds, int vcu, int G, int tid, int wave, int lane, bool dry) {
    for (int jid = vcu; jid < 1184; jid += G) { if (jid < 480) p2_q_job(a, l, lds, jid / 3, jid % 3, tid); else { const int v = jid - 480; p2_kv_job(a, l, lds, v >> 2, v & 3, tid); } }
    __syncthreads();
    (void)dry; (void)wave; (void)lane;
}

struct AttnSeg { const bf16* K; const bf16* V; int ks, vs, nt; };
constexpr int ATT_KVB = 20480;
constexpr int ATT_BIAS_OFF = 2 * ATT_KVB;
typedef LAS const unsigned char* ldsc_t;
__device__ __forceinline__ s16x4 vtr(ldsc_t p) { typedef short v4i16_t __attribute__((ext_vector_type(4))); return __builtin_bit_cast(s16x4, __builtin_amdgcn_ds_read_tr16_b64_v4i16((LAS v4i16_t*)p)); }

__device__ __forceinline__ float max3f(float a, float b, float c) { float r; asm("v_max3_f32 %0, %1, %2, %3" : "=v"(r) : "v"(a), "v"(b), "v"(c)); return r; }
__device__ __forceinline__ float max2f(float a, float b) { float r; asm("v_max_f32_e32 %0, %1, %2" : "=v"(r) : "v"(a), "v"(b)); return r; }
template <int DK, bool LOCAL_OK>
__device__ __forceinline__ void attn_unit(LAS unsigned char* lds, const bf16* Qp, int qs, AttnSeg s0, AttnSeg s1, bf16* Gp, int gs,
                                          const bool local_rt, const float* rpb, int r0, int kr_lo, int tid, bool dry) {
    asm volatile("" : "+v"(tid));
    const bool LOCAL = LOCAL_OK && local_rt;
    constexpr int NS = DK / 16;
    constexpr int KB = 64 * DK * 2;
    const int lane = tid & 63, wave = __builtin_amdgcn_readfirstlane(tid >> 6), r32 = lane & 31, hi = lane >> 5;
    bf16x8 qf[NS];
    { const bf16* qrow = Qp + (size_t)(wave * 32 + r32) * qs + 8 * hi;
#pragma unroll
      for (int s = 0; s < NS; ++s) qf[s] = ld8(qrow + 16 * s); }
    int my_row = 0, my_rs = 0, jbase = 0, lbase = 0;
    if (LOCAL) {
        LAS float* bt = (LAS float*)(lds + ATT_BIAS_OFF);
        if (tid < 480) { const int row = tid >> 1, half = tid & 1; const int L = row / 15, dr = row - L * 15;
#pragma unroll
            for (int q = 0; q < 17; ++q) { const int j = 17 * half + q, dc = j - 1; const bool ok = dc >= L && dc < L + 16 && dc >= 0 && dc <= 30;
                bt[row * 34 + j] = ok ? rpb[dr * 31 + (ok ? dc : 0)] * LOG2E : -1e30f; } }
        my_row = r0 + (wave >> 1); my_rs = min(max(my_row - 4, 0), 56);
        const int qcol = 32 * (wave & 1) + r32, cs_ = min(max(qcol - 8, 0), 48);
        jbase = 16 - qcol + 4 * hi;
        lbase = (cs_ - qcol + 15) * 510;
    }
    const int nt = s0.nt + s1.nt;
    const int vkey = 16 * (wave & 3) + (lane >> 2), vch = 4 * (wave >> 2) + (lane & 3);
    bf16x8 kreg0, kreg1, vreg;
    auto stage_load = [&](int t) {
        const bool in0 = t < s0.nt; const int tt = in0 ? t : t - s0.nt;
        const bf16* Kb = in0 ? s0.K : s1.K; const bf16* Vb = in0 ? s0.V : s1.V; const int ks = in0 ? s0.ks : s1.ks, vs = in0 ? s0.vs : s1.vs;
        const bf16* kp = Kb + (size_t)(tt * 64 + lane) * ks;
        kreg0 = ld8(kp + wave * 8);
        if (DK == 96 && wave < 4) kreg1 = ld8(kp + (wave + 8) * 8);
        vreg = ld8(Vb + (size_t)(tt * 64 + vkey) * vs + vch * 8);
    };
    auto stage_write = [&](int buf) {
        LAS unsigned char* kb = lds + buf * ATT_KVB;
        *(LAS bf16x8*)(kb + wave * 1024 + lane * 16) = kreg0;
        if (DK == 96 && wave < 4) *(LAS bf16x8*)(kb + (wave + 8) * 1024 + lane * 16) = kreg1;
        *(LAS bf16x8*)(kb + KB + wave * 1024 + lane * 16) = vreg;
    };
    float m = 0.f, lsum = 0.f;
    f32x16 o0 = (f32x16){}, o1 = (f32x16){}, negm = (f32x16){};
    stage_load(0); stage_write(0);
    __syncthreads();
    for (int t = 0; t < nt; ++t) {
        if (t + 1 < nt) stage_load(t + 1);
        bool active = true; int dr = 0;
        if (LOCAL && t >= s0.nt) { const int kr = kr_lo + (t - s0.nt); active = (kr >= my_rs) && (kr < my_rs + 8); dr = kr - my_row + 7; }
        if (active) {
            ldsc_t kb = (ldsc_t)(lds + (t & 1) * ATT_KVB);
            f32x16 p0, p1;
            __builtin_amdgcn_s_setprio(1);
            __builtin_amdgcn_iglp_opt(1);
            bf16x8 kf0[NS], kf1[NS];
#pragma unroll
            for (int s = 0; s < NS; ++s) { kf0[s] = *(LAS const bf16x8*)(kb + (2 * s + hi) * 1024 + r32 * 16); kf1[s] = *(LAS const bf16x8*)(kb + (2 * s + hi) * 1024 + r32 * 16 + 512); }
            __builtin_amdgcn_sched_barrier(0);
#pragma unroll
            for (int s = 0; s < NS; ++s) {
                if (s == 0) { p0 = mfma32(kf0[0], qf[0], negm); p1 = mfma32(kf1[0], qf[0], negm); }
                else { p0 = mfma32(kf0[s], qf[s], p0); p1 = mfma32(kf1[s], qf[s], p1); }
            }
            __builtin_amdgcn_s_setprio(0);
            if (LOCAL && t >= s0.nt) {
                LAS const float* bt = (LAS const float*)(lds + ATT_BIAS_OFF) + lbase + dr * 34;
#pragma unroll
                for (int r = 0; r < 16; ++r) {
                    const int j0 = min(max(jbase + (r & 3) + 8 * (r >> 2), 0), 33), j1 = min(max(jbase + (r & 3) + 8 * (r >> 2) + 32, 0), 33);
                    p0[r] += bt[j0]; p1[r] += bt[j1];
                }
            }
            float mxa = max3f(p0[0], p0[1], p1[0]), mxb = max3f(p0[2], p0[3], p1[1]); mxa = max3f(mxa, p1[2], p1[3]);
#pragma unroll
            for (int r = 4; r < 16; r += 4) { mxa = max3f(mxa, p0[r], p0[r + 1]); mxb = max3f(mxb, p0[r + 2], p0[r + 3]); mxa = max3f(mxa, p1[r], p1[r + 1]); mxb = max3f(mxb, p1[r + 2], p1[r + 3]); }
            float mx = max2f(mxa, mxb);
            { const auto rr = __builtin_amdgcn_permlane32_swap(__float_as_uint(mx), __float_as_uint(mx), false, false); mx = max2f(__uint_as_float(rr[0]), __uint_as_float(rr[1])); }
            if (t == 0 || !__all(mx <= 8.0f)) {
                const float d = t == 0 ? mx : fmaxf(mx, 0.f); const float al = __builtin_amdgcn_exp2f(-d);
#pragma unroll
                for (int r = 0; r < 16; ++r) { o0[r] *= al; o1[r] *= al; p0[r] -= d; p1[r] -= d; }
                lsum *= al; m += d;
#pragma unroll
                for (int r = 0; r < 16; ++r) negm[r] = -m;
            }
            ldsc_t vp = kb + KB + ((lane >> 4) & 1) * 32 + (lane & 3) * 8 + (4 * hi + ((lane & 15) >> 2)) * 64;
            s16x4 va[8], vb[8];
#pragma unroll
            for (int i = 0; i < 8; ++i) { va[i] = vtr(vp + (i >> 2) * 4096 + (i & 3) * 1024); vb[i] = vtr(vp + (i >> 2) * 4096 + (i & 3) * 1024 + 512); }
#define ATT_VF(i) ((bf16x8){va[i][0], va[i][1], va[i][2], va[i][3], vb[i][0], vb[i][1], vb[i][2], vb[i][3]})
            float ps = 0.f; float e0[16], e1[16];
#pragma unroll
            for (int r = 0; r < 16; ++r) { e0[r] = __builtin_amdgcn_exp2f(p0[r]); ps += e0[r]; }
            const bf16x8 pa0 = pack8(e0), pa1 = pack8(e0 + 8);
            __builtin_amdgcn_sched_barrier(0);
            o0 = mfma32(ATT_VF(0), pa0, o0); o1 = mfma32(ATT_VF(4), pa0, o1);
            o0 = mfma32(ATT_VF(1), pa1, o0); o1 = mfma32(ATT_VF(5), pa1, o1);
            __builtin_amdgcn_sched_barrier(0);
#pragma unroll
            for (int r = 0; r < 16; ++r) { e1[r] = __builtin_amdgcn_exp2f(p1[r]); ps += e1[r]; }
            lsum += ps;
            const bf16x8 pa2 = pack8(e1), pa3 = pack8(e1 + 8);
            __builtin_amdgcn_sched_barrier(0);
            o0 = mfma32(ATT_VF(2), pa2, o0); o1 = mfma32(ATT_VF(6), pa2, o1);
            o0 = mfma32(ATT_VF(3), pa3, o0); o1 = mfma32(ATT_VF(7), pa3, o1);
#undef ATT_VF
        }
        if (t + 1 < nt) stage_write((t + 1) & 1);
        __syncthreads();
    }
    const float inv = 1.0f / xor32_sum(lsum);
    if (!dry) {
    bf16* grow = Gp + (size_t)(wave * 32 + r32) * gs;
#pragma unroll
    for (int g = 0; g < 4; ++g) {
        { bf16* p = grow + 8 * g + 4 * hi; const u32x2 w = *(const u32x2*)p;
          st4bf(p, o0[4 * g] * inv * silu_f(lo_f(w.x)), o0[4 * g + 1] * inv * silu_f(hi_f(w.x)), o0[4 * g + 2] * inv * silu_f(lo_f(w.y)), o0[4 * g + 3] * inv * silu_f(hi_f(w.y))); }
        { bf16* p = grow + 32 + 8 * g + 4 * hi; const u32x2 w = *(const u32x2*)p;
          st4bf(p, o1[4 * g] * inv * silu_f(lo_f(w.x)), o1[4 * g + 1] * inv * silu_f(hi_f(w.x)), o1[4 * g + 2] * inv * silu_f(lo_f(w.y)), o1[4 * g + 3] * inv * silu_f(hi_f(w.y))); }
    }
    } else { asm volatile("" :: "v"(o0), "v"(o1), "v"(inv)); }
    __syncthreads();
}

constexpr int ATT_UNITS = 1920;
__device__ __forceinline__ void attn_dispatch(CArgs& a, int l, int u, LAS unsigned char* lds, int tid, int dmode) {
    const bool dry = dmode != 0;
    unsigned char* ws = a.ws;
    bf16* PA = (bf16*)(ws + WS_PA);
    if (u < 768 || (u >= 1536 && u < 1728)) {
        AttnSeg s0, s1; int tok0, h;
        if (u < 768) { const int b = u / 96, qb = u % 16; h = (u / 16) % 6; tok0 = NTC + b * TL + qb * 256;
            s0 = AttnSeg{(const bf16*)(ws + WS_CK) + (size_t)(b * 512) * 576 + h * 96, (const bf16*)(ws + WS_CV) + (size_t)(b * 512) * 384 + h * 64, 576, 384, 8};
            s1 = AttnSeg{(const bf16*)(ws + WS_MK) + (size_t)(NTC + b * TL) * 576 + h * 96, (const bf16*)(ws + WS_MV) + (size_t)(NTC + b * TL) * 384 + h * 64, 576, 384, 64};
        } else { const int v = u - 1536; const int b = v / 6; h = v % 6; tok0 = b * TC;
            s0 = AttnSeg{(const bf16*)(ws + WS_MK) + (size_t)tok0 * 576 + h * 96, (const bf16*)(ws + WS_MV) + (size_t)tok0 * 384 + h * 64, 576, 384, 4};
            s1 = AttnSeg{s0.K, s0.V, 576, 384, 0}; }
        attn_unit<96, false>(lds, (const bf16*)(ws + WS_Q) + (size_t)tok0 * 576 + h * 96, 576, s0, s1, PA + (size_t)tok0 * LDA + CA_GM + h * 64, LDA, false, nullptr, 0, 0, tid, dry);
    } else {
        AttnSeg s0, s1; int tok0, h, r0 = 0, kr_lo = 0; bool local = false;
        if (u < 1536) { const int v = u - 768; const int b = v / 96, rg = v % 16; h = (v / 16) % 6; tok0 = NTC + b * TL + rg * 256; r0 = rg * 4; local = true;
            kr_lo = min(max(r0 - 4, 0), 56); const int kr_hi = min(max(r0 + 3 - 4, 0), 56) + 8;
            s0 = AttnSeg{(const bf16*)(ws + WS_NACK) + ((size_t)(b * 2 + l) * 512) * 384 + h * 64, (const bf16*)(ws + WS_NACV) + ((size_t)(b * 2 + l) * 512) * 384 + h * 64, 384, 384, 8};
            const bf16* kb = PA + (size_t)(NTC + b * TL + kr_lo * 64) * LDA;
            s1 = AttnSeg{kb + CA_KN + h * 64, kb + CA_VN + h * 64, LDA, LDA, kr_hi - kr_lo};
        } else { const int v = u - 1728; const int b = v / 6; h = v % 6; tok0 = b * TC;
            const bf16* kb = PA + (size_t)tok0 * LDA;
            s0 = AttnSeg{kb + CA_KN + h * 64, kb + CA_VN + h * 64, LDA, LDA, 4};
            s1 = AttnSeg{s0.K, s0.V, LDA, LDA, 0}; }
        attn_unit<64, true>(lds, PA + (size_t)tok0 * LDA + CA_QN + h * 64, LDA, s0, s1, PA + (size_t)tok0 * LDA + CA_GN + h * 64, LDA, local, a.in[26] + (size_t)(l * 6 + h) * 15 * 31, r0, kr_lo, tid, dry);
    }
}

constexpr int SC_R = 0, SC_V = 4096, SC_NK = 8192, SC_W = 12288, SC_BB = 16384, SC_KD = 20480, SC_KC = 24576, SC_AA = 28672, SC_YB = 32768;
constexpr int SC_NT = 36864, SC_RT = SC_NT + 2176, SC_BT = SC_RT + 2176, SC_KT = SC_BT + 2176;
constexpr int SC_BHT = SC_KT + 2176, SC_KHT = SC_BHT + 2560, SC_VT = SC_KHT + 2560;
constexpr int SC_GC = SC_VT + 2560;
constexpr int SC_A1 = SC_GC + 256;
constexpr int SC_A2 = SC_A1 + 1024, SC_B1 = SC_A2 + 640, SC_B2 = SC_B1 + 640;
constexpr int SC_TW = SC_B2 + 640;
constexpr int SC_CW = SC_TW + 4 * 640;
constexpr int SC_YP = SC_CW + 12 * 256;
constexpr int SC_GC2 = SC_YP + 2048;
constexpr int SC_GX = SC_GC2 + 256;
constexpr int SCAN_SLOT = SC_GX + 1024;
static_assert(2 * SCAN_SLOT <= 131072, "scan LDS map");
__device__ __forceinline__ float dot4(f32x4 x, f32x4 y) { return (x[0] * y[0] + x[1] * y[1]) + (x[2] * y[2] + x[3] * y[3]); }
__device__ __forceinline__ f32x4 ldbf4(const bf16* p) { const u32x2 w = *(const u32x2*)p; return (f32x4){lo_f(w.x), hi_f(w.x), lo_f(w.y), hi_f(w.y)}; }
__device__ __forceinline__ f32x4 cvbf4(u32x2 w) { return (f32x4){lo_f(w.x), hi_f(w.x), lo_f(w.y), hi_f(w.y)}; }
__device__ __forceinline__ float tanh_f(float x) { return 1.f - 2.f * rcp_f(1.f + __expf(2.f * x)); }
__device__ __forceinline__ u32x2 pk4(f32x4 v) { u32x2 w; w.x = pk2(v[0], v[1]); w.y = pk2(v[2], v[3]); return w; }
__device__ __forceinline__ bf16x8 cat8(u32x2 lo, u32x2 hi) { u32x4 w; w.x = lo.x; w.y = lo.y; w.z = hi.x; w.w = hi.y; return __builtin_bit_cast(bf16x8, w); }
__device__ __forceinline__ f32x4 mfma16(bf16x8 x, bf16x8 y, f32x4 c) { return __builtin_amdgcn_mfma_f32_16x16x32_bf16(x, y, c, 0, 0, 0); }
__device__ __forceinline__ u32x2 lds8(LAS const unsigned char* p) { return *(LAS const u32x2*)p; }

__device__ __forceinline__ unsigned char* scan_yp(unsigned char* ws, int jobid) { return jobid < 704 ? ws + WS_YPA + (size_t)jobid * 32768 : ws + WS_YPB + (size_t)(jobid - 704) * 32768; }
__device__ __forceinline__ void scan_job(CArgs& a, int l, LAS unsigned char* slot, bool lat, int b, int d, int h, int c, int jt, int w4, int lane, int mode, int hw) {
    const bool PH1 = lat && c > 0;
    asm volatile("" : "+v"(jt), "+v"(lane));
    (void)mode;
    unsigned char* ws = a.ws;
    const int T = lat ? TL : TC, tokbase = lat ? NTC + b * TL : b * TC;
    const int chain = b * 8 + d * 4 + h;
    const bf16* PA = (const bf16*)(ws + WS_PA);
    const int g4 = lane >> 4, j16 = lane & 15;
    const int tokl = jt >> 4, cg = jt & 15;
    LAS float* fCW = (LAS float*)(slot + SC_CW);
    for (int i = jt; i < 12 * 64; i += 256) { const int rw = i >> 6, ch = i & 63; float v;
        if (rw < 9) v = a.in[14][(size_t)l * 3 * 768 + (rw % 3) * 768 + (rw / 3) * 256 + h * 64 + ch];
        else if (rw == 9) v = a.in[19][l * 256 + h * 64 + ch]; else if (rw == 10) v = a.in[20][l * 256 + h * 64 + ch]; else v = a.in[21][(l * 4 + h) * 64 + ch];
        fCW[i] = v; }
    const bf16* lora_w = (const bf16*)(ws + WS_LORA) + (size_t)(((l * 2 + 0) * 2 + d) * 256 + h * 64 + 16 * w4 + j16) * 64 + 8 * g4;
    const bf16* lora_a = (const bf16*)(ws + WS_LORA) + (size_t)(((l * 2 + 1) * 2 + d) * 256 + h * 64 + 16 * w4 + j16) * 64 + 8 * g4;
    const bf16x8 lw0 = ld8(lora_w), lw1 = ld8(lora_w + 32), la0 = ld8(lora_a), la1 = ld8(lora_a + 32);
    const float w0c = a.in[15][(l * 2 + d) * 256 + h * 64 + 16 * w4 + j16];
    const float a0c = a.in[17][(l * 2 + d) * 256 + h * 64 + 16 * w4 + j16];
    f32x4 S[4], P[4];
    {
        const float* src = nullptr;
        if (!PH1 && lat) src = a.in[2] + (size_t)((((b * 2 + l) * 2 + d) * 4 + h)) * 4096;
#pragma unroll
        for (int blk = 0; blk < 4; ++blk) {
            S[blk] = src ? *(const f32x4*)(src + (16 * w4 + j16) * 64 + 16 * blk + 4 * g4) : (f32x4){0.f, 0.f, 0.f, 0.f};
#pragma unroll
            for (int q = 0; q < 4; ++q) P[blk][q] = (PH1 && (16 * w4 + j16 == 16 * blk + 4 * g4 + q)) ? 1.f : 0.f;
        }
    }
    LAS float* fR = (LAS float*)(slot + SC_R); LAS float* fV = (LAS float*)(slot + SC_V); LAS float* fNK = (LAS float*)(slot + SC_NK); LAS float* fW = (LAS float*)(slot + SC_W);
    LAS float* fBB = (LAS float*)(slot + SC_BB); LAS float* fKD = (LAS float*)(slot + SC_KD); LAS float* fKC = (LAS float*)(slot + SC_KC); LAS float* fAA = (LAS float*)(slot + SC_AA);
    LAS float* fYB = (LAS float*)(slot + SC_YB); LAS float* fGC = (LAS float*)(slot + SC_GC); LAS float* fA1 = (LAS float*)(slot + SC_A1);
    LAS unsigned char* TWw = slot + SC_TW + w4 * 640;
    u32x2 q_r[3], q_k[3], q_v[3]; bf16x8 q_wd0, q_wd1, q_ad0, q_ad1;
    auto issue_loads = [&](int sub) {
        const int tau0 = c * SCAN_L + sub * 16;
        { const int tau = tau0 + tokl; const int t = d ? T - 1 - tau : tau; const bf16* row = PA + ((size_t)tokbase + t) * LDA + h * 64 + 4 * cg;
          const bool hp = t > 0, hn = t + 1 < T; const u32x2 z = (u32x2){0u, 0u};
          q_r[0] = hp ? *(const u32x2*)(row - LDA + CA_R) : z; q_r[1] = *(const u32x2*)(row + CA_R); q_r[2] = hn ? *(const u32x2*)(row + LDA + CA_R) : z;
          q_k[0] = hp ? *(const u32x2*)(row - LDA + CA_K) : z; q_k[1] = *(const u32x2*)(row + CA_K); q_k[2] = hn ? *(const u32x2*)(row + LDA + CA_K) : z;
          q_v[0] = hp ? *(const u32x2*)(row - LDA + CA_V) : z; q_v[1] = *(const u32x2*)(row + CA_V); q_v[2] = hn ? *(const u32x2*)(row + LDA + CA_V) : z; }
        { const int tau2 = tau0 + j16; const int t2 = d ? T - 1 - tau2 : tau2; const bf16* row2 = PA + ((size_t)tokbase + t2) * LDA;
          q_wd0 = ld8(row2 + CA_WD + 8 * g4); q_wd1 = ld8(row2 + CA_WD + 32 + 8 * g4); q_ad0 = ld8(row2 + CA_AD + 8 * g4); q_ad1 = ld8(row2 + CA_AD + 32 + 8 * g4); }
    };
    auto stage_a = [&](int sa) {
    {
#define CWR(rw) (*(LAS const f32x4*)(fCW + (rw) * 64 + 4 * cg))
        const f32x4 r_c = cvbf4(q_r[0]) * CWR(0) + cvbf4(q_r[1]) * CWR(1) + cvbf4(q_r[2]) * CWR(2);
        const f32x4 k_c = cvbf4(q_k[0]) * CWR(3) + cvbf4(q_k[1]) * CWR(4) + cvbf4(q_k[2]) * CWR(5);
        const f32x4 v_c = cvbf4(q_v[0]) * CWR(6) + cvbf4(q_v[1]) * CWR(7) + cvbf4(q_v[2]) * CWR(8);
        const f32x4 kk = k_c * CWR(9);
        float ss = dot4(kk, kk); ss = row16_sum(ss);
        const float inv = __builtin_amdgcn_rsqf(fmaxf(ss, 1e-24f));
        const int o = tokl * 64 + 4 * cg;
        *(LAS f32x4*)(fR + o) = r_c; *(LAS f32x4*)(fV + o) = v_c; *(LAS f32x4*)(fNK + o) = kk * (-inv); *(LAS f32x4*)(fKC + o) = k_c;
    }
    {
        f32x4 accw = (f32x4){0.f, 0.f, 0.f, 0.f}, acca = (f32x4){0.f, 0.f, 0.f, 0.f}; float dq[4];
        accw = mfma16(q_wd0, lw0, accw); accw = mfma16(q_wd1, lw1, accw);
        acca = mfma16(q_ad0, la0, acca); acca = mfma16(q_ad1, la1, acca);
#pragma unroll
        for (int q = 0; q < 4; ++q) {
            const float x = -(w0c + accw[q]);
            const float sp = fmaxf(x, 0.f) + __logf(1.f + __expf(-fabsf(x)));
            const float decay = __expf(-__expf(-sp - 0.5f));
            const float av = sigmoid_f(a0c + acca[q]);
            const int o = (4 * g4 + q) * 64 + 16 * w4 + j16;
            dq[q] = decay; fAA[o] = av;
        }
        dq[1] *= dq[0]; dq[2] *= dq[1]; dq[3] *= dq[2];
        LAS float* gx = (LAS float*)(slot + SC_GX + w4 * 256);
        gx[g4 * 16 + j16] = dq[3];
        LDS_WAIT();
        const float G0 = gx[j16], G1 = gx[16 + j16], G2 = gx[32 + j16], G3 = gx[48 + j16];
        const float E = g4 == 0 ? 1.f : (g4 == 1 ? G0 : (g4 == 2 ? G0 * G1 : G0 * G1 * G2));
#pragma unroll
        for (int q = 0; q < 4; ++q) fW[(4 * g4 + q) * 64 + 16 * w4 + j16] = E * dq[q];
        if (g4 == 0) ((LAS float*)(slot + ((sa & 1) ? SC_GC2 : SC_GC)))[16 * w4 + j16] = (G0 * G1) * (G2 * G3);
    }
    };
    auto flush_y = [&](int sf) {
        const int tauf = c * SCAN_L + sf * 16 + tokl; const int tf_ = d ? T - 1 - tauf : tauf; const size_t tokf = (size_t)tokbase + tf_;
        const f32x4 y4 = *(LAS const f32x4*)(fYB + tokl * 64 + 4 * cg);
        st4bf((bf16*)(ws + WS_Y) + tokf * 512 + d * 256 + h * 64 + 4 * cg, y4[0], y4[1], y4[2], y4[3]);
        if (PH1) *(u32x2*)(scan_yp(ws, chain * 15 + c - 1) + sf * 2048 + jt * 8) = *(LAS const u32x2*)(slot + SC_YP + jt * 8);
    };
    issue_loads(0);
    __syncthreads();
    stage_a(0);
    if (SCAN_L > 16) issue_loads(1);
#pragma unroll 1
    for (int sub = 0; sub < SCAN_L / 16; ++sub) {
        const int tau0 = c * SCAN_L + sub * 16;
        const int tau = tau0 + tokl; const int t = d ? T - 1 - tau : tau; const size_t tok = (size_t)tokbase + t;
        __syncthreads();
        if (sub > 0) flush_y(sub - 1);
        {
            const int o = tokl * 64 + 4 * cg;
            const f32x4 a4 = *(LAS const f32x4*)(fAA + o), nk4 = *(LAS const f32x4*)(fNK + o), kc4 = *(LAS const f32x4*)(fKC + o), r4 = *(LAS const f32x4*)(fR + o);
            const f32x4 bb = -(nk4 * a4);
            const f32x4 kd = kc4 * ((a4 - 1.0f) * CWR(10) + 1.0f);
            *(LAS f32x4*)(fBB + o) = bb; *(LAS f32x4*)(fKD + o) = kd;
            { float cf = dot4(r4 * kd, CWR(11)); cf = row16_sum(cf);
              if (cg == 0) ((float*)(ws + WS_CC))[(tok * 2 + d) * 4 + h] = cf; }
            const f32x4 gi = *(LAS const f32x4*)(fW + o);
            const f32x4 gm = tokl > 0 ? *(LAS const f32x4*)(fW + o - 64) : (f32x4){1.f, 1.f, 1.f, 1.f};
            const f32x4 ig = (f32x4){rcp_f(gi[0]), rcp_f(gi[1]), rcp_f(gi[2]), rcp_f(gi[3])};
            const int ob = (tokl * 68 + 4 * cg) * 2;
            *(LAS u32x2*)(slot + SC_NT + ob) = pk4(gm * nk4); *(LAS u32x2*)(slot + SC_RT + ob) = pk4(gi * r4);
            *(LAS u32x2*)(slot + SC_BT + ob) = pk4(bb * ig);  *(LAS u32x2*)(slot + SC_KT + ob) = pk4(kd * ig);
        }
        __syncthreads();
        {
            const int k = jt & 63, ig = jt >> 6;
            const float g = ((LAS const float*)(slot + ((sub & 1) ? SC_GC2 : SC_GC)))[k];
            f32x4 bh, kh, vt;
#pragma unroll
            for (int e = 0; e < 4; ++e) { const int i = 4 * ig + e; const float sc = g * rcp_f(fW[i * 64 + k]); bh[e] = fBB[i * 64 + k] * sc; kh[e] = fKD[i * 64 + k] * sc; vt[e] = fV[i * 64 + k]; }
            const int ob = (k * 20 + 4 * ig) * 2;
            *(LAS u32x2*)(slot + SC_BHT + ob) = pk4(bh); *(LAS u32x2*)(slot + SC_KHT + ob) = pk4(kh); *(LAS u32x2*)(slot + SC_VT + ob) = pk4(vt);
        }
        {
            const int pi = (w4 - hw) & 3;
            LAS const unsigned char* Xa = slot + ((pi < 2) ? SC_NT : SC_RT) + (j16 * 68 + 4 * g4) * 2;
            LAS const unsigned char* Yb = slot + ((pi & 1) ? SC_KT : SC_BT) + (j16 * 68 + 4 * g4) * 2;
            f32x4 acc = (f32x4){0.f, 0.f, 0.f, 0.f};
            acc = mfma16(cat8(lds8(Xa), lds8(Xa + 32)), cat8(lds8(Yb), lds8(Yb + 32)), acc);
            acc = mfma16(cat8(lds8(Xa + 64), lds8(Xa + 96)), cat8(lds8(Yb + 64), lds8(Yb + 96)), acc);
#pragma unroll
            for (int q = 0; q < 4; ++q) { const int i = 4 * g4 + q; const bool keep = (pi < 2) ? (j16 < i) : (j16 <= i); const float v = keep ? acc[q] : 0.f;
                if (pi == 0) fA1[i * 16 + j16] = v;
                else *(LAS unsigned short*)(slot + (pi == 1 ? SC_A2 : (pi == 2 ? SC_B1 : SC_B2)) + (i * 20 + j16) * 2) = (unsigned short)(pk2(v, 0.f) & 0xffffu); }
            if (pi == 0) {
                LDS_WAIT();
                const int cT = lane >> 2, pT = lane & 3;
                f32x4 ts = (f32x4){0.f, 0.f, 0.f, 0.f};
#pragma unroll
                for (int i = 0; i < 16; ++i) { const f32x4 a4 = *(LAS const f32x4*)(fA1 + i * 16 + 4 * pT);
                    float part = dot4(a4, ts); part += dpp_f<0xB1>(part); part += dpp_f<0x4E>(part);
                    const float tic = part + (i == cT ? 1.f : 0.f);
                    if (pT == (i >> 2)) ts[i & 3] = tic; }
#pragma unroll
                for (int e = 0; e < 4; ++e) *(LAS unsigned short*)(slot + SC_TW + ((4 * pT + e) * 20 + cT) * 2) = (unsigned short)(pk2(ts[e], 0.f) & 0xffffu);
            }
        }
        __syncthreads();
        {
            const u32x2 z2 = (u32x2){0u, 0u};
            LAS const unsigned char* ntp = slot + SC_NT + (j16 * 68 + 4 * g4) * 2;
            LAS const unsigned char* rtp = slot + SC_RT + (j16 * 68 + 4 * g4) * 2;
            const bf16x8 nta0 = cat8(lds8(ntp), lds8(ntp + 32)), nta1 = cat8(lds8(ntp + 64), lds8(ntp + 96));
            const bf16x8 rta0 = cat8(lds8(rtp), lds8(rtp + 32)), rta1 = cat8(lds8(rtp + 64), lds8(rtp + 96));
            const u32x2 vf = lds8(slot + SC_VT + ((16 * w4 + j16) * 20 + 4 * g4) * 2);
            const bf16x8 a2f = cat8(lds8(slot + SC_A2 + (j16 * 20 + 4 * g4) * 2), z2);
            const bf16x8 b12 = cat8(lds8(slot + SC_B1 + (j16 * 20 + 4 * g4) * 2), lds8(slot + SC_B2 + (j16 * 20 + 4 * g4) * 2));
            const bf16x8 tf = cat8(lds8(slot + SC_TW + (j16 * 20 + 4 * g4) * 2), z2);
            const f32x4 z4 = (f32x4){0.f, 0.f, 0.f, 0.f};
            f32x4 gc[4];
#pragma unroll
            for (int blk = 0; blk < 4; ++blk) gc[blk] = *(LAS const f32x4*)((LAS const float*)(slot + ((sub & 1) ? SC_GC2 : SC_GC)) + 16 * blk + 4 * g4);
            bf16x8 af[4];
#pragma unroll
            for (int blk = 0; blk < 4; ++blk) af[blk] = cat8(lds8(slot + SC_BHT + ((16 * blk + j16) * 20 + 4 * g4) * 2), lds8(slot + SC_KHT + ((16 * blk + j16) * 20 + 4 * g4) * 2));
            {
                const bf16x8 sb0 = cat8(pk4(S[0]), pk4(S[1])), sb1 = cat8(pk4(S[2]), pk4(S[3]));
                f32x4 X = mfma16(nta0, sb0, z4); X = mfma16(nta1, sb1, X); X = mfma16(a2f, cat8(vf, z2), X);
                const f32x4 Z = mfma16(tf, cat8(pk4(X), z2), z4);
                const bf16x8 zv = cat8(pk4(Z), vf);
#pragma unroll
                for (int blk = 0; blk < 4; ++blk) S[blk] = mfma16(af[blk], zv, S[blk] * gc[blk]);
                { f32x4 Y = mfma16(rta0, sb0, z4); Y = mfma16(rta1, sb1, Y); Y = mfma16(b12, zv, Y);
#pragma unroll
                  for (int q = 0; q < 4; ++q) fYB[(4 * g4 + q) * 64 + 16 * w4 + j16] = Y[q]; }
            }
            if (PH1) {
                const bf16x8 pb0 = cat8(pk4(P[0]), pk4(P[1])), pb1 = cat8(pk4(P[2]), pk4(P[3]));
                f32x4 X = mfma16(nta0, pb0, z4); X = mfma16(nta1, pb1, X);
                const f32x4 Z = mfma16(tf, cat8(pk4(X), z2), z4);
                const bf16x8 zp = cat8(pk4(Z), z2);
#pragma unroll
                for (int blk = 0; blk < 4; ++blk) P[blk] = mfma16(af[blk], zp, P[blk] * gc[blk]);
                f32x4 Yp = mfma16(rta0, pb0, z4); Yp = mfma16(rta1, pb1, Yp); Yp = mfma16(b12, zp, Yp);
#pragma unroll
                for (int q = 0; q < 4; ++q) *(LAS unsigned short*)(slot + SC_YP + ((4 * g4 + q) * 64 + 16 * w4 + j16) * 2) = (unsigned short)(pk2(Yp[q], 0.f) & 0xffffu);
            }
        }
        if (sub + 1 < SCAN_L / 16) { stage_a(sub + 1); if (sub + 2 < SCAN_L / 16) issue_loads(sub + 2); }
    }
    __syncthreads();
    flush_y(SCAN_L / 16 - 1);
    if (PH1) {
        if (c < 15) {
            float* Pg = (float*)(ws + WS_SCAN) + (size_t)(chain * 14 + c - 1) * 2 * 4096; float* Qg = Pg + 4096;
#pragma unroll
            for (int blk = 0; blk < 4; ++blk) { const int o = (16 * w4 + j16) * 64 + 16 * blk + 4 * g4; *(f32x4*)(Pg + o) = P[blk]; *(f32x4*)(Qg + o) = S[blk]; }
        }
    } else {
        float* st = lat ? (float*)(ws + WS_S1) + (size_t)chain * 4096 : a.out + OUT_STATE + (size_t)((((b * 2 + l) * 2 + d) * 4 + h)) * 4096;
#pragma unroll
        for (int blk = 0; blk < 4; ++blk) *(f32x4*)(st + (16 * w4 + j16) * 64 + 16 * blk + 4 * g4) = S[blk];
    }
}

__device__ __forceinline__ void phase_scan1(CArgs& a, int l, LAS unsigned char* lds, int vcu, int G, int tid, int wave, int lane, int mode) {
    const int hw = wave >> 2, w4 = wave & 3, jt = tid & 255;
    for (int p = vcu; p < 640; p += G) {
        const int jid = 2 * p + hw;
        if (jid < 1024) { const int chain = jid >> 4, c = jid & 15; scan_job(a, l, lds + hw * SCAN_SLOT, true, chain >> 3, (chain >> 2) & 1, chain & 3, c, jt, w4, lane, mode, hw); }
        else { const int chain = jid - 1024; scan_job(a, l, lds + hw * SCAN_SLOT, false, chain >> 3, (chain >> 2) & 1, chain & 3, 0, jt, w4, lane, mode, hw); }
        __syncthreads();
    }
}
__device__ __forceinline__ void phase_scan2(CArgs& a, int l, LAS unsigned char* lds, int vcu, int G, int tid) {
    for (int chain = vcu; chain < 64; chain += G) {
        LAS float* Sl = (LAS float*)lds;
        LAS float* Pl = (LAS float*)(lds + 20480);
        const int row = tid >> 3, jc = tid & 7;
        const float* s0 = (const float*)(a.ws + WS_S1) + (size_t)chain * 4096 + row * 64 + 8 * jc;
        __syncthreads();
#pragma unroll
        for (int q = 0; q < 8; ++q) Sl[row * 65 + 8 * jc + q] = s0[q];
        f32x4 p0, p1, o0, o1;
        { const float* Pg = (const float*)(a.ws + WS_SCAN) + (size_t)(chain * 14) * 2 * 4096; const float* Qg = Pg + 4096;
          p0 = *(const f32x4*)(Pg + tid * 8); p1 = *(const f32x4*)(Pg + tid * 8 + 4); o0 = *(const f32x4*)(Qg + row * 64 + 8 * jc); o1 = *(const f32x4*)(Qg + row * 64 + 8 * jc + 4); }
        for (int c = 0; c < 14; ++c) {
            float* Pg = (float*)(a.ws + WS_SCAN) + (size_t)(chain * 14 + c) * 2 * 4096; float* Qg = Pg + 4096;
            *(LAS f32x4*)(Pl + tid * 8) = p0; *(LAS f32x4*)(Pl + tid * 8 + 4) = p1;
            f32x4 a0 = o0, a1 = o1;
            if (c + 1 < 14) { const float* Pn = Pg + 2 * 4096; const float* Qn = Pn + 4096;
                p0 = *(const f32x4*)(Pn + tid * 8); p1 = *(const f32x4*)(Pn + tid * 8 + 4); o0 = *(const f32x4*)(Qn + row * 64 + 8 * jc); o1 = *(const f32x4*)(Qn + row * 64 + 8 * jc + 4); }
            __syncthreads();
#pragma unroll 8
            for (int k = 0; k < 64; ++k) { const float s = Sl[row * 65 + k]; a0 += *(LAS const f32x4*)(Pl + k * 64 + 8 * jc) * s; a1 += *(LAS const f32x4*)(Pl + k * 64 + 8 * jc + 4) * s; }
            __syncthreads();
#pragma unroll
            for (int q = 0; q < 4; ++q) { Sl[row * 65 + 8 * jc + q] = a0[q]; Sl[row * 65 + 8 * jc + 4 + q] = a1[q]; }
            *(f32x4*)(Qg + row * 64 + 8 * jc) = a0; *(f32x4*)(Qg + row * 64 + 8 * jc + 4) = a1;
        }
        __syncthreads();
    }
}
__device__ __forceinline__ void phase_scan3(CArgs& a, int l, LAS unsigned char* lds, int vcu, int G, int tid, int wave, int lane, int mode) {
    (void)mode; (void)l;
    const int hw = wave >> 2, w4 = wave & 3, jt = tid & 255, g4 = lane >> 4, j16 = lane & 15, tokl = jt >> 4, cg = jt & 15;
    unsigned char* ws = a.ws;
    LAS float* fYB = (LAS float*)(lds + hw * 16384);
    for (int p = vcu; p < 480; p += G) {
        const int jid = 2 * p + hw; const int chain = jid / 15, c = 1 + jid % 15;
        const int b = chain >> 3, d = (chain >> 2) & 1, h = chain & 3;
        const float* ss = c == 1 ? (const float*)(ws + WS_S1) + (size_t)chain * 4096 : (const float*)(ws + WS_SCAN) + ((size_t)(chain * 14 + c - 2) * 2 + 1) * 4096;
        f32x4 S[4];
#pragma unroll
        for (int blk = 0; blk < 4; ++blk) S[blk] = *(const f32x4*)(ss + (16 * w4 + j16) * 64 + 16 * blk + 4 * g4);
        const bf16x8 sb0 = cat8(pk4(S[0]), pk4(S[1])), sb1 = cat8(pk4(S[2]), pk4(S[3]));
        const unsigned char* yp = scan_yp(ws, jid);
        bf16* Y = (bf16*)(ws + WS_Y);
#pragma unroll 1
        for (int sg = 0; sg < SCAN_L / 64; ++sg) {
            bf16x8 ya[4][2];
#pragma unroll
            for (int u = 0; u < 4; ++u) { const unsigned char* yr = yp + (4 * sg + u) * 2048 + (j16 * 64 + 4 * g4) * 2;
                ya[u][0] = cat8(*(const u32x2*)yr, *(const u32x2*)(yr + 32)); ya[u][1] = cat8(*(const u32x2*)(yr + 64), *(const u32x2*)(yr + 96)); }
            f32x4 yl[4]; bf16* yptr[4];
#pragma unroll
            for (int u = 0; u < 4; ++u) { const int tau = c * SCAN_L + (4 * sg + u) * 16 + tokl; const int t = d ? TL - 1 - tau : tau; const size_t tok = (size_t)NTC + b * TL + t;
                yptr[u] = Y + tok * 512 + d * 256 + h * 64 + 4 * cg; yl[u] = ldbf4(yptr[u]); }
#pragma unroll
            for (int u = 0; u < 4; ++u) { f32x4 C = mfma16(ya[u][0], sb0, (f32x4){0.f, 0.f, 0.f, 0.f}); C = mfma16(ya[u][1], sb1, C);
#pragma unroll
                for (int q = 0; q < 4; ++q) fYB[u * 1024 + (4 * g4 + q) * 64 + 16 * w4 + j16] = C[q]; }
            __syncthreads();
#pragma unroll
            for (int u = 0; u < 4; ++u) { const f32x4 y4 = yl[u] + *(LAS const f32x4*)(fYB + u * 1024 + tokl * 64 + 4 * cg); st4bf(yptr[u], y4[0], y4[1], y4[2], y4[3]); }
            __syncthreads();
        }
    }
}
__device__ __forceinline__ void phase_finish(CArgs& a, int l, int vcu, int G, int wave, int lane, bool dry) {
    const int gw = vcu * 8 + wave, NGW = G * 8;
    bf16* PA = (bf16*)(a.ws + WS_PA);
    const bf16* Y = (const bf16*)(a.ws + WS_Y); const float* CC = (const float*)(a.ws + WS_CC);
    const f32x4 lnw = *(const f32x4*)(a.in[22] + l * 256 + 4 * lane), lnb = *(const f32x4*)(a.in[23] + l * 256 + 4 * lane);
    const float* cw = a.in[14] + (size_t)l * 3 * 768 + 512 + 4 * lane;
    const f32x4 c0 = *(const f32x4*)cw, c1 = *(const f32x4*)(cw + 768), c2 = *(const f32x4*)(cw + 1536);
    const int head = lane >> 4;
    for (int tok0 = gw; tok0 < NTOK; tok0 += 2 * NGW) {
        f32x4 vp[2], vc[2], vn[2], yf[2], yb[2], gg[2]; float cfa[2], cfb[2]; bf16* rowp[2]; bool ok[2];
#pragma unroll
        for (int u = 0; u < 2; ++u) {
            const int tok = tok0 + u * NGW; ok[u] = tok < NTOK; const int tk = ok[u] ? tok : tok0;
            int t, T; if (tk < NTC) { t = tk & 255; T = TC; } else { t = (tk - NTC) & 4095; T = TL; }
            bf16* row = PA + (size_t)tk * LDA; rowp[u] = row;
            const f32x4 z = (f32x4){0.f, 0.f, 0.f, 0.f};
            vp[u] = t > 0 ? ldbf4(row - LDA + CA_V + 4 * lane) : z; vc[u] = ldbf4(row + CA_V + 4 * lane); vn[u] = t + 1 < T ? ldbf4(row + LDA + CA_V + 4 * lane) : z;
            yf[u] = ldbf4(Y + (size_t)tk * 512 + 4 * lane); yb[u] = ldbf4(Y + (size_t)tk * 512 + 256 + 4 * lane);
            cfa[u] = CC[((size_t)tk * 2 + 0) * 4 + head]; cfb[u] = CC[((size_t)tk * 2 + 1) * 4 + head];
            gg[u] = ldbf4(row + CA_GR + 4 * lane);
        }
#pragma unroll
        for (int u = 0; u < 2; ++u) {
            const f32x4 v_c = vp[u] * c0 + vc[u] * c1 + vn[u] * c2;
            const f32x4 o = yf[u] + yb[u];
            const float mu = row16_sum((o[0] + o[1]) + (o[2] + o[3])) * (1.f / 64.f);
            const f32x4 dlt = o - mu;
            const float var = row16_sum(dot4(dlt, dlt)) * (1.f / 64.f);
            const float rs = __builtin_amdgcn_rsqf(var + GN_EPS);
            const f32x4 on = dlt * rs * lnw + lnb + v_c * (cfa[u] + cfb[u]);
            const f32x4 g = gg[u];
            if (dry) { asm volatile("" :: "v"(on), "v"(g)); continue; }
            if (ok[u]) st4bf(rowp[u] + CA_GR + 4 * lane, on[0] * silu_f(g[0]), on[1] * silu_f(g[1]), on[2] * silu_f(g[2]), on[3] * silu_f(g[3]));
        }
    }
}

constexpr int NWAVES = 8;
#ifndef OUT_STAGGER_TICKS
#define OUT_STAGGER_TICKS 0
#endif
constexpr int RING_BYTES = 131072, LDSCTL_OFF = RING_BYTES, LDS_BYTES = 147456;
constexpr int N_PHASES = 2 + 8 * 2 - 1;

__global__ void __launch_bounds__(NWAVES * 64, 2) mk_fwd(Args args_) {
    extern __shared__ __attribute__((aligned(16))) unsigned char lds_raw[];
    LAS unsigned char* lds = (LAS unsigned char*)lds_raw;
    const int tid0 = threadIdx.x;
    const int G = gridDim.x; const int bx0 = blockIdx.x;
    const int vcu0 = (G % 8 == 0) ? (bx0 % 8) * (G / 8) + bx0 / 8 : bx0;
#define PHASE_IDS CArgs* ap_ = (CArgs*)__builtin_amdgcn_kernarg_segment_ptr(); asm volatile("" : "+s"(ap_)); CArgs& args = *ap_; int tid = tid0; asm volatile("" : "+v"(tid)); int vcu = vcu0, bx = bx0; asm volatile("" : "+s"(vcu), "+s"(bx)); (void)bx; const int lane = tid & 63; const int wave = __builtin_amdgcn_readfirstlane(tid >> 6); (void)lane; (void)wave;
    volatile LAS unsigned* MISC = (volatile LAS unsigned*)(lds + LDSCTL_OFF);
    for (int u = tid0; u < (LDS_BYTES - LDSCTL_OFF) / 4; u += NWAVES * 64) ((LAS unsigned*)(lds + LDSCTL_OFF))[u] = 0u;
    __syncthreads();
    XcdBarrier bar; bar.bar = (unsigned*)(args_.ws + WS_CTL) + 4096; bar.x = 0; bar.st = nullptr;
    const bool multi = (args_.ph_hi - args_.ph_lo) > 1;
    if (multi) bar = xcd_barrier_post((unsigned*)(args_.ws + WS_CTL) + 4096, MISC + 8);
    const int lo = args_.ph_lo, hi = args_.ph_hi;
#ifndef PH_MASK
#define PH_MASK 0x3ff
#endif
#define PHB(k) ((k) < 2 ? (k) : 2 + (((k) - 2) & 7))
#define IN(k) (((PH_MASK >> PHB(k)) & 1) && lo <= (k) && (k) < hi)
#define SEAM(k) do { if (IN(k) && IN((k) + 1)) { XcdBarrier b2_ = bar; asm volatile("" : "+s"(b2_.bar)); xcd_barrier(b2_); if (PROBE_DUP == 16) { xcd_barrier(b2_); xcd_barrier(b2_); } } } while (0)

    const int ATT_MOVED_LO = 768, ATT_MOVED_HI = (G == 256) ? 768 + 384 + 256 : 768;
#define REPS(id) int reps_ = 1 + (PROBE_DUP == (id) ? 1 : 0); asm volatile("" : "+s"(reps_));
    if (IN(0)) { PHASE_IDS phase_p0a(args, lds, vcu, G, tid, wave, lane); } SEAM(0);
    if (IN(1)) { PHASE_IDS phase_l1_tables(args, vcu, G, tid, wave, lane); REPS(7) for (int rep = 0; rep < reps_; ++rep) phase_norm(args, 0, vcu, G, wave, lane); } SEAM(1);
#pragma unroll 1
    for (int L = 0; L < 2; ++L) {
        const int pb = 2 + 8 * L;
        if (IN(pb + 0)) { PHASE_IDS
            pg8::Gemm g{(const pg8::bf16_t*)(args.ws + WS_H), (const pg8::bf16_t*)(args.ws + WS_WIN) + (size_t)L * NPROJ * DM, NTOK, NPROJ, DM, DM};
            pg8::StaticOrder S; S.init(NTOK, NPROJ, G, bx);
            if (L == 0 || G != 256) {
                pg8::EpiProjT<false> E{ap_, nullptr, L};
                REPS(1) for (int rep = 0; rep < reps_; ++rep) pg8::gemm_phase<pg8::EpiProjT<false>, pg8::StaticOrder, false, true>(lds, g, S, E);
            } else {
                LAS float* T = (LAS float*)(lds + LDSCTL_OFF + 8192);
                pg8::Unit u0; (void)S.next(0, u0);
                const float* part = (const float*)(args.ws + WS_PART);
#pragma unroll 1
                for (int j = 0; j < 4; ++j) { const int pm = u0.pm + 8 * j;
                    if (tid == 0) ((LAS int*)T)[j] = pm < NTOK / 256 ? pm : -1;
                    if (pm < NTOK / 256 && tid < 256) { float s = 0.f;
#pragma unroll 8
                        for (int q = 0; q < 32; ++q) s += part[(size_t)q * NTOK + pm * 256 + tid];
                        T[64 + 256 * j + tid] = __builtin_amdgcn_rsqf(s * (1.f / 1024.f) + EPS); } }
                __syncthreads();
                pg8::EpiProjT<true> E{ap_, T, L};
                pg8::gemm_phase<pg8::EpiProjT<true>, pg8::StaticOrder, false, true>(lds, g, S, E);
            }
        } SEAM(pb + 0);
        if (IN(pb + 1)) { PHASE_IDS REPS(2) for (int rep = 0; rep < reps_; ++rep) phase_p2(args, L, lds, vcu, G, tid, wave, lane, rep + 1 < reps_); } SEAM(pb + 1);
        if (IN(pb + 2)) { PHASE_IDS
            { REPS(3) for (int rep = 0; rep < reps_; ++rep) phase_scan1(args, L, lds, vcu, G, tid, wave, lane, 0); }
            if (G == 256 && vcu >= 128) { for (int k = 0; k < 2; ++k) attn_dispatch(args, L, ATT_MOVED_LO + 384 + 2 * (vcu - 128) + k, lds, tid, 0); }
        } SEAM(pb + 2);
        if (IN(pb + 3)) { PHASE_IDS phase_scan2(args, L, lds, vcu, G, tid);
            if (G == 256 && vcu >= 64) { for (int k = 0; k < 2; ++k) attn_dispatch(args, L, ATT_MOVED_LO + 2 * (vcu - 64) + k, lds, tid, 0); } } SEAM(pb + 3);
        if (IN(pb + 4)) { PHASE_IDS
            { REPS(5) for (int rep = 0; rep < reps_; ++rep) phase_scan3(args, L, lds, vcu, G, tid, wave, lane, 0); }
            {
                unsigned* ctr = (unsigned*)(args.ws + WS_CTL) + 2048 + 64 * L; const int nrest = ATT_UNITS - ATT_MOVED_HI;
                for (int it = 0;; ++it) {
                    int u = vcu + it * G;
                    if (u >= 768) {
                        if (tid == 0) MISC[16] = __hip_atomic_fetch_add(ctr, 1u, __ATOMIC_RELAXED, __HIP_MEMORY_SCOPE_AGENT);
                        __syncthreads(); const int idx = (int)MISC[16]; __syncthreads();
                        if (idx >= nrest) break;
                        u = ATT_MOVED_HI + idx;
                    }
                    attn_dispatch(args, L, u, lds, tid, 0);
                } }
        } SEAM(pb + 4);
        if (IN(pb + 5)) { PHASE_IDS REPS(8) for (int rep = 0; rep < reps_; ++rep) phase_finish(args, L, vcu, G, wave, lane, rep + 1 < reps_); } SEAM(pb + 5);
        if (IN(pb + 6)) { PHASE_IDS (void)tid;
            pg8::Gemm g{(const pg8::bf16_t*)(args.ws + WS_PA), (const pg8::bf16_t*)(args.ws + WS_WOUT) + (size_t)L * DM * DM, NTOK, DM, DM, LDA};
            pg8::StaticOrder S; S.init(NTOK, DM, G, bx);
            if (G == 256) {
                pg8::HalfOrder S2{bx};
                if (L == 0) {
                    pg8::EpiOut0 E{args.in[0], args.in[1], args.out + OUT_Y, (const float*)(args.ws + WS_MOD), (const float*)(args.ws + WS_S1T), (pg8::bf16_t*)(args.ws + WS_H), (float*)(args.ws + WS_PART)};
                    pg8::gemm_phase<pg8::EpiOut0, pg8::HalfOrder, true, true>(lds, g, S2, E);
                } else {
                    pg8::EpiOut E{args.out + OUT_Y, args.out + OUT_Y + (size_t)NTC * DM, args.out + OUT_Y, (const float*)(args.ws + WS_MOD) + (size_t)9 * 3072};
                    pg8::gemm_phase<pg8::EpiOut, pg8::HalfOrder, true, true>(lds, g, S2, E);
                }
            } else {
                const float* x0 = L == 0 ? args.in[0] : args.out + OUT_Y; const float* x1 = L == 0 ? args.in[1] : args.out + OUT_Y + (size_t)NTC * DM;
                pg8::EpiOut E{x0, x1, args.out + OUT_Y, (const float*)(args.ws + WS_MOD) + (size_t)L * 9 * 3072};
                pg8::gemm_phase<pg8::EpiOut, pg8::StaticOrder, true, true>(lds, g, S, E);
            }
        } SEAM(pb + 6);
        if (L == 0 && G != 256) { if (IN(pb + 7)) { PHASE_IDS phase_norm(args, 1, vcu, G, wave, lane); } SEAM(pb + 7); }
    }
#undef IN
#undef SEAM
}

extern "C" void kernel_launch(void* const* d_in, const int* in_sizes, int n_in, void* d_out, int out_size, void* d_ws, size_t ws_size, hipStream_t stream) {
    static int grid = 0;
    if (grid == 0) {
        if (n_in != 34 || ws_size < WS_END) { fprintf(stderr, "kernel_launch: expected 34 inputs and >= %zu bytes of workspace (got %d, %zu)\n", (size_t)WS_END, n_in, ws_size); grid = -1; return; }
        int dev = 0, cus = 0;
        if (hipGetDevice(&dev) != hipSuccess || hipDeviceGetAttribute(&cus, hipDeviceAttributeMultiprocessorCount, dev) != hipSuccess) { grid = -1; return; }
        if (hipFuncSetAttribute((const void*)mk_fwd, hipFuncAttributeMaxDynamicSharedMemorySize, LDS_BYTES) != hipSuccess) { fprintf(stderr, "kernel_launch: hipFuncSetAttribute failed\n"); grid = -1; return; }
        int per_cu = 0;
        if (hipOccupancyMaxActiveBlocksPerMultiprocessor(&per_cu, (const void*)mk_fwd, NWAVES * 64, LDS_BYTES) != hipSuccess || per_cu < 1) fprintf(stderr, "kernel_launch: occupancy query reports %d\n", per_cu);
        (void)hipGetLastError();
        grid = cus;
    }
    if (grid < 0) return;
    (void)hipMemsetAsync((char*)d_ws + WS_CTL, 0, CTL_ZERO_BYTES, stream);
    Args a{};
    for (int i = 0; i < 34; ++i) a.in[i] = (const float*)d_in[i];
    a.out = (float*)d_out; a.ws = (unsigned char*)d_ws;
#if MK_ONE_LAUNCH
    a.ph_lo = 0; a.ph_hi = N_PHASES;
    hipLaunchKernelGGL(mk_fwd, dim3(grid), dim3(NWAVES * 64), LDS_BYTES, stream, a);
#else
    for (int p = 0; p < N_PHASES; ++p) { a.ph_lo = p; a.ph_hi = p + 1; hipLaunchKernelGGL(mk_fwd, dim3(grid), dim3(NWAVES * 64), LDS_BYTES, stream, a); }
#endif
}
```

```cpp
#include <hip/hip_runtime.h>
#include <cstdio>
#include <cstdint>

#ifndef PROBE_DUP
#define PROBE_DUP 0
#endif
#ifndef MK_ONE_LAUNCH
#define MK_ONE_LAUNCH 1
#endif

#define GAS __attribute__((address_space(1)))
#define LAS __attribute__((address_space(3)))
typedef unsigned short bf16;
typedef short bf16x8 __attribute__((ext_vector_type(8)));
typedef short s16x4 __attribute__((ext_vector_type(4)));
typedef float f32x2 __attribute__((ext_vector_type(2)));
typedef float f32x4 __attribute__((ext_vector_type(4)));
typedef float f32x16 __attribute__((ext_vector_type(16)));
typedef unsigned u32x2 __attribute__((ext_vector_type(2)));
typedef unsigned u32x4 __attribute__((ext_vector_type(4)));
typedef __bf16 bf16x2_t __attribute__((ext_vector_type(2)));

constexpr int DM = 1024;
constexpr int NTC = 8192, NTL = 32768, NTOK = 40960;
constexpr int TC = 256, TL = 4096;
constexpr int NPROJ = 3584;
constexpr int LDA = 3072, LDB = 512;
constexpr int CA_GR = 0, CA_GN = 256, CA_GM = 640, CA_R = 1024, CA_K = 1280, CA_V = 1536, CA_QN = 1792, CA_KN = 2176, CA_VN = 2560, CA_WD = 2944, CA_AD = 3008;
constexpr int CB_CQ = 0, CB_CKV = 256, CB_KR = 384;
constexpr float LOG2E = 1.4426950408889634f;
constexpr float EPS = 1e-6f, GN_EPS = 64e-5f;
constexpr float MLA_SCALE = 0.10206207261596575f;
constexpr int SCAN_L = 256;
constexpr int NCHUNK_L = TL / SCAN_L;

constexpr size_t MiB = 1u << 20;
constexpr size_t WS_CTL = 0, CTL_ZERO_BYTES = 1 * MiB;
constexpr size_t WS_MOD = 1 * MiB;
constexpr size_t WS_S1T = WS_MOD + 256 * 1024;
constexpr size_t WS_C1 = WS_MOD + 320 * 1024;
constexpr size_t WS_ABND = WS_MOD + 480 * 1024;
constexpr size_t WS_WIN = 2 * MiB;
constexpr size_t WS_WOUT = 16 * MiB;
constexpr size_t WS_WUQ = 20 * MiB;
constexpr size_t WS_WUKV = 21 * MiB;
constexpr size_t WS_LORA = 21 * MiB + 512 * 1024;
constexpr size_t WS_NACK = 22 * MiB, WS_NACV = 28 * MiB;
constexpr size_t WS_CK = 34 * MiB, WS_CV = 39 * MiB;
constexpr size_t WS_CC = 42 * MiB;
constexpr size_t WS_Q = 44 * MiB;
constexpr size_t WS_Y = 90 * MiB;
constexpr size_t WS_PART = WS_Y;
constexpr size_t WS_H = 130 * MiB;
constexpr size_t WS_MK = WS_H, WS_MV = WS_H + 45 * MiB;
constexpr size_t WS_PB = 210 * MiB;
constexpr size_t WS_SCAN = WS_PB;
constexpr size_t WS_PA = 250 * MiB;
constexpr size_t WS_S1 = WS_PB + 28 * MiB;
constexpr size_t WS_YPB = WS_PB + 29 * MiB;
constexpr size_t WS_YPA = 490 * MiB;
constexpr size_t WS_END = 512 * MiB;

constexpr size_t OUT_Y = 0, OUT_STATE = 41943040, OUT_NAK = 44040192, OUT_NAV = 50331648, OUT_CKV = 56623104, OUT_KROPE = 58720256;

struct Args { const float* in[34]; float* out; unsigned char* ws; int ph_lo, ph_hi; };
typedef const __attribute__((address_space(4))) Args CArgs;

__device__ __forceinline__ float bf2f(unsigned short b) { return __uint_as_float(((unsigned)b) << 16); }
__device__ __forceinline__ unsigned pk2(float lo, float hi) { f32x2 v = {lo, hi}; bf16x2_t b = __builtin_convertvector(v, bf16x2_t); return __builtin_bit_cast(unsigned, b); }
__device__ __forceinline__ float lo_f(unsigned u) { return __uint_as_float(u << 16); }
__device__ __forceinline__ float hi_f(unsigned u) { return __uint_as_float(u & 0xffff0000u); }
__device__ __forceinline__ int crow(int r, int hi) { return (r & 3) + 8 * (r >> 2) + 4 * hi; }
__device__ __forceinline__ float rcp_f(float x) { return __builtin_amdgcn_rcpf(x); }
__device__ __forceinline__ float silu_f(float x) { return x * rcp_f(1.f + __expf(-x)); }
__device__ __forceinline__ float sigmoid_f(float x) { return rcp_f(1.f + __expf(-x)); }
template <int CTRL> __device__ __forceinline__ float dpp_f(float x) { return __int_as_float(__builtin_amdgcn_update_dpp(0, __float_as_int(x), CTRL, 0xf, 0xf, true)); }
__device__ __forceinline__ float row16_sum(float x) { x += dpp_f<0xB1>(x); x += dpp_f<0x4E>(x); x += dpp_f<0x141>(x); x += dpp_f<0x140>(x); return x; }
__device__ __forceinline__ float xor32_sum(float x) { const auto r = __builtin_amdgcn_permlane32_swap(__float_as_uint(x), __float_as_uint(x), false, false); return __uint_as_float(r[0]) + __uint_as_float(r[1]); }
__device__ __forceinline__ float xor32_max(float x) { const auto r = __builtin_amdgcn_permlane32_swap(__float_as_uint(x), __float_as_uint(x), false, false); return fmaxf(__uint_as_float(r[0]), __uint_as_float(r[1])); }
__device__ __forceinline__ float wave64_sum(float x) { x = row16_sum(x); const auto r = __builtin_amdgcn_permlane16_swap(__float_as_uint(x), __float_as_uint(x), false, false); x = __uint_as_float(r[0]) + __uint_as_float(r[1]); return xor32_sum(x); }
__device__ __forceinline__ float ss8(bf16x8 v) { float s = 0.f;
#pragma unroll
    for (int j = 0; j < 8; ++j) { const float f = bf2f((unsigned short)v[j]); s += f * f; } return s; }
#define LDS_WAIT() asm volatile("s_waitcnt lgkmcnt(0)" ::: "memory")
#define VM_WAIT() asm volatile("s_waitcnt vmcnt(0)" ::: "memory")

__device__ __forceinline__ const float* x_row0(CArgs& a, int tok) { return tok < NTC ? a.in[0] + (size_t)tok * DM : a.in[1] + (size_t)(tok - NTC) * DM; }
__device__ __forceinline__ int mod_idx(int tok) { return tok < NTC ? 0 : 1 + ((tok - NTC) >> 12); }

namespace pg8 {
#define PG8_LAS __attribute__((address_space(3)))
typedef unsigned short bf16_t;
typedef short bf16x8 __attribute__((ext_vector_type(8)));
typedef float f32x4 __attribute__((ext_vector_type(4)));
typedef unsigned u32x4 __attribute__((ext_vector_type(4)));
constexpr int BM = 256, BK = 64, HALF = 128, HTB = HALF * BK * 2  , STAGE_BYTES = 8 * HTB, NXCD = 8, WGM = 8;

__host__ __device__ __forceinline__ int lds_byte(int r, int c) { const int st = (r >> 4) * 2 + (c >> 5), rr = r & 15, cc = c & 31, ob = rr * 64 + cc * 2; return st * 1024 + (ob ^ (((ob >> 9) & 1) << 5)); }
__host__ __device__ __forceinline__ void stage_rc(int b, int& R, int& C) { const int st = b / 1024, sb = b % 1024, swz = sb ^ (((sb >> 9) & 1) << 5); R = (st >> 1) * 16 + swz / 64; C = (st & 1) * 32 + (swz % 64) / 2; }
__host__ __device__ __forceinline__ int perm32(int rho) { const int n = rho >> 4, i = rho & 15; return 8 * (i >> 2) + 4 * n + (i & 3); }

struct Unit { int pm, pn, bh; };
struct Gemm { const bf16_t* A; const bf16_t* Bt; int M, N, K, lda; };

struct StaticOrder {
    int nM, nN, nwg, G, c;
    __host__ __device__ void init(int M, int N, int G_, int c_) { nM = M / BM; nN = N / BM; nwg = nM * nN; G = G_; c = c_; }
    __host__ __device__ __forceinline__ bool next(int i, Unit& u) const {
        u.bh = 0;
        const long L = (long)i * G + c; if (L >= nwg) return false;
        int wgid = (int)L; { const int q = nwg / NXCD, r = nwg % NXCD, xcd = wgid % NXCD, off = wgid / NXCD; wgid = (xcd < r ? xcd * (q + 1) : r * (q + 1) + (xcd - r) * q) + off; }
        const int nig = WGM * nN, gid = wgid / nig, fm = gid * WGM, gsz = (nM - fm) < WGM ? (nM - fm) : WGM;
        u.pm = fm + ((wgid % nig) % gsz); u.pn = (wgid % nig) / gsz; return true;
    }
    __device__ __forceinline__ void a_ready(const Unit&) const {}
    __device__ __forceinline__ void done(const Unit&) const {}
};

struct HalfOrder {
    int c;
    __host__ __device__ __forceinline__ bool next(int i, Unit& u) const {
        if (i > 2) return false;
        if (i == 2) { const int x = c % NXCD, j = c / NXCD; u.pm = 128 + 4 * x + (j & 3); u.pn = (j >> 2) & 3; u.bh = 1 + (j >> 4); return true; }
        const int L = i * 256 + c; const int wgid = (L % NXCD) * 64 + L / NXCD;
        u.pm = (wgid / 32) * WGM + (wgid % 32) % WGM; u.pn = (wgid % 32) / WGM; u.bh = 0; return true;
    }
    __device__ __forceinline__ void a_ready(const Unit&) const {}
    __device__ __forceinline__ void done(const Unit&) const {}
};
__device__ __forceinline__ unsigned cvt_pk_bf16(float lo, float hi) { unsigned r; asm volatile("v_cvt_pk_bf16_f32 %0, %1, %2" : "=v"(r) : "v"(lo), "v"(hi)); return r; }
struct EpiOut {
    static constexpr bool PERM = false, AFTER_DRAIN = false, PREFETCH = false;
    const float* x0; const float* x1; float* out; const float* mod;
#if PROBE_DUP == 26
    int live;
#endif
    __device__ __forceinline__ void operator()(const f32x4 (&acc)[2][2][4][2], const Unit& u, int wr, int wc, int fr, int fq) const {
#if PROBE_DUP == 26
        if (!live) return;
#endif
        const int rowt = u.pm * BM;
        const int mi = rowt < 8192 ? 0 : 1 + ((rowt - 8192) >> 12);
        const float* gate = mod + mi * 3072 + 2048;
        const int col0 = u.pn * BM + (u.bh == 2 ? HALF : 0) + wc * 32 + 4 * fq;
        const int nbj = u.bh ? 1 : 2;
        f32x4 gv[2][2];
#pragma unroll
        for (int bj = 0; bj < 2; ++bj)
#pragma unroll
            for (int n = 0; n < 2; ++n) gv[bj][n] = *(const f32x4*)(gate + col0 + bj * HALF + n * 16);
#pragma unroll
        for (int ai = 0; ai < 2; ++ai)
#pragma unroll
            for (int m = 0; m < 4; ++m) { const int row = rowt + ai * HALF + wr * 64 + m * 16 + fr;
                const float* xr = row < 8192 ? x0 + (size_t)row * 1024 : x1 + (size_t)(row - 8192) * 1024;
                float* orow = out + (size_t)row * 1024;
#pragma unroll
                for (int bj = 0; bj < 2; ++bj) { if (bj < nbj) {
#pragma unroll
                    for (int n = 0; n < 2; ++n) { const int c = col0 + bj * HALF + n * 16; const f32x4 xv = *(const f32x4*)(xr + c);
                        *(f32x4*)(orow + c) = xv + gv[bj][n] * acc[ai][bj][m][n]; } } } }
    }
};


__device__ __forceinline__ float fq_sum(float x) { const auto r = __builtin_amdgcn_permlane16_swap(__float_as_uint(x), __float_as_uint(x), false, false); x = __uint_as_float(r[0]) + __uint_as_float(r[1]);
    const auto q = __builtin_amdgcn_permlane32_swap(__float_as_uint(x), __float_as_uint(x), false, false); return __uint_as_float(q[0]) + __uint_as_float(q[1]); }
struct EpiOut0 {
    static constexpr bool PERM = true, AFTER_DRAIN = false;
    const float* x0; const float* x1; float* out; const float* mod;
    const float* s1; bf16_t* H; float* part;
    __device__ __forceinline__ void operator()(const f32x4 (&acc)[2][2][4][2], const Unit& u, int wr, int wc, int fr, int fq) const {
        const int rowt = u.pm * BM;
        const int mi = rowt < 8192 ? 0 : 1 + ((rowt - 8192) >> 12);
        const int colb = u.pn * BM + (u.bh == 2 ? HALF : 0) + wc * 32 + 8 * fq;
        const int nbj = u.bh ? 1 : 2;
        const float* gate = mod + mi * 3072 + 2048 + colb; const float* sv = s1 + mi * 1024 + colb;
        f32x4 gv[2][2];
#pragma unroll
        for (int bj = 0; bj < 2; ++bj) { if (bj < nbj) {
#pragma unroll
            for (int n = 0; n < 2; ++n) gv[bj][n] = *(const f32x4*)(gate + bj * HALF + 4 * n); } }
        const int slot = u.pn * 8 + (u.bh == 2 ? 4 : 0) + wc;
        float* pslot = part + (size_t)slot * 40960;
#pragma unroll
        for (int ai = 0; ai < 2; ++ai)
#pragma unroll
            for (int m = 0; m < 4; ++m) { const int row = rowt + ai * HALF + wr * 64 + m * 16 + fr;
                const float* xr = (row < 8192 ? x0 + (size_t)row * 1024 : x1 + (size_t)(row - 8192) * 1024) + colb;
                float* orow = out + (size_t)row * 1024 + colb; bf16_t* hrow = H + (size_t)row * 1024 + colb;
                float s = 0.f;
#pragma unroll
                for (int bj = 0; bj < 2; ++bj) { if (bj < nbj) {
                    const f32x4 y0 = *(const f32x4*)(xr + bj * HALF) + gv[bj][0] * acc[ai][bj][m][0], y1 = *(const f32x4*)(xr + bj * HALF + 4) + gv[bj][1] * acc[ai][bj][m][1];
                    *(f32x4*)(orow + bj * HALF) = y0; *(f32x4*)(orow + bj * HALF + 4) = y1;
                    s += ((y0[0] * y0[0] + y0[1] * y0[1]) + (y0[2] * y0[2] + y0[3] * y0[3])) + ((y1[0] * y1[0] + y1[1] * y1[1]) + (y1[2] * y1[2] + y1[3] * y1[3]));
                    const f32x4 a0 = y0 * *(const f32x4*)(sv + bj * HALF), a1 = y1 * *(const f32x4*)(sv + bj * HALF + 4);
                    u32x4 w; w.x = cvt_pk_bf16(a0[0], a0[1]); w.y = cvt_pk_bf16(a0[2], a0[3]); w.z = cvt_pk_bf16(a1[0], a1[1]); w.w = cvt_pk_bf16(a1[2], a1[3]);
                    *(u32x4*)(hrow + bj * HALF) = w; } }
                const float t = fq_sum(s);
                if (fq == 0) { pslot[row] = t; if (u.bh == 0) pslot[4 * 40960 + row] = 0.f; } }
    }
};
template <bool L1>
struct EpiProjT {
    static constexpr bool PERM = true, AFTER_DRAIN = false;
    CArgs* ap; PG8_LAS const float* T; int l;
    __device__ __forceinline__ void operator()(const f32x4 (&acc)[2][2][4][2], const Unit& u, int wr, int wc, int fr, int fq) const {
        CArgs* ap_ = ap; asm volatile("" : "+s"(ap_)); CArgs& a = *ap_;
        bf16_t* PA = (bf16_t*)(a.ws + WS_PA); bf16_t* PB = (bf16_t*)(a.ws + WS_PB); const float* c1 = (const float*)(a.ws + WS_C1);
        const float* qw = a.in[24] + l * 64; const float* kw = a.in[25] + l * 64; float* nak = a.out + OUT_NAK; float* nav = a.out + OUT_NAV;
        const int rowt = u.pm * BM; const int row0 = rowt + wr * 64 + fr;
        const int col0 = wc * 32 + 8 * fq;
        f32x4 cv[2][2]; const PG8_LAS float* rs = T;
        if constexpr (L1) {
            const int mi = rowt < 8192 ? 0 : 1 + ((rowt - 8192) >> 12);
            const PG8_LAS int* Tp = (const PG8_LAS int*)T;
            const int j = (u.pm == Tp[1]) ? 1 : ((u.pm == Tp[2]) ? 2 : ((u.pm == Tp[3]) ? 3 : 0));
            rs = T + 64 + 256 * j + wr * 64 + fr;
            const float* cp = c1 + mi * 3584 + u.pn * 256 + col0;
#pragma unroll
            for (int bj = 0; bj < 2; ++bj)
#pragma unroll
                for (int n = 0; n < 2; ++n) cv[bj][n] = *(const f32x4*)(cp + bj * HALF + 4 * n);
        }
        const bool ctx = rowt < 8192;
        if (u.pn >= 7 && u.pn <= 9) {
            const int hq = 4 * (u.pn - 7) + wc; const bool isq = hq < 6;
            const float* gwp = (isq ? qw : kw) + 8 * fq; const float sc0 = isq ? 0.125f * 1.4426950408889634f : 1.0f;
            f32x4 gv[2][2];
#pragma unroll
            for (int bj = 0; bj < 2; ++bj)
#pragma unroll
                for (int n = 0; n < 2; ++n) gv[bj][n] = *(const f32x4*)(gwp + 32 * bj + 4 * n) * sc0;
            const int ncol = 1792 + 64 * hq + 8 * fq;
#pragma unroll
            for (int ai = 0; ai < 2; ++ai)
#pragma unroll
                for (int m = 0; m < 4; ++m) { const int row = row0 + ai * HALF + m * 16;
                    f32x4 v[2][2]; float ss = 0.f;
#pragma unroll
                    for (int bj = 0; bj < 2; ++bj)
#pragma unroll
                        for (int n = 0; n < 2; ++n) { f32x4 x = acc[ai][bj][m][n]; if constexpr (L1) x = x * rs[ai * HALF + m * 16] + cv[bj][n];
                            v[bj][n] = x; ss += (x[0] * x[0] + x[1] * x[1]) + (x[2] * x[2] + x[3] * x[3]); }
                    ss = fq_sum(ss);
                    const float r = __builtin_amdgcn_rsqf(ss * (1.f / 64.f) + 1e-6f);
                    bf16_t* rowp = PA + (size_t)row * 3072 + ncol;
                    float* kc = nak + ((size_t)((row >> 8) * 2 + l) * 256 + (row & 255)) * 384 + (hq - 6) * 64 + 8 * fq;
#pragma unroll
                    for (int bj = 0; bj < 2; ++bj) { const f32x4 o0 = v[bj][0] * r * gv[bj][0], o1 = v[bj][1] * r * gv[bj][1];
                        u32x4 w; w.x = cvt_pk_bf16(o0[0], o0[1]); w.y = cvt_pk_bf16(o0[2], o0[3]); w.z = cvt_pk_bf16(o1[0], o1[1]); w.w = cvt_pk_bf16(o1[2], o1[3]);
                        *(u32x4*)(rowp + 32 * bj) = w;
                        if (ctx && !isq) { *(f32x4*)(kc + 32 * bj) = o0; *(f32x4*)(kc + 32 * bj + 4) = o1; } } }
            return;
        }
        bf16_t* base; int ldc;
        if (u.pn < 12) { base = PA + u.pn * 256; ldc = 3072; } else { base = PB + (u.pn - 12) * 256; ldc = 512; }
        const bool vtile = ctx && (u.pn == 10 || u.pn == 11);
        const bool wdt = u.pn == 11 && wc < 2;
#pragma unroll
        for (int ai = 0; ai < 2; ++ai)
#pragma unroll
            for (int m = 0; m < 4; ++m) { const int row = row0 + ai * HALF + m * 16; bf16_t* rowp = base + (size_t)row * ldc + col0;
                float* vc = nav + ((size_t)((row >> 8) * 2 + l) * 256 + (row & 255)) * 384 + (u.pn - 10) * 256 + col0;
#pragma unroll
                for (int bj = 0; bj < 2; ++bj) { f32x4 v0 = acc[ai][bj][m][0], v1 = acc[ai][bj][m][1];
                    if constexpr (L1) { const float r = rs[ai * HALF + m * 16]; v0 = v0 * r + cv[bj][0]; v1 = v1 * r + cv[bj][1]; }
                    if (wdt && bj == 1) {
#pragma unroll
                        for (int i = 0; i < 4; ++i) { v0[i] = 1.f - 2.f * __builtin_amdgcn_rcpf(1.f + __expf(2.f * v0[i])); v1[i] = 1.f - 2.f * __builtin_amdgcn_rcpf(1.f + __expf(2.f * v1[i])); } }
                    u32x4 w; w.x = cvt_pk_bf16(v0[0], v0[1]); w.y = cvt_pk_bf16(v0[2], v0[3]); w.z = cvt_pk_bf16(v1[0], v1[1]); w.w = cvt_pk_bf16(v1[2], v1[3]);
                    *(u32x4*)(rowp + bj * HALF) = w;
                    if (vtile && (u.pn == 10 || bj == 0)) { *(f32x4*)(vc + bj * HALF) = v0; *(f32x4*)(vc + bj * HALF + 4) = v1; } } }
    }
};
template <class Epi, class Sched, bool ALIGN_EPI = false, bool SP2 = false>
__device__ __forceinline__ void gemm_phase(PG8_LAS unsigned char* lds, const Gemm g, const Sched& S, const Epi& E) {
    int tid_ = threadIdx.x; asm volatile("" : "+v"(tid_));
    const int tid = tid_, wid = __builtin_amdgcn_readfirstlane(tid >> 6), lane = tid & 63, wr = wid >> 2, wc = wid & 3, fr = lane & 15, fq = lane >> 4;
    const int K = g.K, nt = K / BK;
    unsigned voffA[2], voffB[2];
#pragma unroll
    for (int i = 0; i < 2; ++i) { int R, C; stage_rc(tid * 16 + i * 8192, R, C); const int Rb = Epi::PERM ? ((R & ~31) + perm32(R & 31)) : R;
        voffA[i] = (unsigned)(R * g.lda + C) * 2u; voffB[i] = (unsigned)(Rb * K + C) * 2u; }
    const size_t kstep = (size_t)(BK * 2);
    const size_t hstepA = (size_t)HALF * g.lda * 2, hstepB = (size_t)HALF * K * 2;
    const size_t tstepA = 2 * hstepA, tstepB = 2 * hstepB;
    const unsigned ldsw = (unsigned)wid * 1024u;
    const int aoff = lds_byte(wr * 64 + fr, fq * 8), boff = lds_byte(wc * 32 + fr, fq * 8);
#define PG8_SA(b, h) (((b) * 2 + (h)) * HTB)
#define PG8_SB(b, h) ((4 + (b) * 2 + (h)) * HTB)
#define PG8_STAGE(bufoff, gbase, voff) do { _Pragma("unroll") for (int _i = 0; _i < 2; ++_i) \
        __builtin_amdgcn_global_load_lds((const unsigned*)((const char*)(gbase) + (voff)[_i]), (PG8_LAS unsigned*)(lds + (bufoff) + ldsw + _i * 8192), 16, 0, 0); } while (0)
#define PG8_LDA(dst, b, h) do { _Pragma("unroll") for (int m = 0; m < 4; ++m) _Pragma("unroll") for (int k = 0; k < 2; ++k) dst[m][k] = *(const PG8_LAS bf16x8*)(lds + PG8_SA(b, h) + aoff + m * 2048 + k * 1024); } while (0)
#define PG8_LDB(dst, b, h) do { _Pragma("unroll") for (int n = 0; n < 2; ++n) _Pragma("unroll") for (int k = 0; k < 2; ++k) dst[n][k] = *(const PG8_LAS bf16x8*)(lds + PG8_SB(b, h) + boff + n * 2048 + k * 1024); } while (0)
#define PG8_MMA(ai, bj, At, Bt) do { __builtin_amdgcn_s_setprio(1); _Pragma("unroll") for (int m = 0; m < 4; ++m) _Pragma("unroll") for (int n = 0; n < 2; ++n) _Pragma("unroll") for (int k = 0; k < 2; ++k) \
        acc[ai][bj][m][n] = __builtin_amdgcn_mfma_f32_16x16x32_bf16(Bt[n][k], At[m][k], acc[ai][bj][m][n], 0, 0, 0); __builtin_amdgcn_s_setprio(0); } while (0)
#define PG8_WAIT_V(n) asm volatile("s_waitcnt vmcnt(" #n ")" ::: "memory")
#define PG8_WAIT_L(n) asm volatile("s_waitcnt lgkmcnt(" #n ")" ::: "memory")
#define PG8_BAR __builtin_amdgcn_s_barrier()
#define PG8_SCHED __builtin_amdgcn_sched_barrier(0)
    Unit cur, nxt; int ui = 0;
    if (!S.next(0, cur)) return;
    f32x4 acc[2][2][4][2];
#pragma unroll
    for (int a = 0; a < 2; ++a)
#pragma unroll
        for (int b = 0; b < 2; ++b)
#pragma unroll
            for (int m = 0; m < 4; ++m)
#pragma unroll
                for (int n = 0; n < 2; ++n) acc[a][b][m][n] = (f32x4){0.f, 0.f, 0.f, 0.f};
    bf16x8 At[4][2], B0[2][2], B1[2][2];
    const char* cA = (const char*)g.A + (size_t)cur.pm * tstepA; const char* cB = (const char*)g.Bt + (size_t)cur.pn * tstepB + (cur.bh == 2 ? hstepB : (size_t)0);
    S.a_ready(cur);
    if constexpr (SP2) {
        PG8_STAGE(PG8_SB(0, 0), cB, voffB); PG8_STAGE(PG8_SB(0, 1), cB + hstepB, voffB); PG8_STAGE(PG8_SA(0, 0), cA, voffA); PG8_STAGE(PG8_SA(0, 1), cA + hstepA, voffA);
        if (wr == 1) PG8_BAR;
        PG8_WAIT_V(2); PG8_BAR;
        PG8_STAGE(PG8_SB(1, 0), cB + kstep, voffB); PG8_STAGE(PG8_SA(1, 0), cA + kstep, voffA); PG8_STAGE(PG8_SB(1, 1), cB + hstepB + kstep, voffB);
        PG8_WAIT_V(6); PG8_BAR;
    } else {
        PG8_STAGE(PG8_SB(0, 0), cB, voffB); PG8_STAGE(PG8_SA(0, 0), cA, voffA); PG8_STAGE(PG8_SB(0, 1), cB + hstepB, voffB); PG8_STAGE(PG8_SA(0, 1), cA + hstepA, voffA);
        if (wr == 1) PG8_BAR;
        PG8_WAIT_V(4); PG8_BAR;
        PG8_STAGE(PG8_SB(1, 0), cB + kstep, voffB); PG8_STAGE(PG8_SA(1, 0), cA + kstep, voffA); PG8_STAGE(PG8_SB(1, 1), cB + hstepB + kstep, voffB);
        PG8_WAIT_V(6); PG8_BAR;
    }
    for (;;) {
        const bool has_next = S.next(ui + 1, nxt);
        const char* nA = has_next ? (const char*)g.A + (size_t)nxt.pm * tstepA : cA; const char* nB = has_next ? (const char*)g.Bt + (size_t)nxt.pn * tstepB + (nxt.bh == 2 ? hstepB : (size_t)0) : cB;
        const bool full = cur.bh == 0;
        for (int t = 0; t < nt; t += 2) {
            const bool last = (t == nt - 2);
            const char* a1 = cA + (size_t)(t + 1) * kstep;
            const char* a2 = last ? nA : cA + (size_t)(t + 2) * kstep; const char* b2 = last ? nB : cB + (size_t)(t + 2) * kstep;
            const char* a3 = a2 + kstep; const char* b3 = b2 + kstep;
            if (last && has_next) S.a_ready(nxt);
            if constexpr (SP2) {
            PG8_LDB(B0, 0, 0); PG8_LDB(B1, 0, 1); PG8_SCHED; PG8_LDA(At, 0, 0); PG8_STAGE(PG8_SA(1, 1), a1 + hstepA, voffA);
            PG8_WAIT_V(8); PG8_WAIT_L(0); PG8_BAR; PG8_MMA(0, 0, At, B0); if (full) PG8_MMA(0, 1, At, B1); PG8_BAR; PG8_SCHED;
            PG8_LDA(At, 0, 1); PG8_STAGE(PG8_SB(0, 0), b2, voffB); PG8_STAGE(PG8_SB(0, 1), b2 + hstepB, voffB); PG8_STAGE(PG8_SA(0, 0), a2, voffA);
            PG8_WAIT_V(8); PG8_WAIT_L(0); PG8_BAR; PG8_MMA(1, 0, At, B0); if (full) PG8_MMA(1, 1, At, B1); PG8_BAR; PG8_SCHED;
            PG8_LDB(B0, 1, 0); PG8_LDB(B1, 1, 1); PG8_SCHED; PG8_LDA(At, 1, 0); PG8_STAGE(PG8_SA(0, 1), a2 + hstepA, voffA);
            PG8_WAIT_V(8); PG8_WAIT_L(0); PG8_BAR; PG8_MMA(0, 0, At, B0); if (full) PG8_MMA(0, 1, At, B1); PG8_BAR; PG8_SCHED;
            PG8_LDA(At, 1, 1); PG8_STAGE(PG8_SB(1, 0), b3, voffB); PG8_STAGE(PG8_SB(1, 1), b3 + hstepB, voffB); PG8_STAGE(PG8_SA(1, 0), a3, voffA);
            PG8_WAIT_V(8); PG8_WAIT_L(0); PG8_BAR; PG8_MMA(1, 0, At, B0); if (full) PG8_MMA(1, 1, At, B1); PG8_BAR; PG8_SCHED;
            } else {
            PG8_LDB(B0, 0, 0); PG8_SCHED; PG8_LDA(At, 0, 0); PG8_STAGE(PG8_SA(1, 1), a1 + hstepA, voffA);
            PG8_WAIT_L(8); PG8_BAR; PG8_WAIT_L(0); PG8_MMA(0, 0, At, B0); PG8_BAR; PG8_SCHED;
            PG8_LDB(B1, 0, 1); PG8_STAGE(PG8_SB(0, 0), b2, voffB);
            PG8_BAR; PG8_WAIT_L(0); PG8_MMA(0, 1, At, B1); PG8_BAR;
            PG8_LDA(At, 0, 1); PG8_STAGE(PG8_SA(0, 0), a2, voffA);
            PG8_BAR; PG8_WAIT_L(0); PG8_MMA(1, 0, At, B0); PG8_BAR; PG8_SCHED;
            PG8_STAGE(PG8_SB(0, 1), b2 + hstepB, voffB);
            PG8_WAIT_V(6); PG8_BAR; PG8_MMA(1, 1, At, B1); PG8_BAR;
            PG8_LDB(B0, 1, 0); PG8_SCHED; PG8_LDA(At, 1, 0); PG8_STAGE(PG8_SA(0, 1), a2 + hstepA, voffA);
            PG8_WAIT_L(8); PG8_BAR; PG8_WAIT_L(0); PG8_MMA(0, 0, At, B0); PG8_BAR; PG8_SCHED;
            PG8_LDB(B1, 1, 1); PG8_STAGE(PG8_SB(1, 0), b3, voffB);
            PG8_BAR; PG8_WAIT_L(0); PG8_MMA(0, 1, At, B1); PG8_BAR;
            PG8_LDA(At, 1, 1); PG8_STAGE(PG8_SA(1, 0), a3, voffA);
            PG8_BAR; PG8_WAIT_L(0); PG8_MMA(1, 0, At, B0); PG8_BAR; PG8_SCHED;
            PG8_STAGE(PG8_SB(1, 1), b3 + hstepB, voffB);
            PG8_WAIT_V(6); PG8_BAR; PG8_MMA(1, 1, At, B1); PG8_BAR;
            }
        }
        if constexpr (ALIGN_EPI) { if (wr == 0) PG8_BAR; }
        if constexpr (!Epi::AFTER_DRAIN) { E(acc, cur, wr, wc, fr, fq); S.done(cur); }
        if (!has_next) break;
#pragma unroll
        for (int a = 0; a < 2; ++a)
#pragma unroll
            for (int b = 0; b < 2; ++b)
#pragma unroll
                for (int m = 0; m < 4; ++m)
#pragma unroll
                    for (int n = 0; n < 2; ++n) acc[a][b][m][n] = (f32x4){0.f, 0.f, 0.f, 0.f};
        cur = nxt; cA = nA; cB = nB; ++ui;
        if constexpr (ALIGN_EPI) { if (wr == 1) PG8_BAR; }
    }
    PG8_WAIT_V(0);
    if constexpr (!ALIGN_EPI) { if (wr == 0) PG8_BAR; }
    PG8_BAR;
    if constexpr (Epi::AFTER_DRAIN) { E.fused(acc, cur, wr, wc, fr, fq, lds, wid, lane); S.done(cur); }
#undef PG8_SA
#undef PG8_SB
#undef PG8_STAGE
#undef PG8_LDA
#undef PG8_LDB
#undef PG8_MMA
#undef PG8_WAIT_V
#undef PG8_WAIT_L
#undef PG8_BAR
#undef PG8_SCHED
}
}
#define XB_TMO      128
#define XB_XCNT(j)  (256  + 64 * (j))
#define XB_XSUB(j)  (1280 + 64 * (j))
#define XB_XGEN(j)  (2304 + 64 * (j))
#define XB_TOP      3328
#define XB_TOPGEN   3392
#define XCD_BAR_WORDS 3456
#define XB_SPIN_CAP (1u << 18)

__device__ __forceinline__ unsigned xb_ld(unsigned* p)              { return __hip_atomic_load(p, __ATOMIC_RELAXED, __HIP_MEMORY_SCOPE_AGENT); }
__device__ __forceinline__ unsigned xb_add(unsigned* p, unsigned v) { return __hip_atomic_fetch_add(p, v, __ATOMIC_RELAXED, __HIP_MEMORY_SCOPE_AGENT); }
__device__ __forceinline__ unsigned xb_xcc_id() { return (unsigned)__builtin_amdgcn_s_getreg((3 << 11) | 20) & 0xFu; }
#define XB_SPIN(cond, bar) do { unsigned _sp = 0; while (cond) { __builtin_amdgcn_s_sleep(1); \
    if ((++_sp & 255u) == 0u) { if (xb_ld(&(bar)[XB_TMO])) break; if (_sp > XB_SPIN_CAP) { atomicAdd(&(bar)[XB_TMO], 1u); break; } } } } while (0)

struct XcdBarrier {
    unsigned* bar; unsigned x;
    volatile LAS unsigned* st;
};

__device__ __forceinline__ XcdBarrier xcd_barrier_post(unsigned* bar, volatile LAS unsigned* st) {
    XcdBarrier b; b.bar = bar; b.x = xb_xcc_id(); b.st = st;
    if (threadIdx.x == 0) (void)xb_add(&bar[XB_XCNT(b.x)], 1u);
    return b;
}
__device__ __forceinline__ void xcd_barrier_complete(unsigned* bar, unsigned x, unsigned& nloc, unsigned& nx) {
    const unsigned G = gridDim.x * gridDim.y * gridDim.z;
    unsigned sum, cnt, mine, sp = 0u;
    for (;;) {
        sum = 0u; cnt = 0u; mine = 0u;
#pragma unroll
        for (unsigned j = 0; j < 16; ++j) { const unsigned c = xb_ld(&bar[XB_XCNT(j)]); sum += c; cnt += (c > 0u) ? 1u : 0u; mine = (j == x) ? c : mine; }
        if (sum == G) break;
        __builtin_amdgcn_s_sleep(1);
        if ((++sp & 255u) == 0u) { if (xb_ld(&bar[XB_TMO])) break; if (sp > XB_SPIN_CAP) { atomicAdd(&bar[XB_TMO], 1u); break; } }
    }
    nloc = mine > 0u ? mine : 1u; nx = cnt > 0u ? cnt : 1u;
}

__device__ __forceinline__ void xcd_barrier(const XcdBarrier& b) {
    asm volatile("s_waitcnt vmcnt(0)" ::: "memory");
    __syncthreads();
    if (threadIdx.x == 0) {
        unsigned* bar = b.bar;
        __builtin_amdgcn_s_waitcnt(0);
        unsigned nloc = b.st[0], nx = b.st[1];
        if (nloc == 0u) { xcd_barrier_complete(bar, b.x, nloc, nx); b.st[0] = nloc; b.st[1] = nx; }
        const unsigned old = xb_add(&bar[XB_XSUB(b.x)], 1u);
        const unsigned gen = old / nloc;
        if (old + 1u == (gen + 1u) * nloc) {
            __builtin_amdgcn_fence(__ATOMIC_RELEASE, "agent");
            asm volatile("s_waitcnt vmcnt(0)" ::: "memory");
            const unsigned og = xb_add(&bar[XB_TOP], 1u);
            const unsigned tg = og / nx;
            if (og + 1u == (tg + 1u) * nx) xb_add(&bar[XB_TOPGEN], 1u);
            else XB_SPIN(xb_ld(&bar[XB_TOPGEN]) == tg, bar);
            __builtin_amdgcn_fence(__ATOMIC_ACQUIRE, "agent");
            xb_add(&bar[XB_XGEN(b.x)], 1u);
            asm volatile("s_waitcnt vmcnt(0)" ::: "memory");
        } else {
            XB_SPIN(xb_ld(&bar[XB_XGEN(b.x)]) == gen, bar);
            __builtin_amdgcn_fence(__ATOMIC_ACQUIRE, "agent");
            asm volatile("s_waitcnt vmcnt(0)" ::: "memory");
        }
    }
    __syncthreads();
}


__device__ __forceinline__ int win_src_col(int n) {
    if (n < 256) return 896 + n;
    if (n < 640) return 2304 + (n - 256);
    if (n < 1024) return 3104 + (n - 640);
    if (n < 1280) return n - 1024;
    if (n < 1536) return 256 + (n - 1280);
    if (n < 1792) return 512 + (n - 1536);
    if (n < 2176) return 1152 + (n - 1792);
    if (n < 2560) return 1536 + (n - 2176);
    if (n < 2944) return 1920 + (n - 2560);
    if (n < 3008) return 768 + (n - 2944);
    if (n < 3072) return 832 + (n - 3008);
    if (n < 3328) return 2688 + (n - 3072);
    if (n < 3456) return 2944 + (n - 3328);
    if (n < 3488) return 3072 + (n - 3456);
    return -1;
}
__device__ __forceinline__ int win_blk(int nb) { const int tile = nb >> 3, d = nb & 7; return (tile >= 7 && tile <= 9) ? tile * 8 + 2 * (d & 3) + (d >> 2) : nb; }
__device__ __forceinline__ void p0_tr_item(const float* W, int ldw, int src_n0, int K, bf16* WT, int dst_row0, int k0, const float* kscale, LAS float* scr, int lane) {
#pragma unroll 8
    for (int i = 0; i < 32; ++i) { const int kk = 2 * i + (lane >> 5);
        float v = src_n0 >= 0 ? W[(size_t)(k0 + kk) * ldw + src_n0 + (lane & 31)] : 0.f;
        if (kscale) v *= kscale[k0 + kk];
        scr[kk * 33 + (lane & 31)] = v; }
    LDS_WAIT(); asm volatile("" ::: "memory");
    const int c = lane & 7;
#pragma unroll
    for (int j = 0; j < 4; ++j) { const int n = (lane >> 3) + 8 * j; const LAS float* s = scr + (8 * c) * 33 + n;
        u32x4 o; o.x = pk2(s[0 * 33], s[1 * 33]); o.y = pk2(s[2 * 33], s[3 * 33]); o.z = pk2(s[4 * 33], s[5 * 33]); o.w = pk2(s[6 * 33], s[7 * 33]);
        *(u32x4*)(WT + (size_t)(dst_row0 + n) * K + k0 + 8 * c) = o; }
    LDS_WAIT(); asm volatile("" ::: "memory");
}

__device__ __forceinline__ void phase_p0a(CArgs& a, LAS unsigned char* lds, int vcu, int G, int tid, int wave, int lane) {
    unsigned char* ws = a.ws;
    if (vcu < 96) {
        const int l = vcu / 48, n0 = (vcu % 48) * 64;
        LAS float* tab = (LAS float*)lds;
        LAS float* red = tab + 9216;
        for (int i = tid; i < 9216; i += 512) { const int j = i >> 10, k = i & 1023; const float c = j == 0 ? a.in[8][k] : a.in[7][(j - 1) * 1024 + k]; tab[i] = silu_f(c); }
        __syncthreads();
        float acc[9];
#pragma unroll
        for (int j = 0; j < 9; ++j) acc[j] = 0.f;
        const float* wm = a.in[9] + (size_t)l * 1024 * 3072 + n0 + lane;
        for (int kk = 0; kk < 128; ++kk) { const int k = wave * 128 + kk; const float wv = wm[(size_t)k * 3072];
#pragma unroll
            for (int j = 0; j < 9; ++j) acc[j] += tab[j * 1024 + k] * wv; }
#pragma unroll
        for (int j = 0; j < 9; ++j) red[(wave * 9 + j) * 64 + lane] = acc[j];
        __syncthreads();
        float* mod = (float*)(ws + WS_MOD);
        for (int i = tid; i < 576; i += 512) { const int j = i >> 6, ln = i & 63; float s = 0.f;
#pragma unroll
            for (int w = 0; w < 8; ++w) s += red[(w * 9 + j) * 64 + ln];
            mod[(size_t)(l * 9 + j) * 3072 + n0 + ln] = s + a.in[10][l * 3072 + n0 + ln]; }
        __syncthreads();
    }
    LAS float* scr = (LAS float*)(lds + 57344 + wave * 8704);
    const int gw = vcu * 8 + wave, NGW = G * 8;
    bf16* WIN = (bf16*)(ws + WS_WIN); bf16* WOUT = (bf16*)(ws + WS_WOUT); bf16* WUQ = (bf16*)(ws + WS_WUQ); bf16* WUKV = (bf16*)(ws + WS_WUKV); bf16* LORA = (bf16*)(ws + WS_LORA);
    for (int it = gw; it < 4912; it += NGW) {
        int r = it;
        if (r < 3584) { const int l = r / 1792, q = r % 1792, kb = q / 112, nb = q % 112;
            p0_tr_item(a.in[12] + (size_t)l * 1024 * 3488, 3488, win_src_col(32 * win_blk(nb)), 1024, WIN + (size_t)l * 3584 * 1024, 32 * nb, 64 * kb, nullptr, scr, lane); continue; } r -= 3584;
        if (r < 1024) { const int l = r / 512, q = r % 512, kb = q / 32, nb = q % 32;
            p0_tr_item(a.in[13] + (size_t)l * 1024 * 1024, 1024, 32 * nb, 1024, WOUT + (size_t)l * 1024 * 1024, 32 * nb, 64 * kb, nullptr, scr, lane); continue; } r -= 1024;
        if (r < 144) { const int l = r / 72, q = r % 72, kb = q / 18, nb = q % 18;
            p0_tr_item(a.in[29] + (size_t)l * 256 * 576, 576, 32 * nb, 256, WUQ + (size_t)l * 576 * 256, 32 * nb, 64 * kb, a.in[27] + l * 256, scr, lane); continue; } r -= 144;
        if (r < 48) { const int l = r / 24, q = r % 24, kb = q / 12, nb = q % 12;
            p0_tr_item(a.in[30] + (size_t)l * 128 * 384, 384, 32 * nb, 128, WUKV + (size_t)l * 768 * 128, 32 * nb, 64 * kb, nullptr, scr, lane); continue; } r -= 48;
        if (r < 48) { const int l = r / 24, q = r % 24, kb = q / 12, nb = q % 12;
            p0_tr_item(a.in[31] + (size_t)l * 128 * 384, 384, 32 * nb, 128, WUKV + (size_t)l * 768 * 128, 384 + 32 * nb, 64 * kb, nullptr, scr, lane); continue; } r -= 48;
        { const int which = r / 32, q = r % 32, ld = q / 8, nb = q % 8;
          const int l = ld >> 1, d = ld & 1;
          p0_tr_item(a.in[which ? 18 : 16] + (size_t)ld * 64 * 256, 256, 32 * nb, 64, LORA + (size_t)(((l * 2 + which) * 2 + d) * 256) * 64, 32 * nb, 0, nullptr, scr, lane); }
    }
    {
        const size_t gt = (size_t)vcu * 512 + tid, NT = (size_t)G * 512;
        for (int w = 0; w < 2; ++w) { const float* src = a.in[3 + w]; bf16* dst = (bf16*)(ws + (w ? WS_NACV : WS_NACK));
            for (size_t c = gt; c < 393216; c += NT) { const f32x4 v0 = *(const f32x4*)(src + c * 8), v1 = *(const f32x4*)(src + c * 8 + 4);
                u32x4 o; o.x = pk2(v0[0], v0[1]); o.y = pk2(v0[2], v0[3]); o.z = pk2(v1[0], v1[1]); o.w = pk2(v1[2], v1[3]); *(u32x4*)(dst + c * 8) = o; } }
    }
}

__device__ __forceinline__ void phase_norm(CArgs& a, int l, int vcu, int G, int wave, int lane) {
    const int gw = vcu * 8 + wave, NGW = G * 8;
    const float* mod = (const float*)(a.ws + WS_MOD) + (size_t)l * 9 * 3072;
    const float* nw = a.in[11] + l * 1024;
    bf16* H = (bf16*)(a.ws + WS_H);
    for (int tok = gw; tok < NTOK; tok += NGW) {
        const float* xr = (l == 0) ? x_row0(a, tok) : a.out + OUT_Y + (size_t)tok * DM;
        const float* md = mod + mod_idx(tok) * 3072;
        f32x4 v[4]; float s = 0.f;
#pragma unroll
        for (int j = 0; j < 4; ++j) { v[j] = *(const f32x4*)(xr + 4 * lane + 256 * j); s += (v[j][0] * v[j][0] + v[j][1] * v[j][1]) + (v[j][2] * v[j][2] + v[j][3] * v[j][3]); }
        s = wave64_sum(s);
        const float rstd = __builtin_amdgcn_rsqf(s * (1.f / 1024.f) + EPS);
#pragma unroll
        for (int j = 0; j < 4; ++j) { const int c = 4 * lane + 256 * j;
            const f32x4 g = *(const f32x4*)(nw + c), sh = *(const f32x4*)(md + c), sc = *(const f32x4*)(md + 1024 + c);
            f32x4 o = ((v[j] * rstd) * g) * (sc + 1.0f) + sh;
            u32x2 w; w.x = pk2(o[0], o[1]); w.y = pk2(o[2], o[3]);
            *(u32x2*)(H + (size_t)tok * DM + c) = w; }
    }
}

__device__ __forceinline__ void phase_l1_tables(CArgs& a, int vcu, int G, int tid, int wave, int lane) {
    const float* mod1 = (const float*)(a.ws + WS_MOD) + (size_t)9 * 3072;
    const float* nw1 = a.in[11] + 1024;
    float* S1 = (float*)(a.ws + WS_S1T); float* C1 = (float*)(a.ws + WS_C1);
    if (vcu == 0 && wave == 0) {
        for (int l = 0; l < 2; ++l) { float mq = 0.f, mk = 0.f;
            for (int i = lane; i < 96; i += 64) { mq = fmaxf(mq, fabsf(a.in[32][l * 96 + i])); mk = fmaxf(mk, fabsf(a.in[33][l * 96 + i])); }
            mq = xor32_max(mq); mk = xor32_max(mk);
#pragma unroll
            for (int o = 16; o > 0; o >>= 1) { mq = fmaxf(mq, __shfl_xor(mq, o)); mk = fmaxf(mk, __shfl_xor(mk, o)); }
            if (lane == 0) ((float*)(a.ws + WS_ABND))[l] = 96.f * mq * mk * (MLA_SCALE * LOG2E); }
    }
    for (int i = vcu * 512 + tid; i < 9216; i += G * 512) { const int b = i >> 10, k = i & 1023; S1[i] = nw1[k] * (1.0f + mod1[b * 3072 + 1024 + k]); }
    const bf16* W1 = (const bf16*)(a.ws + WS_WIN) + (size_t)NPROJ * DM;
    for (int n = vcu * 8 + wave; n < NPROJ; n += G * 8) {
        const bf16x8 w0 = *(const bf16x8*)(W1 + (size_t)n * DM + 16 * lane), w1 = *(const bf16x8*)(W1 + (size_t)n * DM + 16 * lane + 8);
        float wf[16];
#pragma unroll
        for (int q = 0; q < 8; ++q) { wf[q] = bf2f((unsigned short)w0[q]); wf[8 + q] = bf2f((unsigned short)w1[q]); }
#pragma unroll 1
        for (int b = 0; b < 9; ++b) { const float* sh = mod1 + b * 3072 + 16 * lane; float s = 0.f;
#pragma unroll
            for (int q = 0; q < 4; ++q) { const f32x4 v = *(const f32x4*)(sh + 4 * q); s += (v[0] * wf[4 * q] + v[1] * wf[4 * q + 1]) + (v[2] * wf[4 * q + 2] + v[3] * wf[4 * q + 3]); }
            s = wave64_sum(s);
            if (lane == 0) C1[b * NPROJ + n] = s; }
    }
}

__device__ __forceinline__ bf16x8 ld8(const bf16* p) { return *(const bf16x8*)p; }
__device__ __forceinline__ f32x16 mfma32(bf16x8 x, bf16x8 y, f32x16 c) { return __builtin_amdgcn_mfma_f32_32x32x16_bf16(x, y, c, 0, 0, 0); }
__device__ __forceinline__ bf16x8 pack8(const float* f) { u32x4 w; w.x = pk2(f[0], f[1]); w.y = pk2(f[2], f[3]); w.z = pk2(f[4], f[5]); w.w = pk2(f[6], f[7]); return __builtin_bit_cast(bf16x8, w); }
__device__ __forceinline__ void st4bf(bf16* p, float x0, float x1, float x2, float x3) { u32x2 w; w.x = pk2(x0, x1); w.y = pk2(x2, x3); *(u32x2*)p = w; }

__device__ __forceinline__ void rope_tables(float (&cs)[8], float (&sn)[8], bool latent, int tok, int hi) {
    if (latent) { const int tp = (tok - NTC) & 4095; const float prow = (float)(tp >> 6), pcol = (float)(tp & 63);
#pragma unroll
        for (int r = 0; r < 8; ++r) { const float f = (float)((r & 3) + 4 * hi); const float inv = __builtin_amdgcn_exp2f(-f * 1.6609640474436812f);
            float rev = (r < 4 ? prow : pcol) * inv * 0.15915494309189535f; rev = rev - floorf(rev);
            cs[r] = __builtin_amdgcn_cosf(rev); sn[r] = __builtin_amdgcn_sinf(rev); } }
    else {
#pragma unroll
        for (int r = 0; r < 8; ++r) { cs[r] = 1.f; sn[r] = 0.f; } }
}
__device__ __forceinline__ void st32blk(bf16* rowp, const float* v, int hi) {
#pragma unroll
    for (int k = 0; k < 4; k += 2) {
        u32x2 A, B; A.x = pk2(v[4 * k], v[4 * k + 1]); A.y = pk2(v[4 * k + 2], v[4 * k + 3]); B.x = pk2(v[4 * k + 4], v[4 * k + 5]); B.y = pk2(v[4 * k + 6], v[4 * k + 7]);
        const auto r0 = __builtin_amdgcn_permlane32_swap(A.x, B.x, false, false); const auto r1 = __builtin_amdgcn_permlane32_swap(A.y, B.y, false, false);
        u32x4 w; w.x = r0[0]; w.y = r1[0]; w.z = r0[1]; w.w = r1[1];
        *(u32x4*)(rowp + 8 * k + 8 * hi) = w;
    }
}
constexpr int P2_RQ = 528, P2_RKV = 272;
__device__ __forceinline__ void p2_q_job(CArgs& a, int l, LAS unsigned char* lds, int tile, int hp, int tid) {
    asm volatile("" : "+v"(tid));
    const int lane = tid & 63, wave = __builtin_amdgcn_readfirstlane(tid >> 6), r32 = lane & 31, hi = lane >> 5;
    const bf16* Wuq = (const bf16*)(a.ws + WS_WUQ) + (size_t)l * 576 * 256;
    const bool latent = tile >= NTC / 256;
    const unsigned tok = tile * 256 + wave * 32 + r32;
    const bf16* PB = (const bf16*)(a.ws + WS_PB);
    bf16x8 xq[16]; float ss = 0.f;
    { const bf16* pp = PB + tok * LDB + CB_CQ + 8 * hi;
#pragma unroll
      for (int s = 0; s < 16; ++s) { xq[s] = ld8(pp + 16 * s); ss += ss8(xq[s]); } }
    ss = xor32_sum(ss);
    const float rstd_cq = __builtin_amdgcn_rsqf(ss * (1.f / 256.f) + EPS);
    const float* qn = a.in[32] + l * 96;
    bf16* Qrow = (bf16*)(a.ws + WS_Q) + (size_t)tok * 576;
    bf16x8 wreg[6];
    const int wrow = tid >> 5, wc = tid & 31;
    unsigned wso = wrow * 256 + wc * 8; asm volatile("" : "+v"(wso));
#pragma unroll
    for (int i = 0; i < 6; ++i) wreg[i] = ld8(Wuq + ((2 * hp) * 96 + 16 * i) * 256 + wso);
#pragma unroll 1
    for (int hh = 0; hh < 2; ++hh) {
        const int head = 2 * hp + hh;
        __syncthreads();
#pragma unroll
        for (int i = 0; i < 6; ++i) *(LAS bf16x8*)(lds + (wrow + 16 * i) * P2_RQ + wc * 16) = wreg[i];
        if (hh == 0) {
#pragma unroll
            for (int i = 0; i < 6; ++i) wreg[i] = ld8(Wuq + ((2 * hp + 1) * 96 + 16 * i) * 256 + wso);
        }
        __syncthreads();
        f32x16 acc[3];
#pragma unroll
        for (int b = 0; b < 3; ++b) { acc[b] = (f32x16){};
            LAS const unsigned char* wl = lds + (32 * b + r32) * P2_RQ + 16 * hi;
#pragma unroll
            for (int s = 0; s < 16; ++s) acc[b] = mfma32(*(LAS const bf16x8*)(wl + 32 * s), xq[s], acc[b]); }
        float q2 = 0.f;
#pragma unroll
        for (int b = 0; b < 3; ++b)
#pragma unroll
            for (int r = 0; r < 16; ++r) q2 += acc[b][r] * acc[b][r];
        q2 = xor32_sum(q2) * (rstd_cq * rstd_cq);
        const float rq = (__builtin_amdgcn_rsqf(q2 * (1.f / 96.f) + EPS)) * (MLA_SCALE * LOG2E) * rstd_cq;
#pragma unroll
        for (int b = 0; b < 3; ++b)
#pragma unroll
            for (int g = 0; g < 4; ++g) { const f32x4 w4 = *(const f32x4*)(qn + b * 32 + 8 * g + 4 * hi);
#pragma unroll
                for (int i = 0; i < 4; ++i) acc[b][4 * g + i] *= rq * w4[i]; }
        { int tk = (int)tok; asm volatile("" : "+v"(tk)); float cs[8], sn[8]; rope_tables(cs, sn, latent, tk, hi);
#pragma unroll
          for (int r = 0; r < 8; ++r) { const float x1 = acc[2][r], x2 = acc[2][r + 8]; acc[2][r] = x1 * cs[r] - x2 * sn[r]; acc[2][r + 8] = x2 * cs[r] + x1 * sn[r]; } }
#pragma unroll
        for (int b = 0; b < 3; ++b) { float v[16];
#pragma unroll
            for (int r = 0; r < 16; ++r) v[r] = acc[b][r];
            st32blk(Qrow + head * 96 + b * 32, v, hi); }
    }
}
__device__ __forceinline__ void p2_kv_job(CArgs& a, int l, LAS unsigned char* lds, int tile, int part, int tid) {
    asm volatile("" : "+v"(tid));
    const int lane = tid & 63, wave = __builtin_amdgcn_readfirstlane(tid >> 6), r32 = lane & 31, hi = lane >> 5;
    unsigned char* ws = a.ws;
    const bf16* Wukv = (const bf16*)(ws + WS_WUKV) + (size_t)l * 768 * 128;
    const bool is_cc = tile >= 160;
    const bool latent = !is_cc && tile >= NTC / 256;
    const bool context = !is_cc && !latent;
    const unsigned tok = (is_cc ? (tile - 160) * 256 : tile * 256) + wave * 32 + r32;
    { const int rb = part < 2 ? 192 * part : 384 + 192 * (part - 2); const int wrow = tid >> 4, wc = tid & 15;
      bf16x8 wreg[6];
      unsigned wso = wrow * 128 + wc * 8; asm volatile("" : "+v"(wso));
#pragma unroll
      for (int i = 0; i < 6; ++i) wreg[i] = ld8(Wukv + (rb + 32 * i) * 128 + wso);
      __syncthreads();
#pragma unroll
      for (int i = 0; i < 6; ++i) *(LAS bf16x8*)(lds + (wrow + 32 * i) * P2_RKV + wc * 16) = wreg[i]; }
    bf16* Kd = (bf16*)(ws + (is_cc ? WS_CK : WS_MK)) + (size_t)tok * 576; bf16* Vd = (bf16*)(ws + (is_cc ? WS_CV : WS_MV)) + (size_t)tok * 384;
    bf16x8 xk[8]; float kr[16]; float kr2 = 0.f;
    if (!is_cc) {
        const bf16* PB = (const bf16*)(ws + WS_PB);
        const unsigned pbo = tok * LDB + 8 * hi;
        float ss = 0.f;
        { const bf16* pp = PB + pbo + CB_CKV;
#pragma unroll
          for (int s = 0; s < 8; ++s) { xk[s] = ld8(pp + 16 * s); ss += ss8(xk[s]); } }
        ss = xor32_sum(ss);
        const float rstd = __builtin_amdgcn_rsqf(ss * (1.f / 128.f) + EPS);
        const float* gk = a.in[28] + l * 128;
        const unsigned cb = tok >> 8, ct = tok & 255;
        float* ckv_out = a.out + OUT_CKV; const unsigned co = ((cb * 2 + l) * 256 + ct) * 128 + 8 * hi;
        const bool wr_cache = context && part == 0;
#pragma unroll
        for (int s = 0; s < 8; ++s) { float f[8];
            const f32x4 g0 = *(const f32x4*)(gk + 16 * s + 8 * hi), g1 = *(const f32x4*)(gk + 16 * s + 8 * hi + 4);
#pragma unroll
            for (int j = 0; j < 8; ++j) f[j] = bf2f((unsigned short)xk[s][j]) * rstd * (j < 4 ? g0[j & 3] : g1[j & 3]);
            if (wr_cache) { *(f32x4*)(ckv_out + co + 16 * s) = (f32x4){f[0], f[1], f[2], f[3]}; *(f32x4*)(ckv_out + co + (16 * s + 4)) = (f32x4){f[4], f[5], f[6], f[7]}; }
            xk[s] = pack8(f); }
        float* kr_out = a.out + OUT_KROPE; const unsigned kro = ((cb * 2 + l) * 256 + ct) * 32 + 4 * hi;
#pragma unroll
        for (int g = 0; g < 4; ++g) { const u32x2 w = *(const u32x2*)(PB + pbo + (CB_KR + 8 * g) - 4 * hi);
            kr[4 * g] = lo_f(w.x); kr[4 * g + 1] = hi_f(w.x); kr[4 * g + 2] = lo_f(w.y); kr[4 * g + 3] = hi_f(w.y);
            if (wr_cache) *(f32x4*)(kr_out + kro + 8 * g) = (f32x4){kr[4 * g], kr[4 * g + 1], kr[4 * g + 2], kr[4 * g + 3]}; }
    } else {
        const unsigned b = tok >> 9, p = tok & 511;
        const float* src = a.in[5]; const unsigned so = ((b * 2 + l) * 512 + p) * 128 + 8 * hi;
#pragma unroll
        for (int s = 0; s < 8; ++s) { const f32x4 v0 = *(const f32x4*)(src + so + 16 * s), v1 = *(const f32x4*)(src + so + (16 * s + 4));
            float f[8] = {v0[0], v0[1], v0[2], v0[3], v1[0], v1[1], v1[2], v1[3]}; xk[s] = pack8(f); }
        const float* ksrc = a.in[6]; const unsigned kso = ((b * 2 + l) * 512 + p) * 32 + 4 * hi;
#pragma unroll
        for (int g = 0; g < 4; ++g) { const f32x4 v = *(const f32x4*)(ksrc + kso + 8 * g); kr[4 * g] = v[0]; kr[4 * g + 1] = v[1]; kr[4 * g + 2] = v[2]; kr[4 * g + 3] = v[3]; }
    }
#pragma unroll
    for (int r = 0; r < 16; ++r) kr2 += kr[r] * kr[r];
    kr2 = xor32_sum(kr2);
    const float* kn = a.in[33] + l * 96;
    __syncthreads();
    if (part < 2) {
#pragma unroll 1
        for (int hh = 0; hh < 3; ++hh) {
            const int head = 3 * part + hh;
            f32x16 acc[2];
#pragma unroll
            for (int b = 0; b < 2; ++b) { acc[b] = (f32x16){};
                LAS const unsigned char* wl = lds + (64 * hh + 32 * b + r32) * P2_RKV + 16 * hi;
#pragma unroll
                for (int s = 0; s < 8; ++s) acc[b] = mfma32(*(LAS const bf16x8*)(wl + 32 * s), xk[s], acc[b]); }
            float k2 = 0.f;
#pragma unroll
            for (int b = 0; b < 2; ++b)
#pragma unroll
                for (int r = 0; r < 16; ++r) k2 += acc[b][r] * acc[b][r];
            k2 = xor32_sum(k2);
            const float rk = __builtin_amdgcn_rsqf((k2 + kr2) * (1.f / 96.f) + EPS);
#pragma unroll
            for (int b = 0; b < 2; ++b) { float v[16];
#pragma unroll
                for (int g = 0; g < 4; ++g) { const f32x4 w4 = *(const f32x4*)(kn + b * 32 + 8 * g + 4 * hi);
#pragma unroll
                    for (int i = 0; i < 4; ++i) v[4 * g + i] = acc[b][4 * g + i] * rk * w4[i]; }
                st32blk(Kd + head * 96 + b * 32, v, hi); }
            float kv[16];
#pragma unroll
            for (int g = 0; g < 4; ++g) { const f32x4 w4 = *(const f32x4*)(kn + 64 + 8 * g + 4 * hi);
#pragma unroll
                for (int i = 0; i < 4; ++i) kv[4 * g + i] = kr[4 * g + i] * rk * w4[i]; }
            { int tk = (int)tok; asm volatile("" : "+v"(tk)); float cs[8], sn[8]; rope_tables(cs, sn, latent, tk, hi);
#pragma unroll
              for (int r = 0; r < 8; ++r) { const float x1 = kv[r], x2 = kv[r + 8]; kv[r] = x1 * cs[r] - x2 * sn[r]; kv[r + 8] = x2 * cs[r] + x1 * sn[r]; } }
            st32blk(Kd + head * 96 + 64, kv, hi);
        }
    } else {
#pragma unroll 1
        for (int nb = 0; nb < 6; ++nb) {
            f32x16 acc = (f32x16){};
            LAS const unsigned char* wl = lds + (32 * nb + r32) * P2_RKV + 16 * hi;
#pragma unroll
            for (int s = 0; s < 8; ++s) acc = mfma32(*(LAS const bf16x8*)(wl + 32 * s), xk[s], acc);
            float v[16];
#pragma unroll
            for (int r = 0; r < 16; ++r) v[r] = acc[r];
            st32blk(Vd + 192 * (part - 2) + nb * 32, v, hi);
        }
    }
}

__device__ __forceinline__ void p2_na_token(CArgs& a, int l, int tok, int lane) {
    asm volatile("" : "+v"(lane));
    bf16* row = (bf16*)(a.ws + WS_PA) + (size_t)tok * LDA;
    const bool context = tok < NTC;
    const int cb = tok >> 8, ct = tok & 255;
    float* nak = a.out + OUT_NAK + ((size_t)(cb * 2 + l) * 256 + ct) * 384;
    float* nav = a.out + OUT_NAV + ((size_t)(cb * 2 + l) * 256 + ct) * 384;
    const float* qw = a.in[24] + l * 64; const float* kw = a.in[25] + l * 64;
#pragma unroll
    for (int i = 0; i < 3; ++i) {
        const int e = 4 * lane + 256 * i;
        const u32x2 w = *(const u32x2*)(row + CA_QN + e);
        float f[4] = {lo_f(w.x), hi_f(w.x), lo_f(w.y), hi_f(w.y)};
        float s = (f[0] * f[0] + f[1] * f[1]) + (f[2] * f[2] + f[3] * f[3]);
        s = row16_sum(s);
        const float rs = __builtin_amdgcn_rsqf(s * (1.f / 64.f) + EPS);
        const bool isq = e < 384; const int d = e & 63;
        const float* gw = isq ? qw : kw; const float sc = isq ? rs * (0.125f * LOG2E) : rs;
        float o[4];
#pragma unroll
        for (int j = 0; j < 4; ++j) o[j] = f[j] * sc * gw[d + j];
        st4bf(row + CA_QN + e, o[0], o[1], o[2], o[3]);
        if (context && !isq) *(f32x4*)(nak + (e - 384)) = (f32x4){o[0], o[1], o[2], o[3]};
    }
    if (context) {
#pragma unroll
        for (int i = 0; i < 2; ++i) { const int e = 4 * lane + 256 * i;
            if (e < 384) { const u32x2 w = *(const u32x2*)(row + CA_VN + e); *(f32x4*)(nav + e) = (f32x4){lo_f(w.x), hi_f(w.x), lo_f(w.y), hi_f(w.y)}; } }
    }
}

__device__ __forceinline__ void phase_p2(CArgs& a, int l, LAS unsigned char* lds, int vcu, int G, int tid, int wave, int lane, bool dry) {
    for (int jid = vcu; jid < 1184; jid += G) { if (jid < 480) p2_q_job(a, l, lds, jid / 3, jid % 3, tid); else { const int v = jid - 480; p2_kv_job(a, l, lds, v >> 2, v & 3, tid); } }
    __syncthreads();
    (void)dry; (void)wave; (void)lane;
}

struct AttnSeg { const bf16* K; const bf16* V; int ks, vs, nt; };
constexpr int ATT_KVB = 20480;
constexpr int ATT_BIAS_OFF = 2 * ATT_KVB;
typedef LAS const unsigned char* ldsc_t;
__device__ __forceinline__ s16x4 vtr(ldsc_t p) { typedef short v4i16_t __attribute__((ext_vector_type(4))); return __builtin_bit_cast(s16x4, __builtin_amdgcn_ds_read_tr16_b64_v4i16((LAS v4i16_t*)p)); }

__device__ __forceinline__ float max3f(float a, float b, float c) { float r; asm("v_max3_f32 %0, %1, %2, %3" : "=v"(r) : "v"(a), "v"(b), "v"(c)); return r; }
__device__ __forceinline__ float max2f(float a, float b) { float r; asm("v_max_f32_e32 %0, %1, %2" : "=v"(r) : "v"(a), "v"(b)); return r; }
template <int DK, bool LOCAL_OK>
__device__ __forceinline__ void attn_unit(LAS unsigned char* lds, const bf16* Qp, int qs, AttnSeg s0, AttnSeg s1, bf16* Gp, int gs,
                                          const bool local_rt, const float* rpb, int r0, int kr_lo, int tid, bool dry, bool fast) {
    asm volatile("" : "+v"(tid));
    const bool LOCAL = LOCAL_OK && local_rt;
    constexpr int NS = DK / 16;
    constexpr int KB = 64 * DK * 2;
    const int lane = tid & 63, wave = __builtin_amdgcn_readfirstlane(tid >> 6), r32 = lane & 31, hi = lane >> 5;
    bf16x8 qf[NS];
    { const bf16* qrow = Qp + (size_t)(wave * 32 + r32) * qs + 8 * hi;
#pragma unroll
      for (int s = 0; s < NS; ++s) qf[s] = ld8(qrow + 16 * s); }
    int my_row = 0, my_rs = 0, jbase = 0, lbase = 0;
    if (LOCAL) {
        LAS float* bt = (LAS float*)(lds + ATT_BIAS_OFF);
        if (tid < 480) { const int row = tid >> 1, half = tid & 1; const int L = row / 15, dr = row - L * 15;
#pragma unroll
            for (int q = 0; q < 17; ++q) { const int j = 17 * half + q, dc = j - 1; const bool ok = dc >= L && dc < L + 16 && dc >= 0 && dc <= 30;
                bt[row * 34 + j] = ok ? rpb[dr * 31 + (ok ? dc : 0)] * LOG2E : -1e30f; } }
        my_row = r0 + (wave >> 1); my_rs = min(max(my_row - 4, 0), 56);
        const int qcol = 32 * (wave & 1) + r32, cs_ = min(max(qcol - 8, 0), 48);
        jbase = 16 - qcol + 4 * hi;
        lbase = (cs_ - qcol + 15) * 510;
    }
    const int nt = s0.nt + s1.nt;
    const int vkey = 16 * (wave & 3) + (lane >> 2), vch = 4 * (wave >> 2) + (lane & 3);
    bf16x8 kreg0, kreg1, vreg;
    auto stage_load = [&](int t) {
        const bool in0 = t < s0.nt; const int tt = in0 ? t : t - s0.nt;
        const bf16* Kb = in0 ? s0.K : s1.K; const bf16* Vb = in0 ? s0.V : s1.V; const int ks = in0 ? s0.ks : s1.ks, vs = in0 ? s0.vs : s1.vs;
        const bf16* kp = Kb + (size_t)(tt * 64 + lane) * ks;
        kreg0 = ld8(kp + wave * 8);
        if (DK == 96 && wave < 4) kreg1 = ld8(kp + (wave + 8) * 8);
        vreg = ld8(Vb + (size_t)(tt * 64 + vkey) * vs + vch * 8);
    };
    auto stage_write = [&](int buf) {
        LAS unsigned char* kb = lds + buf * ATT_KVB;
        *(LAS bf16x8*)(kb + wave * 1024 + lane * 16) = kreg0;
        if (DK == 96 && wave < 4) *(LAS bf16x8*)(kb + (wave + 8) * 1024 + lane * 16) = kreg1;
        *(LAS bf16x8*)(kb + KB + wave * 1024 + lane * 16) = vreg;
    };
    float m = 0.f, lsum = 0.f;
    f32x16 o0 = (f32x16){}, o1 = (f32x16){}, negm = (f32x16){};
    stage_load(0); stage_write(0);
    __syncthreads();
    if (!LOCAL_OK && fast) {
    const f32x16 zero16 = (f32x16){};
    for (int t = 0; t < nt; ++t) {
        if (t + 1 < nt) stage_load(t + 1);
        ldsc_t kb = (ldsc_t)(lds + (t & 1) * ATT_KVB);
        f32x16 p0, p1;
        __builtin_amdgcn_s_setprio(1);
        __builtin_amdgcn_iglp_opt(1);
        bf16x8 kf0[NS], kf1[NS];
#pragma unroll
        for (int s = 0; s < NS; ++s) { kf0[s] = *(LAS const bf16x8*)(kb + (2 * s + hi) * 1024 + r32 * 16); kf1[s] = *(LAS const bf16x8*)(kb + (2 * s + hi) * 1024 + r32 * 16 + 512); }
        __builtin_amdgcn_sched_barrier(0);
#pragma unroll
        for (int s = 0; s < NS; ++s) {
            if (s == 0) { p0 = mfma32(kf0[0], qf[0], zero16); p1 = mfma32(kf1[0], qf[0], zero16); }
            else { p0 = mfma32(kf0[s], qf[s], p0); p1 = mfma32(kf1[s], qf[s], p1); }
        }
        __builtin_amdgcn_s_setprio(0);
        ldsc_t vp = kb + KB + ((lane >> 4) & 1) * 32 + (lane & 3) * 8 + (4 * hi + ((lane & 15) >> 2)) * 64;
        s16x4 va[8], vb[8];
#pragma unroll
        for (int i = 0; i < 8; ++i) { va[i] = vtr(vp + (i >> 2) * 4096 + (i & 3) * 1024); vb[i] = vtr(vp + (i >> 2) * 4096 + (i & 3) * 1024 + 512); }
#define ATT_VF(i) ((bf16x8){va[i][0], va[i][1], va[i][2], va[i][3], vb[i][0], vb[i][1], vb[i][2], vb[i][3]})
        float ps = 0.f; float e0[16], e1[16];
#pragma unroll
        for (int r = 0; r < 16; ++r) { e0[r] = __builtin_amdgcn_exp2f(p0[r]); ps += e0[r]; }
        const bf16x8 pa0 = pack8(e0), pa1 = pack8(e0 + 8);
        __builtin_amdgcn_sched_barrier(0);
        o0 = mfma32(ATT_VF(0), pa0, o0); o1 = mfma32(ATT_VF(4), pa0, o1);
        o0 = mfma32(ATT_VF(1), pa1, o0); o1 = mfma32(ATT_VF(5), pa1, o1);
        __builtin_amdgcn_sched_barrier(0);
#pragma unroll
        for (int r = 0; r < 16; ++r) { e1[r] = __builtin_amdgcn_exp2f(p1[r]); ps += e1[r]; }
        lsum += ps;
        const bf16x8 pa2 = pack8(e1), pa3 = pack8(e1 + 8);
        __builtin_amdgcn_sched_barrier(0);
        o0 = mfma32(ATT_VF(2), pa2, o0); o1 = mfma32(ATT_VF(6), pa2, o1);
        o0 = mfma32(ATT_VF(3), pa3, o0); o1 = mfma32(ATT_VF(7), pa3, o1);
#undef ATT_VF
        if (t + 1 < nt) stage_write((t + 1) & 1);
        __syncthreads();
    }
    } else
    for (int t = 0; t < nt; ++t) {
        if (t + 1 < nt) stage_load(t + 1);
        bool active = true; int dr = 0;
        if (LOCAL && t >= s0.nt) { const int kr = kr_lo + (t - s0.nt); active = (kr >= my_rs) && (kr < my_rs + 8); dr = kr - my_row + 7; }
        if (active) {
            ldsc_t kb = (ldsc_t)(lds + (t & 1) * ATT_KVB);
            f32x16 p0, p1;
            __builtin_amdgcn_s_setprio(1);
            __builtin_amdgcn_iglp_opt(1);
            bf16x8 kf0[NS], kf1[NS];
#pragma unroll
            for (int s = 0; s < NS; ++s) { kf0[s] = *(LAS const bf16x8*)(kb + (2 * s + hi) * 1024 + r32 * 16); kf1[s] = *(LAS const bf16x8*)(kb + (2 * s + hi) * 1024 + r32 * 16 + 512); }
            __builtin_amdgcn_sched_barrier(0);
#pragma unroll
            for (int s = 0; s < NS; ++s) {
                if (s == 0) { p0 = mfma32(kf0[0], qf[0], negm); p1 = mfma32(kf1[0], qf[0], negm); }
                else { p0 = mfma32(kf0[s], qf[s], p0); p1 = mfma32(kf1[s], qf[s], p1); }
            }
            __builtin_amdgcn_s_setprio(0);
            if (LOCAL && t >= s0.nt) {
                LAS const float* bt = (LAS const float*)(lds + ATT_BIAS_OFF) + lbase + dr * 34;
#pragma unroll
                for (int r = 0; r < 16; ++r) {
                    const int j0 = min(max(jbase + (r & 3) + 8 * (r >> 2), 0), 33), j1 = min(max(jbase + (r & 3) + 8 * (r >> 2) + 32, 0), 33);
                    p0[r] += bt[j0]; p1[r] += bt[j1];
                }
            }
            float mxa = max3f(p0[0], p0[1], p1[0]), mxb = max3f(p0[2], p0[3], p1[1]); mxa = max3f(mxa, p1[2], p1[3]);
#pragma unroll
            for (int r = 4; r < 16; r += 4) { mxa = max3f(mxa, p0[r], p0[r + 1]); mxb = max3f(mxb, p0[r + 2], p0[r + 3]); mxa = max3f(mxa, p1[r], p1[r + 1]); mxb = max3f(mxb, p1[r + 2], p1[r + 3]); }
            float mx = max2f(mxa, mxb);
            { const auto rr = __builtin_amdgcn_permlane32_swap(__float_as_uint(mx), __float_as_uint(mx), false, false); mx = max2f(__uint_as_float(rr[0]), __uint_as_float(rr[1])); }
            if (t == 0 || !__all(mx <= 8.0f)) {
                const float d = t == 0 ? mx : fmaxf(mx, 0.f); const float al = __builtin_amdgcn_exp2f(-d);
#pragma unroll
                for (int r = 0; r < 16; ++r) { o0[r] *= al; o1[r] *= al; p0[r] -= d; p1[r] -= d; }
                lsum *= al; m += d;
#pragma unroll
                for (int r = 0; r < 16; ++r) negm[r] = -m;
            }
            ldsc_t vp = kb + KB + ((lane >> 4) & 1) * 32 + (lane & 3) * 8 + (4 * hi + ((lane & 15) >> 2)) * 64;
            s16x4 va[8], vb[8];
#pragma unroll
            for (int i = 0; i < 8; ++i) { va[i] = vtr(vp + (i >> 2) * 4096 + (i & 3) * 1024); vb[i] = vtr(vp + (i >> 2) * 4096 + (i & 3) * 1024 + 512); }
#define ATT_VF(i) ((bf16x8){va[i][0], va[i][1], va[i][2], va[i][3], vb[i][0], vb[i][1], vb[i][2], vb[i][3]})
            float ps = 0.f; float e0[16], e1[16];
#pragma unroll
            for (int r = 0; r < 16; ++r) { e0[r] = __builtin_amdgcn_exp2f(p0[r]); ps += e0[r]; }
            const bf16x8 pa0 = pack8(e0), pa1 = pack8(e0 + 8);
            __builtin_amdgcn_sched_barrier(0);
            o0 = mfma32(ATT_VF(0), pa0, o0); o1 = mfma32(ATT_VF(4), pa0, o1);
            o0 = mfma32(ATT_VF(1), pa1, o0); o1 = mfma32(ATT_VF(5), pa1, o1);
            __builtin_amdgcn_sched_barrier(0);
#pragma unroll
            for (int r = 0; r < 16; ++r) { e1[r] = __builtin_amdgcn_exp2f(p1[r]); ps += e1[r]; }
            lsum += ps;
            const bf16x8 pa2 = pack8(e1), pa3 = pack8(e1 + 8);
            __builtin_amdgcn_sched_barrier(0);
            o0 = mfma32(ATT_VF(2), pa2, o0); o1 = mfma32(ATT_VF(6), pa2, o1);
            o0 = mfma32(ATT_VF(3), pa3, o0); o1 = mfma32(ATT_VF(7), pa3, o1);
#undef ATT_VF
        }
        if (t + 1 < nt) stage_write((t + 1) & 1);
        __syncthreads();
    }
    const float inv = 1.0f / xor32_sum(lsum);
    if (!dry) {
    bf16* grow = Gp + (size_t)(wave * 32 + r32) * gs;
#pragma unroll
    for (int g = 0; g < 4; ++g) {
        { bf16* p = grow + 8 * g + 4 * hi; const u32x2 w = *(const u32x2*)p;
          st4bf(p, o0[4 * g] * inv * silu_f(lo_f(w.x)), o0[4 * g + 1] * inv * silu_f(hi_f(w.x)), o0[4 * g + 2] * inv * silu_f(lo_f(w.y)), o0[4 * g + 3] * inv * silu_f(hi_f(w.y))); }
        { bf16* p = grow + 32 + 8 * g + 4 * hi; const u32x2 w = *(const u32x2*)p;
          st4bf(p, o1[4 * g] * inv * silu_f(lo_f(w.x)), o1[4 * g + 1] * inv * silu_f(hi_f(w.x)), o1[4 * g + 2] * inv * silu_f(lo_f(w.y)), o1[4 * g + 3] * inv * silu_f(hi_f(w.y))); }
    }
    } else { asm volatile("" :: "v"(o0), "v"(o1), "v"(inv)); }
    __syncthreads();
}

constexpr int ATT_UNITS = 1920;
__device__ __forceinline__ void attn_dispatch(CArgs& a, int l, int u, LAS unsigned char* lds, int tid, int dmode) {
    const bool dry = dmode != 0;
    unsigned char* ws = a.ws;
    bf16* PA = (bf16*)(ws + WS_PA);
    if (u < 768 || (u >= 1536 && u < 1728)) {
        AttnSeg s0, s1; int tok0, h;
        if (u < 768) { const int b = u / 96, qb = u % 16; h = (u / 16) % 6; tok0 = NTC + b * TL + qb * 256;
            s0 = AttnSeg{(const bf16*)(ws + WS_CK) + (size_t)(b * 512) * 576 + h * 96, (const bf16*)(ws + WS_CV) + (size_t)(b * 512) * 384 + h * 64, 576, 384, 8};
            s1 = AttnSeg{(const bf16*)(ws + WS_MK) + (size_t)(NTC + b * TL) * 576 + h * 96, (const bf16*)(ws + WS_MV) + (size_t)(NTC + b * TL) * 384 + h * 64, 576, 384, 64};
        } else { const int v = u - 1536; const int b = v / 6; h = v % 6; tok0 = b * TC;
            s0 = AttnSeg{(const bf16*)(ws + WS_MK) + (size_t)tok0 * 576 + h * 96, (const bf16*)(ws + WS_MV) + (size_t)tok0 * 384 + h * 64, 576, 384, 4};
            s1 = AttnSeg{s0.K, s0.V, 576, 384, 0}; }
        attn_unit<96, false>(lds, (const bf16*)(ws + WS_Q) + (size_t)tok0 * 576 + h * 96, 576, s0, s1, PA + (size_t)tok0 * LDA + CA_GM + h * 64, LDA, false, nullptr, 0, 0, tid, dry, ((const float*)(ws + WS_ABND))[l] <= 60.0f);
    } else {
        AttnSeg s0, s1; int tok0, h, r0 = 0, kr_lo = 0; bool local = false;
        if (u < 1536) { const int v = u - 768; const int b = v / 96, rg = v % 16; h = (v / 16) % 6; tok0 = NTC + b * TL + rg * 256; r0 = rg * 4; local = true;
            kr_lo = min(max(r0 - 4, 0), 56); const int kr_hi = min(max(r0 + 3 - 4, 0), 56) + 8;
            s0 = AttnSeg{(const bf16*)(ws + WS_NACK) + ((size_t)(b * 2 + l) * 512) * 384 + h * 64, (const bf16*)(ws + WS_NACV) + ((size_t)(b * 2 + l) * 512) * 384 + h * 64, 384, 384, 8};
            const bf16* kb = PA + (size_t)(NTC + b * TL + kr_lo * 64) * LDA;
            s1 = AttnSeg{kb + CA_KN + h * 64, kb + CA_VN + h * 64, LDA, LDA, kr_hi - kr_lo};
        } else { const int v = u - 1728; const int b = v / 6; h = v % 6; tok0 = b * TC;
            const bf16* kb = PA + (size_t)tok0 * LDA;
            s0 = AttnSeg{kb + CA_KN + h * 64, kb + CA_VN + h * 64, LDA, LDA, 4};
            s1 = AttnSeg{s0.K, s0.V, LDA, LDA, 0}; }
        attn_unit<64, true>(lds, PA + (size_t)tok0 * LDA + CA_QN + h * 64, LDA, s0, s1, PA + (size_t)tok0 * LDA + CA_GN + h * 64, LDA, local, a.in[26] + (size_t)(l * 6 + h) * 15 * 31, r0, kr_lo, tid, dry, false);
    }
}

constexpr int SC_R = 0, SC_V = 4096, SC_NK = 8192, SC_W = 12288, SC_BB = 16384, SC_KD = 20480, SC_KC = 24576, SC_AA = 28672, SC_YB = 32768;
constexpr int SC_NT = 36864, SC_RT = SC_NT + 2176, SC_BT = SC_RT + 2176, SC_KT = SC_BT + 2176;
constexpr int SC_BHT = SC_KT + 2176, SC_KHT = SC_BHT + 2560, SC_VT = SC_KHT + 2560;
constexpr int SC_GC = SC_VT + 2560;
constexpr int SC_A1 = SC_GC + 256;
constexpr int SC_A2 = SC_A1 + 1024, SC_B1 = SC_A2 + 640, SC_B2 = SC_B1 + 640;
constexpr int SC_TW = SC_B2 + 640;
constexpr int SC_CW = SC_TW + 4 * 640;
constexpr int SC_YP = SC_CW + 12 * 256;
constexpr int SC_GC2 = SC_YP + 2048;
constexpr int SC_GX = SC_GC2 + 256;
constexpr int SCAN_SLOT = SC_GX + 1024;
static_assert(2 * SCAN_SLOT <= 131072, "scan LDS map");
__device__ __forceinline__ float dot4(f32x4 x, f32x4 y) { return (x[0] * y[0] + x[1] * y[1]) + (x[2] * y[2] + x[3] * y[3]); }
__device__ __forceinline__ f32x4 ldbf4(const bf16* p) { const u32x2 w = *(const u32x2*)p; return (f32x4){lo_f(w.x), hi_f(w.x), lo_f(w.y), hi_f(w.y)}; }
__device__ __forceinline__ f32x4 cvbf4(u32x2 w) { return (f32x4){lo_f(w.x), hi_f(w.x), lo_f(w.y), hi_f(w.y)}; }
__device__ __forceinline__ float tanh_f(float x) { return 1.f - 2.f * rcp_f(1.f + __expf(2.f * x)); }
__device__ __forceinline__ u32x2 pk4(f32x4 v) { u32x2 w; w.x = pk2(v[0], v[1]); w.y = pk2(v[2], v[3]); return w; }
__device__ __forceinline__ bf16x8 cat8(u32x2 lo, u32x2 hi) { u32x4 w; w.x = lo.x; w.y = lo.y; w.z = hi.x; w.w = hi.y; return __builtin_bit_cast(bf16x8, w); }
__device__ __forceinline__ f32x4 mfma16(bf16x8 x, bf16x8 y, f32x4 c) { return __builtin_amdgcn_mfma_f32_16x16x32_bf16(x, y, c, 0, 0, 0); }
__device__ __forceinline__ u32x2 lds8(LAS const unsigned char* p) { return *(LAS const u32x2*)p; }

__device__ __forceinline__ unsigned char* scan_yp(unsigned char* ws, int jobid) { return jobid < 704 ? ws + WS_YPA + (size_t)jobid * 32768 : ws + WS_YPB + (size_t)(jobid - 704) * 32768; }
__device__ __forceinline__ void scan_job(CArgs& a, int l, LAS unsigned char* slot, bool lat, int b, int d, int h, int c, int jt, int w4, int lane, int mode, int hw) {
    const bool PH1 = lat && c > 0;
    asm volatile("" : "+v"(jt), "+v"(lane));
    (void)mode;
    unsigned char* ws = a.ws;
    const int T = lat ? TL : TC, tokbase = lat ? NTC + b * TL : b * TC;
    const int chain = b * 8 + d * 4 + h;
    const bf16* PA = (const bf16*)(ws + WS_PA);
    const int g4 = lane >> 4, j16 = lane & 15;
    const int tokl = jt >> 4, cg = jt & 15;
    LAS float* fCW = (LAS float*)(slot + SC_CW);
    for (int i = jt; i < 12 * 64; i += 256) { const int rw = i >> 6, ch = i & 63; float v;
        if (rw < 9) v = a.in[14][(size_t)l * 3 * 768 + (rw % 3) * 768 + (rw / 3) * 256 + h * 64 + ch];
        else if (rw == 9) v = a.in[19][l * 256 + h * 64 + ch]; else if (rw == 10) v = a.in[20][l * 256 + h * 64 + ch]; else v = a.in[21][(l * 4 + h) * 64 + ch];
        fCW[i] = v; }
    const bf16* lora_w = (const bf16*)(ws + WS_LORA) + (size_t)(((l * 2 + 0) * 2 + d) * 256 + h * 64 + 16 * w4 + j16) * 64 + 8 * g4;
    const bf16* lora_a = (const bf16*)(ws + WS_LORA) + (size_t)(((l * 2 + 1) * 2 + d) * 256 + h * 64 + 16 * w4 + j16) * 64 + 8 * g4;
    const bf16x8 lw0 = ld8(lora_w), lw1 = ld8(lora_w + 32), la0 = ld8(lora_a), la1 = ld8(lora_a + 32);
    const float w0c = a.in[15][(l * 2 + d) * 256 + h * 64 + 16 * w4 + j16];
    const float a0c = a.in[17][(l * 2 + d) * 256 + h * 64 + 16 * w4 + j16];
    f32x4 S[4], P[4];
    {
        const float* src = nullptr;
        if (!PH1 && lat) src = a.in[2] + (size_t)((((b * 2 + l) * 2 + d) * 4 + h)) * 4096;
#pragma unroll
        for (int blk = 0; blk < 4; ++blk) {
            S[blk] = src ? *(const f32x4*)(src + (16 * w4 + j16) * 64 + 16 * blk + 4 * g4) : (f32x4){0.f, 0.f, 0.f, 0.f};
#pragma unroll
            for (int q = 0; q < 4; ++q) P[blk][q] = (PH1 && (16 * w4 + j16 == 16 * blk + 4 * g4 + q)) ? 1.f : 0.f;
        }
    }
    LAS float* fR = (LAS float*)(slot + SC_R); LAS float* fV = (LAS float*)(slot + SC_V); LAS float* fNK = (LAS float*)(slot + SC_NK); LAS float* fW = (LAS float*)(slot + SC_W);
    LAS float* fBB = (LAS float*)(slot + SC_BB); LAS float* fKD = (LAS float*)(slot + SC_KD); LAS float* fKC = (LAS float*)(slot + SC_KC); LAS float* fAA = (LAS float*)(slot + SC_AA);
    LAS float* fYB = (LAS float*)(slot + SC_YB); LAS float* fGC = (LAS float*)(slot + SC_GC); LAS float* fA1 = (LAS float*)(slot + SC_A1);
    LAS unsigned char* TWw = slot + SC_TW + w4 * 640;
    u32x2 q_r[3], q_k[3], q_v[3]; bf16x8 q_wd0, q_wd1, q_ad0, q_ad1;
    auto issue_loads = [&](int sub) {
        const int tau0 = c * SCAN_L + sub * 16;
        { const int tau = tau0 + tokl; const int t = d ? T - 1 - tau : tau; const bf16* row = PA + ((size_t)tokbase + t) * LDA + h * 64 + 4 * cg;
          const bool hp = t > 0, hn = t + 1 < T; const u32x2 z = (u32x2){0u, 0u};
          q_r[0] = hp ? *(const u32x2*)(row - LDA + CA_R) : z; q_r[1] = *(const u32x2*)(row + CA_R); q_r[2] = hn ? *(const u32x2*)(row + LDA + CA_R) : z;
          q_k[0] = hp ? *(const u32x2*)(row - LDA + CA_K) : z; q_k[1] = *(const u32x2*)(row + CA_K); q_k[2] = hn ? *(const u32x2*)(row + LDA + CA_K) : z;
          q_v[0] = hp ? *(const u32x2*)(row - LDA + CA_V) : z; q_v[1] = *(const u32x2*)(row + CA_V); q_v[2] = hn ? *(const u32x2*)(row + LDA + CA_V) : z; }
        { const int tau2 = tau0 + j16; const int t2 = d ? T - 1 - tau2 : tau2; const bf16* row2 = PA + ((size_t)tokbase + t2) * LDA;
          q_wd0 = ld8(row2 + CA_WD + 8 * g4); q_wd1 = ld8(row2 + CA_WD + 32 + 8 * g4); q_ad0 = ld8(row2 + CA_AD + 8 * g4); q_ad1 = ld8(row2 + CA_AD + 32 + 8 * g4); }
    };
    auto stage_a = [&](int sa) {
    {
#define CWR(rw) (*(LAS const f32x4*)(fCW + (rw) * 64 + 4 * cg))
        const f32x4 r_c = cvbf4(q_r[0]) * CWR(0) + cvbf4(q_r[1]) * CWR(1) + cvbf4(q_r[2]) * CWR(2);
        const f32x4 k_c = cvbf4(q_k[0]) * CWR(3) + cvbf4(q_k[1]) * CWR(4) + cvbf4(q_k[2]) * CWR(5);
        const f32x4 v_c = cvbf4(q_v[0]) * CWR(6) + cvbf4(q_v[1]) * CWR(7) + cvbf4(q_v[2]) * CWR(8);
        const f32x4 kk = k_c * CWR(9);
        float ss = dot4(kk, kk); ss = row16_sum(ss);
        const float inv = __builtin_amdgcn_rsqf(fmaxf(ss, 1e-24f));
        const int o = tokl * 64 + 4 * cg;
        *(LAS f32x4*)(fR + o) = r_c; *(LAS f32x4*)(fV + o) = v_c; *(LAS f32x4*)(fNK + o) = kk * (-inv); *(LAS f32x4*)(fKC + o) = k_c;
    }
    {
        f32x4 accw = (f32x4){0.f, 0.f, 0.f, 0.f}, acca = (f32x4){0.f, 0.f, 0.f, 0.f}; float dq[4];
        accw = mfma16(q_wd0, lw0, accw); accw = mfma16(q_wd1, lw1, accw);
        acca = mfma16(q_ad0, la0, acca); acca = mfma16(q_ad1, la1, acca);
#pragma unroll
        for (int q = 0; q < 4; ++q) {
            const float x = -(w0c + accw[q]);
            const float sp = fmaxf(x, 0.f) + __logf(1.f + __expf(-fabsf(x)));
            const float decay = __expf(-__expf(-sp - 0.5f));
            const float av = sigmoid_f(a0c + acca[q]);
            const int o = (4 * g4 + q) * 64 + 16 * w4 + j16;
            dq[q] = decay; fAA[o] = av;
        }
        dq[1] *= dq[0]; dq[2] *= dq[1]; dq[3] *= dq[2];
        LAS float* gx = (LAS float*)(slot + SC_GX + w4 * 256);
        gx[g4 * 16 + j16] = dq[3];
        LDS_WAIT();
        const float G0 = gx[j16], G1 = gx[16 + j16], G2 = gx[32 + j16], G3 = gx[48 + j16];
        const float E = g4 == 0 ? 1.f : (g4 == 1 ? G0 : (g4 == 2 ? G0 * G1 : G0 * G1 * G2));
#pragma unroll
        for (int q = 0; q < 4; ++q) fW[(4 * g4 + q) * 64 + 16 * w4 + j16] = E * dq[q];
        if (g4 == 0) ((LAS float*)(slot + ((sa & 1) ? SC_GC2 : SC_GC)))[16 * w4 + j16] = (G0 * G1) * (G2 * G3);
    }
    };
    auto flush_y = [&](int sf) {
        const int tauf = c * SCAN_L + sf * 16 + tokl; const int tf_ = d ? T - 1 - tauf : tauf; const size_t tokf = (size_t)tokbase + tf_;
        const f32x4 y4 = *(LAS const f32x4*)(fYB + tokl * 64 + 4 * cg);
        st4bf((bf16*)(ws + WS_Y) + tokf * 512 + d * 256 + h * 64 + 4 * cg, y4[0], y4[1], y4[2], y4[3]);
        if (PH1) *(u32x2*)(scan_yp(ws, chain * 15 + c - 1) + sf * 2048 + jt * 8) = *(LAS const u32x2*)(slot + SC_YP + jt * 8);
    };
    issue_loads(0);
    __syncthreads();
    stage_a(0);
    if (SCAN_L > 16) issue_loads(1);
#pragma unroll 1
    for (int sub = 0; sub < SCAN_L / 16; ++sub) {
        const int tau0 = c * SCAN_L + sub * 16;
        const int tau = tau0 + tokl; const int t = d ? T - 1 - tau : tau; const size_t tok = (size_t)tokbase + t;
        __syncthreads();
        if (sub > 0) flush_y(sub - 1);
        {
            const int o = tokl * 64 + 4 * cg;
            const f32x4 a4 = *(LAS const f32x4*)(fAA + o), nk4 = *(LAS const f32x4*)(fNK + o), kc4 = *(LAS const f32x4*)(fKC + o), r4 = *(LAS const f32x4*)(fR + o);
            const f32x4 bb = -(nk4 * a4);
            const f32x4 kd = kc4 * ((a4 - 1.0f) * CWR(10) + 1.0f);
            *(LAS f32x4*)(fBB + o) = bb; *(LAS f32x4*)(fKD + o) = kd;
            { float cf = dot4(r4 * kd, CWR(11)); cf = row16_sum(cf);
              if (cg == 0) ((float*)(ws + WS_CC))[(tok * 2 + d) * 4 + h] = cf; }
            const f32x4 gi = *(LAS const f32x4*)(fW + o);
            const f32x4 gm = tokl > 0 ? *(LAS const f32x4*)(fW + o - 64) : (f32x4){1.f, 1.f, 1.f, 1.f};
            const f32x4 ig = (f32x4){rcp_f(gi[0]), rcp_f(gi[1]), rcp_f(gi[2]), rcp_f(gi[3])};
            const int ob = (tokl * 68 + 4 * cg) * 2;
            *(LAS u32x2*)(slot + SC_NT + ob) = pk4(gm * nk4); *(LAS u32x2*)(slot + SC_RT + ob) = pk4(gi * r4);
            *(LAS u32x2*)(slot + SC_BT + ob) = pk4(bb * ig);  *(LAS u32x2*)(slot + SC_KT + ob) = pk4(kd * ig);
        }
        __syncthreads();
        {
            const int k = jt & 63, ig = jt >> 6;
            const float g = ((LAS const float*)(slot + ((sub & 1) ? SC_GC2 : SC_GC)))[k];
            f32x4 bh, kh, vt;
#pragma unroll
            for (int e = 0; e < 4; ++e) { const int i = 4 * ig + e; const float sc = g * rcp_f(fW[i * 64 + k]); bh[e] = fBB[i * 64 + k] * sc; kh[e] = fKD[i * 64 + k] * sc; vt[e] = fV[i * 64 + k]; }
            const int ob = (k * 20 + 4 * ig) * 2;
            *(LAS u32x2*)(slot + SC_BHT + ob) = pk4(bh); *(LAS u32x2*)(slot + SC_KHT + ob) = pk4(kh); *(LAS u32x2*)(slot + SC_VT + ob) = pk4(vt);
        }
        {
            const int pi = (w4 - hw) & 3;
            LAS const unsigned char* Xa = slot + ((pi < 2) ? SC_NT : SC_RT) + (j16 * 68 + 4 * g4) * 2;
            LAS const unsigned char* Yb = slot + ((pi & 1) ? SC_KT : SC_BT) + (j16 * 68 + 4 * g4) * 2;
            f32x4 acc = (f32x4){0.f, 0.f, 0.f, 0.f};
            acc = mfma16(cat8(lds8(Xa), lds8(Xa + 32)), cat8(lds8(Yb), lds8(Yb + 32)), acc);
            acc = mfma16(cat8(lds8(Xa + 64), lds8(Xa + 96)), cat8(lds8(Yb + 64), lds8(Yb + 96)), acc);
#pragma unroll
            for (int q = 0; q < 4; ++q) { const int i = 4 * g4 + q; const bool keep = (pi < 2) ? (j16 < i) : (j16 <= i); const float v = keep ? acc[q] : 0.f;
                if (pi == 0) fA1[i * 16 + j16] = v;
                else *(LAS unsigned short*)(slot + (pi == 1 ? SC_A2 : (pi == 2 ? SC_B1 : SC_B2)) + (i * 20 + j16) * 2) = (unsigned short)(pk2(v, 0.f) & 0xffffu); }
            if (pi == 0) {
                LDS_WAIT();
                const int cT = lane >> 2, pT = lane & 3;
                f32x4 ts = (f32x4){0.f, 0.f, 0.f, 0.f};
#pragma unroll
                for (int i = 0; i < 16; ++i) { const f32x4 a4 = *(LAS const f32x4*)(fA1 + i * 16 + 4 * pT);
                    float part = dot4(a4, ts); part += dpp_f<0xB1>(part); part += dpp_f<0x4E>(part);
                    const float tic = part + (i == cT ? 1.f : 0.f);
                    if (pT == (i >> 2)) ts[i & 3] = tic; }
#pragma unroll
                for (int e = 0; e < 4; ++e) *(LAS unsigned short*)(slot + SC_TW + ((4 * pT + e) * 20 + cT) * 2) = (unsigned short)(pk2(ts[e], 0.f) & 0xffffu);
            }
        }
        __syncthreads();
        {
            const u32x2 z2 = (u32x2){0u, 0u};
            LAS const unsigned char* ntp = slot + SC_NT + (j16 * 68 + 4 * g4) * 2;
            LAS const unsigned char* rtp = slot + SC_RT + (j16 * 68 + 4 * g4) * 2;
            const bf16x8 nta0 = cat8(lds8(ntp), lds8(ntp + 32)), nta1 = cat8(lds8(ntp + 64), lds8(ntp + 96));
            const bf16x8 rta0 = cat8(lds8(rtp), lds8(rtp + 32)), rta1 = cat8(lds8(rtp + 64), lds8(rtp + 96));
            const u32x2 vf = lds8(slot + SC_VT + ((16 * w4 + j16) * 20 + 4 * g4) * 2);
            const bf16x8 a2f = cat8(lds8(slot + SC_A2 + (j16 * 20 + 4 * g4) * 2), z2);
            const bf16x8 b12 = cat8(lds8(slot + SC_B1 + (j16 * 20 + 4 * g4) * 2), lds8(slot + SC_B2 + (j16 * 20 + 4 * g4) * 2));
            const bf16x8 tf = cat8(lds8(slot + SC_TW + (j16 * 20 + 4 * g4) * 2), z2);
            const f32x4 z4 = (f32x4){0.f, 0.f, 0.f, 0.f};
            f32x4 gc[4];
#pragma unroll
            for (int blk = 0; blk < 4; ++blk) gc[blk] = *(LAS const f32x4*)((LAS const float*)(slot + ((sub & 1) ? SC_GC2 : SC_GC)) + 16 * blk + 4 * g4);
            bf16x8 af[4];
#pragma unroll
            for (int blk = 0; blk < 4; ++blk) af[blk] = cat8(lds8(slot + SC_BHT + ((16 * blk + j16) * 20 + 4 * g4) * 2), lds8(slot + SC_KHT + ((16 * blk + j16) * 20 + 4 * g4) * 2));
            {
                const bf16x8 sb0 = cat8(pk4(S[0]), pk4(S[1])), sb1 = cat8(pk4(S[2]), pk4(S[3]));
                f32x4 X = mfma16(nta0, sb0, z4); X = mfma16(nta1, sb1, X); X = mfma16(a2f, cat8(vf, z2), X);
                const f32x4 Z = mfma16(tf, cat8(pk4(X), z2), z4);
                const bf16x8 zv = cat8(pk4(Z), vf);
#pragma unroll
                for (int blk = 0; blk < 4; ++blk) S[blk] = mfma16(af[blk], zv, S[blk] * gc[blk]);
                { f32x4 Y = mfma16(rta0, sb0, z4); Y = mfma16(rta1, sb1, Y); Y = mfma16(b12, zv, Y);
#pragma unroll
                  for (int q = 0; q < 4; ++q) fYB[(4 * g4 + q) * 64 + 16 * w4 + j16] = Y[q]; }
            }
            if (PH1) {
                const bf16x8 pb0 = cat8(pk4(P[0]), pk4(P[1])), pb1 = cat8(pk4(P[2]), pk4(P[3]));
                f32x4 X = mfma16(nta0, pb0, z4); X = mfma16(nta1, pb1, X);
                const f32x4 Z = mfma16(tf, cat8(pk4(X), z2), z4);
                const bf16x8 zp = cat8(pk4(Z), z2);
#pragma unroll
                for (int blk = 0; blk < 4; ++blk) P[blk] = mfma16(af[blk], zp, P[blk] * gc[blk]);
                f32x4 Yp = mfma16(rta0, pb0, z4); Yp = mfma16(rta1, pb1, Yp); Yp = mfma16(b12, zp, Yp);
#pragma unroll
                for (int q = 0; q < 4; ++q) *(LAS unsigned short*)(slot + SC_YP + ((4 * g4 + q) * 64 + 16 * w4 + j16) * 2) = (unsigned short)(pk2(Yp[q], 0.f) & 0xffffu);
            }
        }
        if (sub + 1 < SCAN_L / 16) { stage_a(sub + 1); if (sub + 2 < SCAN_L / 16) issue_loads(sub + 2); }
    }
    __syncthreads();
    flush_y(SCAN_L / 16 - 1);
    if (PH1) {
        if (c < 15) {
            float* Pg = (float*)(ws + WS_SCAN) + (size_t)(chain * 14 + c - 1) * 2 * 4096; float* Qg = Pg + 4096;
#pragma unroll
            for (int blk = 0; blk < 4; ++blk) { const int o = (16 * w4 + j16) * 64 + 16 * blk + 4 * g4; *(f32x4*)(Pg + o) = P[blk]; *(f32x4*)(Qg + o) = S[blk]; }
        }
    } else {
        float* st = lat ? (float*)(ws + WS_S1) + (size_t)chain * 4096 : a.out + OUT_STATE + (size_t)((((b * 2 + l) * 2 + d) * 4 + h)) * 4096;
#pragma unroll
        for (int blk = 0; blk < 4; ++blk) *(f32x4*)(st + (16 * w4 + j16) * 64 + 16 * blk + 4 * g4) = S[blk];
    }
}

__device__ __forceinline__ void phase_scan1(CArgs& a, int l, LAS unsigned char* lds, int vcu, int G, int tid, int wave, int lane, int mode) {
    const int hw = wave >> 2, w4 = wave & 3, jt = tid & 255;
    for (int p = vcu; p < 640; p += G) {
        const int jid = 2 * p + hw;
        if (jid < 1024) { const int chain = jid >> 4, c = jid & 15; scan_job(a, l, lds + hw * SCAN_SLOT, true, chain >> 3, (chain >> 2) & 1, chain & 3, c, jt, w4, lane, mode, hw); }
        else { const int chain = jid - 1024; scan_job(a, l, lds + hw * SCAN_SLOT, false, chain >> 3, (chain >> 2) & 1, chain & 3, 0, jt, w4, lane, mode, hw); }
        __syncthreads();
    }
}
__device__ __forceinline__ void phase_scan2(CArgs& a, int l, LAS unsigned char* lds, int vcu, int G, int tid) {
    for (int chain = vcu; chain < 64; chain += G) {
        LAS float* Sl = (LAS float*)lds;
        LAS float* Pl = (LAS float*)(lds + 20480);
        const int row = tid >> 3, jc = tid & 7;
        const float* s0 = (const float*)(a.ws + WS_S1) + (size_t)chain * 4096 + row * 64 + 8 * jc;
        __syncthreads();
#pragma unroll
        for (int q = 0; q < 8; ++q) Sl[row * 65 + 8 * jc + q] = s0[q];
        f32x4 p0, p1, o0, o1;
        { const float* Pg = (const float*)(a.ws + WS_SCAN) + (size_t)(chain * 14) * 2 * 4096; const float* Qg = Pg + 4096;
          p0 = *(const f32x4*)(Pg + tid * 8); p1 = *(const f32x4*)(Pg + tid * 8 + 4); o0 = *(const f32x4*)(Qg + row * 64 + 8 * jc); o1 = *(const f32x4*)(Qg + row * 64 + 8 * jc + 4); }
        for (int c = 0; c < 14; ++c) {
            float* Pg = (float*)(a.ws + WS_SCAN) + (size_t)(chain * 14 + c) * 2 * 4096; float* Qg = Pg + 4096;
            *(LAS f32x4*)(Pl + tid * 8) = p0; *(LAS f32x4*)(Pl + tid * 8 + 4) = p1;
            f32x4 a0 = o0, a1 = o1;
            if (c + 1 < 14) { const float* Pn = Pg + 2 * 4096; const float* Qn = Pn + 4096;
                p0 = *(const f32x4*)(Pn + tid * 8); p1 = *(const f32x4*)(Pn + tid * 8 + 4); o0 = *(const f32x4*)(Qn + row * 64 + 8 * jc); o1 = *(const f32x4*)(Qn + row * 64 + 8 * jc + 4); }
            __syncthreads();
#pragma unroll 8
            for (int k = 0; k < 64; ++k) { const float s = Sl[row * 65 + k]; a0 += *(LAS const f32x4*)(Pl + k * 64 + 8 * jc) * s; a1 += *(LAS const f32x4*)(Pl + k * 64 + 8 * jc + 4) * s; }
            __syncthreads();
#pragma unroll
            for (int q = 0; q < 4; ++q) { Sl[row * 65 + 8 * jc + q] = a0[q]; Sl[row * 65 + 8 * jc + 4 + q] = a1[q]; }
            *(f32x4*)(Qg + row * 64 + 8 * jc) = a0; *(f32x4*)(Qg + row * 64 + 8 * jc + 4) = a1;
        }
        __syncthreads();
    }
}
__device__ __forceinline__ void phase_scan3(CArgs& a, int l, LAS unsigned char* lds, int vcu, int G, int tid, int wave, int lane, int mode) {
    (void)mode; (void)l;
    const int hw = wave >> 2, w4 = wave & 3, jt = tid & 255, g4 = lane >> 4, j16 = lane & 15, tokl = jt >> 4, cg = jt & 15;
    unsigned char* ws = a.ws;
    LAS float* fYB = (LAS float*)(lds + hw * 16384);
    for (int p = vcu; p < 480; p += G) {
        const int jid = 2 * p + hw; const int chain = jid / 15, c = 1 + jid % 15;
        const int b = chain >> 3, d = (chain >> 2) & 1, h = chain & 3;
        const float* ss = c == 1 ? (const float*)(ws + WS_S1) + (size_t)chain * 4096 : (const float*)(ws + WS_SCAN) + ((size_t)(chain * 14 + c - 2) * 2 + 1) * 4096;
        f32x4 S[4];
#pragma unroll
        for (int blk = 0; blk < 4; ++blk) S[blk] = *(const f32x4*)(ss + (16 * w4 + j16) * 64 + 16 * blk + 4 * g4);
        const bf16x8 sb0 = cat8(pk4(S[0]), pk4(S[1])), sb1 = cat8(pk4(S[2]), pk4(S[3]));
        const unsigned char* yp = scan_yp(ws, jid);
        bf16* Y = (bf16*)(ws + WS_Y);
#pragma unroll 1
        for (int sg = 0; sg < SCAN_L / 64; ++sg) {
            bf16x8 ya[4][2];
#pragma unroll
            for (int u = 0; u < 4; ++u) { const unsigned char* yr = yp + (4 * sg + u) * 2048 + (j16 * 64 + 4 * g4) * 2;
                ya[u][0] = cat8(*(const u32x2*)yr, *(const u32x2*)(yr + 32)); ya[u][1] = cat8(*(const u32x2*)(yr + 64), *(const u32x2*)(yr + 96)); }
            f32x4 yl[4]; bf16* yptr[4];
#pragma unroll
            for (int u = 0; u < 4; ++u) { const int tau = c * SCAN_L + (4 * sg + u) * 16 + tokl; const int t = d ? TL - 1 - tau : tau; const size_t tok = (size_t)NTC + b * TL + t;
                yptr[u] = Y + tok * 512 + d * 256 + h * 64 + 4 * cg; yl[u] = ldbf4(yptr[u]); }
#pragma unroll
            for (int u = 0; u < 4; ++u) { f32x4 C = mfma16(ya[u][0], sb0, (f32x4){0.f, 0.f, 0.f, 0.f}); C = mfma16(ya[u][1], sb1, C);
#pragma unroll
                for (int q = 0; q < 4; ++q) fYB[u * 1024 + (4 * g4 + q) * 64 + 16 * w4 + j16] = C[q]; }
            __syncthreads();
#pragma unroll
            for (int u = 0; u < 4; ++u) { const f32x4 y4 = yl[u] + *(LAS const f32x4*)(fYB + u * 1024 + tokl * 64 + 4 * cg); st4bf(yptr[u], y4[0], y4[1], y4[2], y4[3]); }
            __syncthreads();
        }
    }
}
__device__ __forceinline__ void phase_finish(CArgs& a, int l, int vcu, int G, int wave, int lane, bool dry) {
    const int gw = vcu * 8 + wave, NGW = G * 8;
    bf16* PA = (bf16*)(a.ws + WS_PA);
    const bf16* Y = (const bf16*)(a.ws + WS_Y); const float* CC = (const float*)(a.ws + WS_CC);
    const f32x4 lnw = *(const f32x4*)(a.in[22] + l * 256 + 4 * lane), lnb = *(const f32x4*)(a.in[23] + l * 256 + 4 * lane);
    const float* cw = a.in[14] + (size_t)l * 3 * 768 + 512 + 4 * lane;
    const f32x4 c0 = *(const f32x4*)cw, c1 = *(const f32x4*)(cw + 768), c2 = *(const f32x4*)(cw + 1536);
    const int head = lane >> 4;
    for (int tok0 = gw; tok0 < NTOK; tok0 += 2 * NGW) {
        f32x4 vp[2], vc[2], vn[2], yf[2], yb[2], gg[2]; float cfa[2], cfb[2]; bf16* rowp[2]; bool ok[2];
#pragma unroll
        for (int u = 0; u < 2; ++u) {
            const int tok = tok0 + u * NGW; ok[u] = tok < NTOK; const int tk = ok[u] ? tok : tok0;
            int t, T; if (tk < NTC) { t = tk & 255; T = TC; } else { t = (tk - NTC) & 4095; T = TL; }
            bf16* row = PA + (size_t)tk * LDA; rowp[u] = row;
            const f32x4 z = (f32x4){0.f, 0.f, 0.f, 0.f};
            vp[u] = t > 0 ? ldbf4(row - LDA + CA_V + 4 * lane) : z; vc[u] = ldbf4(row + CA_V + 4 * lane); vn[u] = t + 1 < T ? ldbf4(row + LDA + CA_V + 4 * lane) : z;
            yf[u] = ldbf4(Y + (size_t)tk * 512 + 4 * lane); yb[u] = ldbf4(Y + (size_t)tk * 512 + 256 + 4 * lane);
            cfa[u] = CC[((size_t)tk * 2 + 0) * 4 + head]; cfb[u] = CC[((size_t)tk * 2 + 1) * 4 + head];
            gg[u] = ldbf4(row + CA_GR + 4 * lane);
        }
#pragma unroll
        for (int u = 0; u < 2; ++u) {
            const f32x4 v_c = vp[u] * c0 + vc[u] * c1 + vn[u] * c2;
            const f32x4 o = yf[u] + yb[u];
            const float mu = row16_sum((o[0] + o[1]) + (o[2] + o[3])) * (1.f / 64.f);
            const f32x4 dlt = o - mu;
            const float var = row16_sum(dot4(dlt, dlt)) * (1.f / 64.f);
            const float rs = __builtin_amdgcn_rsqf(var + GN_EPS);
            const f32x4 on = dlt * rs * lnw + lnb + v_c * (cfa[u] + cfb[u]);
            const f32x4 g = gg[u];
            if (dry) { asm volatile("" :: "v"(on), "v"(g)); continue; }
            if (ok[u]) st4bf(rowp[u] + CA_GR + 4 * lane, on[0] * silu_f(g[0]), on[1] * silu_f(g[1]), on[2] * silu_f(g[2]), on[3] * silu_f(g[3]));
        }
    }
}

constexpr int NWAVES = 8;
#ifndef OUT_STAGGER_TICKS
#define OUT_STAGGER_TICKS 0
#endif
constexpr int RING_BYTES = 131072, LDSCTL_OFF = RING_BYTES, LDS_BYTES = 147456;
constexpr int N_PHASES = 2 + 8 * 2 - 1;

__global__ void __launch_bounds__(NWAVES * 64, 2) mk_fwd(Args args_) {
    extern __shared__ __attribute__((aligned(16))) unsigned char lds_raw[];
    LAS unsigned char* lds = (LAS unsigned char*)lds_raw;
    const int tid0 = threadIdx.x;
    const int G = gridDim.x; const int bx0 = blockIdx.x;
    const int vcu0 = (G % 8 == 0) ? (bx0 % 8) * (G / 8) + bx0 / 8 : bx0;
#define PHASE_IDS CArgs* ap_ = (CArgs*)__builtin_amdgcn_kernarg_segment_ptr(); asm volatile("" : "+s"(ap_)); CArgs& args = *ap_; int tid = tid0; asm volatile("" : "+v"(tid)); int vcu = vcu0, bx = bx0; asm volatile("" : "+s"(vcu), "+s"(bx)); (void)bx; const int lane = tid & 63; const int wave = __builtin_amdgcn_readfirstlane(tid >> 6); (void)lane; (void)wave;
    volatile LAS unsigned* MISC = (volatile LAS unsigned*)(lds + LDSCTL_OFF);
    for (int u = tid0; u < (LDS_BYTES - LDSCTL_OFF) / 4; u += NWAVES * 64) ((LAS unsigned*)(lds + LDSCTL_OFF))[u] = 0u;
    __syncthreads();
    XcdBarrier bar; bar.bar = (unsigned*)(args_.ws + WS_CTL) + 4096; bar.x = 0; bar.st = nullptr;
    const bool multi = (args_.ph_hi - args_.ph_lo) > 1;
    if (multi) bar = xcd_barrier_post((unsigned*)(args_.ws + WS_CTL) + 4096, MISC + 8);
    const int lo = args_.ph_lo, hi = args_.ph_hi;
#ifndef PH_MASK
#define PH_MASK 0x3ff
#endif
#define PHB(k) ((k) < 2 ? (k) : 2 + (((k) - 2) & 7))
#define IN(k) (((PH_MASK >> PHB(k)) & 1) && lo <= (k) && (k) < hi)
#define SEAM(k) do { if (IN(k) && IN((k) + 1)) { XcdBarrier b2_ = bar; asm volatile("" : "+s"(b2_.bar)); xcd_barrier(b2_); if (PROBE_DUP == 16) { xcd_barrier(b2_); xcd_barrier(b2_); } } } while (0)

    const int ATT_MOVED_LO = 768, ATT_MOVED_HI = (G == 256) ? 768 + 384 + 256 : 768;
#define REPS(id) int reps_ = 1 + (PROBE_DUP == (id) ? 1 : 0); asm volatile("" : "+s"(reps_));
    if (IN(0)) { PHASE_IDS phase_p0a(args, lds, vcu, G, tid, wave, lane); } SEAM(0);
    if (IN(1)) { PHASE_IDS phase_l1_tables(args, vcu, G, tid, wave, lane); REPS(7) for (int rep = 0; rep < reps_; ++rep) phase_norm(args, 0, vcu, G, wave, lane); } SEAM(1);
#pragma unroll 1
    for (int L = 0; L < 2; ++L) {
        const int pb = 2 + 8 * L;
        if (IN(pb + 0)) { PHASE_IDS
            pg8::Gemm g{(const pg8::bf16_t*)(args.ws + WS_H), (const pg8::bf16_t*)(args.ws + WS_WIN) + (size_t)L * NPROJ * DM, NTOK, NPROJ, DM, DM};
            pg8::StaticOrder S; S.init(NTOK, NPROJ, G, bx);
            if (L == 0 || G != 256) {
                pg8::EpiProjT<false> E{ap_, nullptr, L};
                REPS(1) for (int rep = 0; rep < reps_; ++rep) pg8::gemm_phase<pg8::EpiProjT<false>, pg8::StaticOrder, true, true>(lds, g, S, E);
            } else {
                LAS float* T = (LAS float*)(lds + LDSCTL_OFF + 8192);
                pg8::Unit u0; (void)S.next(0, u0);
                const float* part = (const float*)(args.ws + WS_PART);
#pragma unroll 1
                for (int j = 0; j < 4; ++j) { const int pm = u0.pm + 8 * j;
                    if (tid == 0) ((LAS int*)T)[j] = pm < NTOK / 256 ? pm : -1;
                    if (pm < NTOK / 256 && tid < 256) { float s = 0.f;
#pragma unroll 8
                        for (int q = 0; q < 32; ++q) s += part[(size_t)q * NTOK + pm * 256 + tid];
                        T[64 + 256 * j + tid] = __builtin_amdgcn_rsqf(s * (1.f / 1024.f) + EPS); } }
                __syncthreads();
                pg8::EpiProjT<true> E{ap_, T, L};
                pg8::gemm_phase<pg8::EpiProjT<true>, pg8::StaticOrder, true, true>(lds, g, S, E);
            }
        } SEAM(pb + 0);
        if (IN(pb + 1)) { PHASE_IDS REPS(2) for (int rep = 0; rep < reps_; ++rep) phase_p2(args, L, lds, vcu, G, tid, wave, lane, rep + 1 < reps_); } SEAM(pb + 1);
        if (IN(pb + 2)) { PHASE_IDS
            { REPS(3) for (int rep = 0; rep < reps_; ++rep) phase_scan1(args, L, lds, vcu, G, tid, wave, lane, 0); }
            if (G == 256 && vcu >= 128) { for (int k = 0; k < 2; ++k) attn_dispatch(args, L, ATT_MOVED_LO + 384 + 2 * (vcu - 128) + k, lds, tid, 0); }
        } SEAM(pb + 2);
        if (IN(pb + 3)) { PHASE_IDS phase_scan2(args, L, lds, vcu, G, tid);
            if (G == 256 && vcu >= 64) { for (int k = 0; k < 2; ++k) attn_dispatch(args, L, ATT_MOVED_LO + 2 * (vcu - 64) + k, lds, tid, 0); } } SEAM(pb + 3);
        if (IN(pb + 4)) { PHASE_IDS
            { REPS(5) for (int rep = 0; rep < reps_; ++rep) phase_scan3(args, L, lds, vcu, G, tid, wave, lane, 0); }
            {
                unsigned* ctr = (unsigned*)(args.ws + WS_CTL) + 2048 + 64 * L; const int nrest = ATT_UNITS - ATT_MOVED_HI;
                for (int it = 0;; ++it) {
                    int u = vcu + it * G;
                    if (u >= 768) {
                        if (tid == 0) MISC[16] = __hip_atomic_fetch_add(ctr, 1u, __ATOMIC_RELAXED, __HIP_MEMORY_SCOPE_AGENT);
                        __syncthreads(); const int idx = (int)MISC[16]; __syncthreads();
                        if (idx >= nrest) break;
                        u = ATT_MOVED_HI + idx;
                    }
                    attn_dispatch(args, L, u, lds, tid, 0);
                } }
        } SEAM(pb + 4);
        if (IN(pb + 5)) { PHASE_IDS REPS(8) for (int rep = 0; rep < reps_; ++rep) phase_finish(args, L, vcu, G, wave, lane, rep + 1 < reps_); } SEAM(pb + 5);
        if (IN(pb + 6)) { PHASE_IDS (void)tid;
            pg8::Gemm g{(const pg8::bf16_t*)(args.ws + WS_PA), (const pg8::bf16_t*)(args.ws + WS_WOUT) + (size_t)L * DM * DM, NTOK, DM, DM, LDA};
            pg8::StaticOrder S; S.init(NTOK, DM, G, bx);
            if (G == 256) {
                pg8::HalfOrder S2{bx};
                if (L == 0) {
                    pg8::EpiOut0 E{args.in[0], args.in[1], args.out + OUT_Y, (const float*)(args.ws + WS_MOD), (const float*)(args.ws + WS_S1T), (pg8::bf16_t*)(args.ws + WS_H), (float*)(args.ws + WS_PART)};
                    pg8::gemm_phase<pg8::EpiOut0, pg8::HalfOrder, true, true>(lds, g, S2, E);
                } else {
                    pg8::EpiOut E{args.out + OUT_Y, args.out + OUT_Y + (size_t)NTC * DM, args.out + OUT_Y, (const float*)(args.ws + WS_MOD) + (size_t)9 * 3072};
                    pg8::gemm_phase<pg8::EpiOut, pg8::HalfOrder, true, true>(lds, g, S2, E);
                }
            } else {
                const float* x0 = L == 0 ? args.in[0] : args.out + OUT_Y; const float* x1 = L == 0 ? args.in[1] : args.out + OUT_Y + (size_t)NTC * DM;
                pg8::EpiOut E{x0, x1, args.out + OUT_Y, (const float*)(args.ws + WS_MOD) + (size_t)L * 9 * 3072};
                pg8::gemm_phase<pg8::EpiOut, pg8::StaticOrder, true, true>(lds, g, S, E);
            }
        } SEAM(pb + 6);
        if (L == 0 && G != 256) { if (IN(pb + 7)) { PHASE_IDS phase_norm(args, 1, vcu, G, wave, lane); } SEAM(pb + 7); }
    }
#undef IN
#undef SEAM
}

extern "C" void kernel_launch(void* const* d_in, const int* in_sizes, int n_in, void* d_out, int out_size, void* d_ws, size_t ws_size, hipStream_t stream) {
    static int grid = 0;
    if (grid == 0) {
        if (n_in != 34 || ws_size < WS_END) { fprintf(stderr, "kernel_launch: expected 34 inputs and >= %zu bytes of workspace (got %d, %zu)\n", (size_t)WS_END, n_in, ws_size); grid = -1; return; }
        int dev = 0, cus = 0;
        if (hipGetDevice(&dev) != hipSuccess || hipDeviceGetAttribute(&cus, hipDeviceAttributeMultiprocessorCount, dev) != hipSuccess) { grid = -1; return; }
        if (hipFuncSetAttribute((const void*)mk_fwd, hipFuncAttributeMaxDynamicSharedMemorySize, LDS_BYTES) != hipSuccess) { fprintf(stderr, "kernel_launch: hipFuncSetAttribute failed\n"); grid = -1; return; }
        int per_cu = 0;
        if (hipOccupancyMaxActiveBlocksPerMultiprocessor(&per_cu, (const void*)mk_fwd, NWAVES * 64, LDS_BYTES) != hipSuccess || per_cu < 1) fprintf(stderr, "kernel_launch: occupancy query reports %d\n", per_cu);
        (void)hipGetLastError();
        grid = cus;
    }
    if (grid < 0) return;
    (void)hipMemsetAsync((char*)d_ws + WS_CTL, 0, CTL_ZERO_BYTES, stream);
    Args a{};
    for (int i = 0; i < 34; ++i) a.in[i] = (const float*)d_in[i];
    a.out = (float*)d_out; a.ws = (unsigned char*)d_ws;
#if MK_ONE_LAUNCH
    a.ph_lo = 0; a.ph_hi = N_PHASES;
    hipLaunchKernelGGL(mk_fwd, dim3(grid), dim3(NWAVES * 64), LDS_BYTES, stream, a);
#else
    for (int p = 0; p < N_PHASES; ++p) { a.ph_lo = p; a.ph_hi = p + 1; hipLaunchKernelGGL(mk_fwd, dim3(grid), dim3(NWAVES * 64), LDS_BYTES, stream, a); }
#endif
}
```

```cpp
#include <hip/hip_runtime.h>
#include <cstdio>
#include <cstdint>

#ifndef PROBE_DUP
#define PROBE_DUP 0
#endif
#ifndef MK_ONE_LAUNCH
#define MK_ONE_LAUNCH 1
#endif

#define GAS __attribute__((address_space(1)))
#define LAS __attribute__((address_space(3)))
typedef unsigned short bf16;
typedef short bf16x8 __attribute__((ext_vector_type(8)));
typedef short s16x4 __attribute__((ext_vector_type(4)));
typedef float f32x2 __attribute__((ext_vector_type(2)));
typedef float f32x4 __attribute__((ext_vector_type(4)));
typedef float f32x16 __attribute__((ext_vector_type(16)));
typedef unsigned u32x2 __attribute__((ext_vector_type(2)));
typedef unsigned u32x4 __attribute__((ext_vector_type(4)));
typedef __bf16 bf16x2_t __attribute__((ext_vector_type(2)));

constexpr int DM = 1024;
constexpr int NTC = 8192, NTL = 32768, NTOK = 40960;
constexpr int TC = 256, TL = 4096;
constexpr int NPROJ = 3584;
constexpr int LDA = 3072, LDB = 512;
constexpr int CA_GR = 0, CA_GN = 256, CA_GM = 640, CA_R = 1024, CA_K = 1280, CA_V = 1536, CA_QN = 1792, CA_KN = 2176, CA_VN = 2560, CA_WD = 2944, CA_AD = 3008;
constexpr int CB_CQ = 0, CB_CKV = 256, CB_KR = 384;
constexpr float LOG2E = 1.4426950408889634f;
constexpr float EPS = 1e-6f, GN_EPS = 64e-5f;
constexpr float MLA_SCALE = 0.10206207261596575f;
constexpr int SCAN_L = 256;
constexpr int NCHUNK_L = TL / SCAN_L;

constexpr size_t MiB = 1u << 20;
constexpr size_t WS_CTL = 0, CTL_ZERO_BYTES = 1 * MiB;
constexpr size_t WS_MOD = 1 * MiB;
constexpr size_t WS_S1T = WS_MOD + 256 * 1024;
constexpr size_t WS_C1 = WS_MOD + 320 * 1024;
constexpr size_t WS_ABND = WS_MOD + 480 * 1024;
constexpr size_t WS_WIN = 2 * MiB;
constexpr size_t WS_WOUT = 16 * MiB;
constexpr size_t WS_WUQ = 20 * MiB;
constexpr size_t WS_WUKV = 21 * MiB;
constexpr size_t WS_LORA = 21 * MiB + 512 * 1024;
constexpr size_t WS_NACK = 22 * MiB, WS_NACV = 28 * MiB;
constexpr size_t WS_CK = 34 * MiB, WS_CV = 39 * MiB;
constexpr size_t WS_CC = 42 * MiB;
constexpr size_t WS_Q = 44 * MiB;
constexpr size_t WS_Y = 90 * MiB;
constexpr size_t WS_PART = WS_Y;
constexpr size_t WS_H = 130 * MiB;
constexpr size_t WS_MK = WS_H, WS_MV = WS_H + 45 * MiB;
constexpr size_t WS_PB = 210 * MiB;
constexpr size_t WS_SCAN = WS_PB;
constexpr size_t WS_PA = 250 * MiB;
constexpr size_t WS_S1 = WS_PB + 28 * MiB;
constexpr size_t WS_YPB = WS_PB + 29 * MiB;
constexpr size_t WS_YPA = 490 * MiB;
constexpr size_t WS_END = 512 * MiB;

constexpr size_t OUT_Y = 0, OUT_STATE = 41943040, OUT_NAK = 44040192, OUT_NAV = 50331648, OUT_CKV = 56623104, OUT_KROPE = 58720256;

struct Args { const float* in[34]; float* out; unsigned char* ws; int ph_lo, ph_hi; };
typedef const __attribute__((address_space(4))) Args CArgs;

__device__ __forceinline__ float bf2f(unsigned short b) { return __uint_as_float(((unsigned)b) << 16); }
__device__ __forceinline__ unsigned pk2(float lo, float hi) { f32x2 v = {lo, hi}; bf16x2_t b = __builtin_convertvector(v, bf16x2_t); return __builtin_bit_cast(unsigned, b); }
__device__ __forceinline__ float lo_f(unsigned u) { return __uint_as_float(u << 16); }
__device__ __forceinline__ float hi_f(unsigned u) { return __uint_as_float(u & 0xffff0000u); }
__device__ __forceinline__ int crow(int r, int hi) { return (r & 3) + 8 * (r >> 2) + 4 * hi; }
__device__ __forceinline__ float rcp_f(float x) { return __builtin_amdgcn_rcpf(x); }
__device__ __forceinline__ float silu_f(float x) { return x * rcp_f(1.f + __expf(-x)); }
__device__ __forceinline__ float sigmoid_f(float x) { return rcp_f(1.f + __expf(-x)); }
template <int CTRL> __device__ __forceinline__ float dpp_f(float x) { return __int_as_float(__builtin_amdgcn_update_dpp(0, __float_as_int(x), CTRL, 0xf, 0xf, true)); }
__device__ __forceinline__ float row16_sum(float x) { x += dpp_f<0xB1>(x); x += dpp_f<0x4E>(x); x += dpp_f<0x141>(x); x += dpp_f<0x140>(x); return x; }
__device__ __forceinline__ float xor32_sum(float x) { const auto r = __builtin_amdgcn_permlane32_swap(__float_as_uint(x), __float_as_uint(x), false, false); return __uint_as_float(r[0]) + __uint_as_float(r[1]); }
__device__ __forceinline__ float xor32_max(float x) { const auto r = __builtin_amdgcn_permlane32_swap(__float_as_uint(x), __float_as_uint(x), false, false); return fmaxf(__uint_as_float(r[0]), __uint_as_float(r[1])); }
__device__ __forceinline__ float wave64_sum(float x) { x = row16_sum(x); const auto r = __builtin_amdgcn_permlane16_swap(__float_as_uint(x), __float_as_uint(x), false, false); x = __uint_as_float(r[0]) + __uint_as_float(r[1]); return xor32_sum(x); }
__device__ __forceinline__ float ss8(bf16x8 v) { float s = 0.f;
#pragma unroll
    for (int j = 0; j < 8; ++j) { const float f = bf2f((unsigned short)v[j]); s += f * f; } return s; }
#define LDS_WAIT() asm volatile("s_waitcnt lgkmcnt(0)" ::: "memory")
#define VM_WAIT() asm volatile("s_waitcnt vmcnt(0)" ::: "memory")

__device__ __forceinline__ const float* x_row0(CArgs& a, int tok) { return tok < NTC ? a.in[0] + (size_t)tok * DM : a.in[1] + (size_t)(tok - NTC) * DM; }
__device__ __forceinline__ int mod_idx(int tok) { return tok < NTC ? 0 : 1 + ((tok - NTC) >> 12); }

namespace pg8 {
#define PG8_LAS __attribute__((address_space(3)))
typedef unsigned short bf16_t;
typedef short bf16x8 __attribute__((ext_vector_type(8)));
typedef float f32x4 __attribute__((ext_vector_type(4)));
typedef unsigned u32x4 __attribute__((ext_vector_type(4)));
constexpr int BM = 256, BK = 64, HALF = 128, HTB = HALF * BK * 2  , STAGE_BYTES = 8 * HTB, NXCD = 8, WGM = 8;

__host__ __device__ __forceinline__ int lds_byte(int r, int c) { const int st = (r >> 4) * 2 + (c >> 5), rr = r & 15, cc = c & 31, ob = rr * 64 + cc * 2; return st * 1024 + (ob ^ (((ob >> 9) & 1) << 5)); }
__host__ __device__ __forceinline__ void stage_rc(int b, int& R, int& C) { const int st = b / 1024, sb = b % 1024, swz = sb ^ (((sb >> 9) & 1) << 5); R = (st >> 1) * 16 + swz / 64; C = (st & 1) * 32 + (swz % 64) / 2; }
__host__ __device__ __forceinline__ int perm32(int rho) { const int n = rho >> 4, i = rho & 15; return 8 * (i >> 2) + 4 * n + (i & 3); }

struct Unit { int pm, pn, bh; };
struct Gemm { const bf16_t* A; const bf16_t* Bt; int M, N, K, lda; };

struct StaticOrder {
    int nM, nN, nwg, G, c;
    __host__ __device__ void init(int M, int N, int G_, int c_) { nM = M / BM; nN = N / BM; nwg = nM * nN; G = G_; c = c_; }
    __host__ __device__ __forceinline__ bool next(int i, Unit& u) const {
        u.bh = 0;
        const long L = (long)i * G + c; if (L >= nwg) return false;
        int wgid = (int)L; { const int q = nwg / NXCD, r = nwg % NXCD, xcd = wgid % NXCD, off = wgid / NXCD; wgid = (xcd < r ? xcd * (q + 1) : r * (q + 1) + (xcd - r) * q) + off; }
        const int nig = WGM * nN, gid = wgid / nig, fm = gid * WGM, gsz = (nM - fm) < WGM ? (nM - fm) : WGM;
        u.pm = fm + ((wgid % nig) % gsz); u.pn = (wgid % nig) / gsz; return true;
    }
    __device__ __forceinline__ void a_ready(const Unit&) const {}
    __device__ __forceinline__ void done(const Unit&) const {}
};

struct HalfOrder {
    int c;
    __host__ __device__ __forceinline__ bool next(int i, Unit& u) const {
        if (i > 2) return false;
        if (i == 2) { const int x = c % NXCD, j = c / NXCD; u.pm = 128 + 4 * x + (j & 3); u.pn = (j >> 2) & 3; u.bh = 1 + (j >> 4); return true; }
        const int L = i * 256 + c; const int wgid = (L % NXCD) * 64 + L / NXCD;
        u.pm = (wgid / 32) * WGM + (wgid % 32) % WGM; u.pn = (wgid % 32) / WGM; u.bh = 0; return true;
    }
    __device__ __forceinline__ void a_ready(const Unit&) const {}
    __device__ __forceinline__ void done(const Unit&) const {}
};
__device__ __forceinline__ unsigned cvt_pk_bf16(float lo, float hi) { unsigned r; asm volatile("v_cvt_pk_bf16_f32 %0, %1, %2" : "=v"(r) : "v"(lo), "v"(hi)); return r; }
struct EpiOut {
    static constexpr bool PERM = false, AFTER_DRAIN = false, PREFETCH = false;
    const float* x0; const float* x1; float* out; const float* mod;
#if PROBE_DUP == 26
    int live;
#endif
    __device__ __forceinline__ void operator()(const f32x4 (&acc)[2][2][4][2], const Unit& u, int wr, int wc, int fr, int fq) const {
#if PROBE_DUP == 26
        if (!live) return;
#endif
        const int rowt = u.pm * BM;
        const int mi = rowt < 8192 ? 0 : 1 + ((rowt - 8192) >> 12);
        const float* gate = mod + mi * 3072 + 2048;
        const int col0 = u.pn * BM + (u.bh == 2 ? HALF : 0) + wc * 32 + 4 * fq;
        const int nbj = u.bh ? 1 : 2;
        f32x4 gv[2][2];
#pragma unroll
        for (int bj = 0; bj < 2; ++bj)
#pragma unroll
            for (int n = 0; n < 2; ++n) gv[bj][n] = *(const f32x4*)(gate + col0 + bj * HALF + n * 16);
#pragma unroll
        for (int ai = 0; ai < 2; ++ai)
#pragma unroll
            for (int m = 0; m < 4; ++m) { const int row = rowt + ai * HALF + wr * 64 + m * 16 + fr;
                const float* xr = row < 8192 ? x0 + (size_t)row * 1024 : x1 + (size_t)(row - 8192) * 1024;
                float* orow = out + (size_t)row * 1024;
#pragma unroll
                for (int bj = 0; bj < 2; ++bj) { if (bj < nbj) {
#pragma unroll
                    for (int n = 0; n < 2; ++n) { const int c = col0 + bj * HALF + n * 16; const f32x4 xv = *(const f32x4*)(xr + c);
                        *(f32x4*)(orow + c) = xv + gv[bj][n] * acc[ai][bj][m][n]; } } } }
    }
};


__device__ __forceinline__ float fq_sum(float x) { const auto r = __builtin_amdgcn_permlane16_swap(__float_as_uint(x), __float_as_uint(x), false, false); x = __uint_as_float(r[0]) + __uint_as_float(r[1]);
    const auto q = __builtin_amdgcn_permlane32_swap(__float_as_uint(x), __float_as_uint(x), false, false); return __uint_as_float(q[0]) + __uint_as_float(q[1]); }
struct EpiOut0 {
    static constexpr bool PERM = true, AFTER_DRAIN = false;
    const float* x0; const float* x1; float* out; const float* mod;
    const float* s1; bf16_t* H; float* part;
    __device__ __forceinline__ void operator()(const f32x4 (&acc)[2][2][4][2], const Unit& u, int wr, int wc, int fr, int fq) const {
        const int rowt = u.pm * BM;
        const int mi = rowt < 8192 ? 0 : 1 + ((rowt - 8192) >> 12);
        const int colb = u.pn * BM + (u.bh == 2 ? HALF : 0) + wc * 32 + 8 * fq;
        const int nbj = u.bh ? 1 : 2;
        const float* gate = mod + mi * 3072 + 2048 + colb; const float* sv = s1 + mi * 1024 + colb;
        f32x4 gv[2][2];
#pragma unroll
        for (int bj = 0; bj < 2; ++bj) { if (bj < nbj) {
#pragma unroll
            for (int n = 0; n < 2; ++n) gv[bj][n] = *(const f32x4*)(gate + bj * HALF + 4 * n); } }
        const int slot = u.pn * 8 + (u.bh == 2 ? 4 : 0) + wc;
        float* pslot = part + (size_t)slot * 40960;
#pragma unroll
        for (int ai = 0; ai < 2; ++ai)
#pragma unroll
            for (int m = 0; m < 4; ++m) { const int row = rowt + ai * HALF + wr * 64 + m * 16 + fr;
                const float* xr = (row < 8192 ? x0 + (size_t)row * 1024 : x1 + (size_t)(row - 8192) * 1024) + colb;
                float* orow = out + (size_t)row * 1024 + colb; bf16_t* hrow = H + (size_t)row * 1024 + colb;
                float s = 0.f;
#pragma unroll
                for (int bj = 0; bj < 2; ++bj) { if (bj < nbj) {
                    const f32x4 y0 = *(const f32x4*)(xr + bj * HALF) + gv[bj][0] * acc[ai][bj][m][0], y1 = *(const f32x4*)(xr + bj * HALF + 4) + gv[bj][1] * acc[ai][bj][m][1];
                    *(f32x4*)(orow + bj * HALF) = y0; *(f32x4*)(orow + bj * HALF + 4) = y1;
                    s += ((y0[0] * y0[0] + y0[1] * y0[1]) + (y0[2] * y0[2] + y0[3] * y0[3])) + ((y1[0] * y1[0] + y1[1] * y1[1]) + (y1[2] * y1[2] + y1[3] * y1[3]));
                    const f32x4 a0 = y0 * *(const f32x4*)(sv + bj * HALF), a1 = y1 * *(const f32x4*)(sv + bj * HALF + 4);
                    u32x4 w; w.x = cvt_pk_bf16(a0[0], a0[1]); w.y = cvt_pk_bf16(a0[2], a0[3]); w.z = cvt_pk_bf16(a1[0], a1[1]); w.w = cvt_pk_bf16(a1[2], a1[3]);
                    *(u32x4*)(hrow + bj * HALF) = w; } }
                const float t = fq_sum(s);
                if (fq == 0) { pslot[row] = t; if (u.bh == 0) pslot[4 * 40960 + row] = 0.f; } }
    }
};
template <bool L1>
struct EpiProjT {
    static constexpr bool PERM = true, AFTER_DRAIN = false;
    CArgs* ap; PG8_LAS const float* T; int l;
    __device__ __forceinline__ void operator()(const f32x4 (&acc)[2][2][4][2], const Unit& u, int wr, int wc, int fr, int fq) const {
        CArgs* ap_ = ap; asm volatile("" : "+s"(ap_)); CArgs& a = *ap_;
        bf16_t* PA = (bf16_t*)(a.ws + WS_PA); bf16_t* PB = (bf16_t*)(a.ws + WS_PB); const float* c1 = (const float*)(a.ws + WS_C1);
        const float* qw = a.in[24] + l * 64; const float* kw = a.in[25] + l * 64; float* nak = a.out + OUT_NAK; float* nav = a.out + OUT_NAV;
        const int rowt = u.pm * BM; const int row0 = rowt + wr * 64 + fr;
        const int col0 = wc * 32 + 8 * fq;
        f32x4 cv[2][2]; const PG8_LAS float* rs = T;
        if constexpr (L1) {
            const int mi = rowt < 8192 ? 0 : 1 + ((rowt - 8192) >> 12);
            const PG8_LAS int* Tp = (const PG8_LAS int*)T;
            const int j = (u.pm == Tp[1]) ? 1 : ((u.pm == Tp[2]) ? 2 : ((u.pm == Tp[3]) ? 3 : 0));
            rs = T + 64 + 256 * j + wr * 64 + fr;
            const float* cp = c1 + mi * 3584 + u.pn * 256 + col0;
#pragma unroll
            for (int bj = 0; bj < 2; ++bj)
#pragma unroll
                for (int n = 0; n < 2; ++n) cv[bj][n] = *(const f32x4*)(cp + bj * HALF + 4 * n);
        }
        const bool ctx = rowt < 8192;
        if (u.pn >= 7 && u.pn <= 9) {
            const int hq = 4 * (u.pn - 7) + wc; const bool isq = hq < 6;
            const float* gwp = (isq ? qw : kw) + 8 * fq; const float sc0 = isq ? 0.125f * 1.4426950408889634f : 1.0f;
            f32x4 gv[2][2];
#pragma unroll
            for (int bj = 0; bj < 2; ++bj)
#pragma unroll
                for (int n = 0; n < 2; ++n) gv[bj][n] = *(const f32x4*)(gwp + 32 * bj + 4 * n) * sc0;
            const int ncol = 1792 + 64 * hq + 8 * fq;
#pragma unroll
            for (int ai = 0; ai < 2; ++ai)
#pragma unroll
                for (int m = 0; m < 4; ++m) { const int row = row0 + ai * HALF + m * 16;
                    f32x4 v[2][2]; float ss = 0.f;
#pragma unroll
                    for (int bj = 0; bj < 2; ++bj)
#pragma unroll
                        for (int n = 0; n < 2; ++n) { f32x4 x = acc[ai][bj][m][n]; if constexpr (L1) x = x * rs[ai * HALF + m * 16] + cv[bj][n];
                            v[bj][n] = x; ss += (x[0] * x[0] + x[1] * x[1]) + (x[2] * x[2] + x[3] * x[3]); }
                    ss = fq_sum(ss);
                    const float r = __builtin_amdgcn_rsqf(ss * (1.f / 64.f) + 1e-6f);
                    bf16_t* rowp = PA + (size_t)row * 3072 + ncol;
                    float* kc = nak + ((size_t)((row >> 8) * 2 + l) * 256 + (row & 255)) * 384 + (hq - 6) * 64 + 8 * fq;
#pragma unroll
                    for (int bj = 0; bj < 2; ++bj) { const f32x4 o0 = v[bj][0] * r * gv[bj][0], o1 = v[bj][1] * r * gv[bj][1];
                        u32x4 w; w.x = cvt_pk_bf16(o0[0], o0[1]); w.y = cvt_pk_bf16(o0[2], o0[3]); w.z = cvt_pk_bf16(o1[0], o1[1]); w.w = cvt_pk_bf16(o1[2], o1[3]);
                        *(u32x4*)(rowp + 32 * bj) = w;
                        if (ctx && !isq) { *(f32x4*)(kc + 32 * bj) = o0; *(f32x4*)(kc + 32 * bj + 4) = o1; } } }
            return;
        }
        bf16_t* base; int ldc;
        if (u.pn < 12) { base = PA + u.pn * 256; ldc = 3072; } else { base = PB + (u.pn - 12) * 256; ldc = 512; }
        const bool vtile = ctx && (u.pn == 10 || u.pn == 11);
        const bool wdt = u.pn == 11 && wc < 2;
#pragma unroll
        for (int ai = 0; ai < 2; ++ai)
#pragma unroll
            for (int m = 0; m < 4; ++m) { const int row = row0 + ai * HALF + m * 16; bf16_t* rowp = base + (size_t)row * ldc + col0;
                float* vc = nav + ((size_t)((row >> 8) * 2 + l) * 256 + (row & 255)) * 384 + (u.pn - 10) * 256 + col0;
#pragma unroll
                for (int bj = 0; bj < 2; ++bj) { f32x4 v0 = acc[ai][bj][m][0], v1 = acc[ai][bj][m][1];
                    if constexpr (L1) { const float r = rs[ai * HALF + m * 16]; v0 = v0 * r + cv[bj][0]; v1 = v1 * r + cv[bj][1]; }
                    if (wdt && bj == 1) {
#pragma unroll
                        for (int i = 0; i < 4; ++i) { v0[i] = 1.f - 2.f * __builtin_amdgcn_rcpf(1.f + __expf(2.f * v0[i])); v1[i] = 1.f - 2.f * __builtin_amdgcn_rcpf(1.f + __expf(2.f * v1[i])); } }
                    u32x4 w; w.x = cvt_pk_bf16(v0[0], v0[1]); w.y = cvt_pk_bf16(v0[2], v0[3]); w.z = cvt_pk_bf16(v1[0], v1[1]); w.w = cvt_pk_bf16(v1[2], v1[3]);
                    *(u32x4*)(rowp + bj * HALF) = w;
                    if (vtile && (u.pn == 10 || bj == 0)) { *(f32x4*)(vc + bj * HALF) = v0; *(f32x4*)(vc + bj * HALF + 4) = v1; } } }
    }
};
template <class Epi, class Sched, bool ALIGN_EPI = false, bool SP2 = false>
__device__ __forceinline__ void gemm_phase(PG8_LAS unsigned char* lds, const Gemm g, const Sched& S, const Epi& E) {
    int tid_ = threadIdx.x; asm volatile("" : "+v"(tid_));
    const int tid = tid_, wid = __builtin_amdgcn_readfirstlane(tid >> 6), lane = tid & 63, wr = wid >> 2, wc = wid & 3, fr = lane & 15, fq = lane >> 4;
    const int K = g.K, nt = K / BK;
    unsigned voffA[2], voffB[2];
#pragma unroll
    for (int i = 0; i < 2; ++i) { int R, C; stage_rc(tid * 16 + i * 8192, R, C); const int Rb = Epi::PERM ? ((R & ~31) + perm32(R & 31)) : R;
        voffA[i] = (unsigned)(R * g.lda + C) * 2u; voffB[i] = (unsigned)(Rb * K + C) * 2u; }
    const size_t kstep = (size_t)(BK * 2);
    const size_t hstepA = (size_t)HALF * g.lda * 2, hstepB = (size_t)HALF * K * 2;
    const size_t tstepA = 2 * hstepA, tstepB = 2 * hstepB;
    const unsigned ldsw = (unsigned)wid * 1024u;
    const int aoff = lds_byte(wr * 64 + fr, fq * 8), boff = lds_byte(wc * 32 + fr, fq * 8);
#define PG8_SA(b, h) (((b) * 2 + (h)) * HTB)
#define PG8_SB(b, h) ((4 + (b) * 2 + (h)) * HTB)
#define PG8_STAGE(bufoff, gbase, voff) do { _Pragma("unroll") for (int _i = 0; _i < 2; ++_i) \
        __builtin_amdgcn_global_load_lds((const unsigned*)((const char*)(gbase) + (voff)[_i]), (PG8_LAS unsigned*)(lds + (bufoff) + ldsw + _i * 8192), 16, 0, 0); } while (0)
#define PG8_LDA(dst, b, h) do { _Pragma("unroll") for (int m = 0; m < 4; ++m) _Pragma("unroll") for (int k = 0; k < 2; ++k) dst[m][k] = *(const PG8_LAS bf16x8*)(lds + PG8_SA(b, h) + aoff + m * 2048 + k * 1024); } while (0)
#define PG8_LDB(dst, b, h) do { _Pragma("unroll") for (int n = 0; n < 2; ++n) _Pragma("unroll") for (int k = 0; k < 2; ++k) dst[n][k] = *(const PG8_LAS bf16x8*)(lds + PG8_SB(b, h) + boff + n * 2048 + k * 1024); } while (0)
#define PG8_MMA(ai, bj, At, Bt) do { __builtin_amdgcn_s_setprio(1); _Pragma("unroll") for (int m = 0; m < 4; ++m) _Pragma("unroll") for (int n = 0; n < 2; ++n) _Pragma("unroll") for (int k = 0; k < 2; ++k) \
        acc[ai][bj][m][n] = __builtin_amdgcn_mfma_f32_16x16x32_bf16(Bt[n][k], At[m][k], acc[ai][bj][m][n], 0, 0, 0); __builtin_amdgcn_s_setprio(0); } while (0)
#define PG8_WAIT_V(n) asm volatile("s_waitcnt vmcnt(" #n ")" ::: "memory")
#define PG8_WAIT_L(n) asm volatile("s_waitcnt lgkmcnt(" #n ")" ::: "memory")
#define PG8_BAR __builtin_amdgcn_s_barrier()
#define PG8_SCHED __builtin_amdgcn_sched_barrier(0)
    Unit cur, nxt; int ui = 0;
    if (!S.next(0, cur)) return;
    f32x4 acc[2][2][4][2];
#pragma unroll
    for (int a = 0; a < 2; ++a)
#pragma unroll
        for (int b = 0; b < 2; ++b)
#pragma unroll
            for (int m = 0; m < 4; ++m)
#pragma unroll
                for (int n = 0; n < 2; ++n) acc[a][b][m][n] = (f32x4){0.f, 0.f, 0.f, 0.f};
    bf16x8 At[4][2], B0[2][2], B1[2][2];
    const char* cA = (const char*)g.A + (size_t)cur.pm * tstepA; const char* cB = (const char*)g.Bt + (size_t)cur.pn * tstepB + (cur.bh == 2 ? hstepB : (size_t)0);
    S.a_ready(cur);
    if constexpr (SP2) {
        PG8_STAGE(PG8_SB(0, 0), cB, voffB); PG8_STAGE(PG8_SB(0, 1), cB + hstepB, voffB); PG8_STAGE(PG8_SA(0, 0), cA, voffA); PG8_STAGE(PG8_SA(0, 1), cA + hstepA, voffA);
        if (wr == 1) PG8_BAR;
        PG8_WAIT_V(2); PG8_BAR;
        PG8_STAGE(PG8_SB(1, 0), cB + kstep, voffB); PG8_STAGE(PG8_SA(1, 0), cA + kstep, voffA); PG8_STAGE(PG8_SB(1, 1), cB + hstepB + kstep, voffB);
        PG8_WAIT_V(6); PG8_BAR;
    } else {
        PG8_STAGE(PG8_SB(0, 0), cB, voffB); PG8_STAGE(PG8_SA(0, 0), cA, voffA); PG8_STAGE(PG8_SB(0, 1), cB + hstepB, voffB); PG8_STAGE(PG8_SA(0, 1), cA + hstepA, voffA);
        if (wr == 1) PG8_BAR;
        PG8_WAIT_V(4); PG8_BAR;
        PG8_STAGE(PG8_SB(1, 0), cB + kstep, voffB); PG8_STAGE(PG8_SA(1, 0), cA + kstep, voffA); PG8_STAGE(PG8_SB(1, 1), cB + hstepB + kstep, voffB);
        PG8_WAIT_V(6); PG8_BAR;
    }
    for (;;) {
        const bool has_next = S.next(ui + 1, nxt);
        const char* nA = has_next ? (const char*)g.A + (size_t)nxt.pm * tstepA : cA; const char* nB = has_next ? (const char*)g.Bt + (size_t)nxt.pn * tstepB + (nxt.bh == 2 ? hstepB : (size_t)0) : cB;
        const bool full = cur.bh == 0;
        for (int t = 0; t < nt; t += 2) {
            const bool last = (t == nt - 2);
            const char* a1 = cA + (size_t)(t + 1) * kstep;
            const char* a2 = last ? nA : cA + (size_t)(t + 2) * kstep; const char* b2 = last ? nB : cB + (size_t)(t + 2) * kstep;
            const char* a3 = a2 + kstep; const char* b3 = b2 + kstep;
            if (last && has_next) S.a_ready(nxt);
            if constexpr (SP2) {
            PG8_LDB(B0, 0, 0); PG8_LDB(B1, 0, 1); PG8_SCHED; PG8_LDA(At, 0, 0); PG8_STAGE(PG8_SA(1, 1), a1 + hstepA, voffA);
            PG8_WAIT_V(8); PG8_WAIT_L(0); PG8_BAR; PG8_MMA(0, 0, At, B0); if (full) PG8_MMA(0, 1, At, B1); PG8_BAR; PG8_SCHED;
            PG8_LDA(At, 0, 1); PG8_STAGE(PG8_SB(0, 0), b2, voffB); PG8_STAGE(PG8_SB(0, 1), b2 + hstepB, voffB); PG8_STAGE(PG8_SA(0, 0), a2, voffA);
            PG8_WAIT_V(8); PG8_WAIT_L(0); PG8_BAR; PG8_MMA(1, 0, At, B0); if (full) PG8_MMA(1, 1, At, B1); PG8_BAR; PG8_SCHED;
            PG8_LDB(B0, 1, 0); PG8_LDB(B1, 1, 1); PG8_SCHED; PG8_LDA(At, 1, 0); PG8_STAGE(PG8_SA(0, 1), a2 + hstepA, voffA);
            PG8_WAIT_V(8); PG8_WAIT_L(0); PG8_BAR; PG8_MMA(0, 0, At, B0); if (full) PG8_MMA(0, 1, At, B1); PG8_BAR; PG8_SCHED;
            PG8_LDA(At, 1, 1); PG8_STAGE(PG8_SB(1, 0), b3, voffB); PG8_STAGE(PG8_SB(1, 1), b3 + hstepB, voffB); PG8_STAGE(PG8_SA(1, 0), a3, voffA);
            PG8_WAIT_V(8); PG8_WAIT_L(0); PG8_BAR; PG8_MMA(1, 0, At, B0); if (full) PG8_MMA(1, 1, At, B1); PG8_BAR; PG8_SCHED;
            } else {
            PG8_LDB(B0, 0, 0); PG8_SCHED; PG8_LDA(At, 0, 0); PG8_STAGE(PG8_SA(1, 1), a1 + hstepA, voffA);
            PG8_WAIT_L(8); PG8_BAR; PG8_WAIT_L(0); PG8_MMA(0, 0, At, B0); PG8_BAR; PG8_SCHED;
            PG8_LDB(B1, 0, 1); PG8_STAGE(PG8_SB(0, 0), b2, voffB);
            PG8_BAR; PG8_WAIT_L(0); PG8_MMA(0, 1, At, B1); PG8_BAR;
            PG8_LDA(At, 0, 1); PG8_STAGE(PG8_SA(0, 0), a2, voffA);
            PG8_BAR; PG8_WAIT_L(0); PG8_MMA(1, 0, At, B0); PG8_BAR; PG8_SCHED;
            PG8_STAGE(PG8_SB(0, 1), b2 + hstepB, voffB);
            PG8_WAIT_V(6); PG8_BAR; PG8_MMA(1, 1, At, B1); PG8_BAR;
            PG8_LDB(B0, 1, 0); PG8_SCHED; PG8_LDA(At, 1, 0); PG8_STAGE(PG8_SA(0, 1), a2 + hstepA, voffA);
            PG8_WAIT_L(8); PG8_BAR; PG8_WAIT_L(0); PG8_MMA(0, 0, At, B0); PG8_BAR; PG8_SCHED;
            PG8_LDB(B1, 1, 1); PG8_STAGE(PG8_SB(1, 0), b3, voffB);
            PG8_BAR; PG8_WAIT_L(0); PG8_MMA(0, 1, At, B1); PG8_BAR;
            PG8_LDA(At, 1, 1); PG8_STAGE(PG8_SA(1, 0), a3, voffA);
            PG8_BAR; PG8_WAIT_L(0); PG8_MMA(1, 0, At, B0); PG8_BAR; PG8_SCHED;
            PG8_STAGE(PG8_SB(1, 1), b3 + hstepB, voffB);
            PG8_WAIT_V(6); PG8_BAR; PG8_MMA(1, 1, At, B1); PG8_BAR;
            }
        }
        if constexpr (ALIGN_EPI) { if (wr == 0) PG8_BAR; }
        if constexpr (!Epi::AFTER_DRAIN) { E(acc, cur, wr, wc, fr, fq); S.done(cur); }
        if (!has_next) break;
#pragma unroll
        for (int a = 0; a < 2; ++a)
#pragma unroll
            for (int b = 0; b < 2; ++b)
#pragma unroll
                for (int m = 0; m < 4; ++m)
#pragma unroll
                    for (int n = 0; n < 2; ++n) acc[a][b][m][n] = (f32x4){0.f, 0.f, 0.f, 0.f};
        cur = nxt; cA = nA; cB = nB; ++ui;
        if constexpr (ALIGN_EPI) { if (wr == 1) PG8_BAR; }
    }
    PG8_WAIT_V(0);
    if constexpr (!ALIGN_EPI) { if (wr == 0) PG8_BAR; }
    PG8_BAR;
    if constexpr (Epi::AFTER_DRAIN) { E.fused(acc, cur, wr, wc, fr, fq, lds, wid, lane); S.done(cur); }
#undef PG8_SA
#undef PG8_SB
#undef PG8_STAGE
#undef PG8_LDA
#undef PG8_LDB
#undef PG8_MMA
#undef PG8_WAIT_V
#undef PG8_WAIT_L
#undef PG8_BAR
#undef PG8_SCHED
}
}
#define XB_TMO      128
#define XB_XCNT(j)  (256  + 64 * (j))
#define XB_XSUB(j)  (1280 + 64 * (j))
#define XB_XGEN(j)  (2304 + 64 * (j))
#define XB_TOP      3328
#define XB_TOPGEN   3392
#define XCD_BAR_WORDS 3456
#define XB_SPIN_CAP (1u << 18)

__device__ __forceinline__ unsigned xb_ld(unsigned* p)              { return __hip_atomic_load(p, __ATOMIC_RELAXED, __HIP_MEMORY_SCOPE_AGENT); }
__device__ __forceinline__ unsigned xb_add(unsigned* p, unsigned v) { return __hip_atomic_fetch_add(p, v, __ATOMIC_RELAXED, __HIP_MEMORY_SCOPE_AGENT); }
__device__ __forceinline__ unsigned xb_xcc_id() { return (unsigned)__builtin_amdgcn_s_getreg((3 << 11) | 20) & 0xFu; }
#define XB_SPIN(cond, bar) do { unsigned _sp = 0; while (cond) { __builtin_amdgcn_s_sleep(1); \
    if ((++_sp & 255u) == 0u) { if (xb_ld(&(bar)[XB_TMO])) break; if (_sp > XB_SPIN_CAP) { atomicAdd(&(bar)[XB_TMO], 1u); break; } } } } while (0)

struct XcdBarrier {
    unsigned* bar; unsigned x;
    volatile LAS unsigned* st;
};

__device__ __forceinline__ XcdBarrier xcd_barrier_post(unsigned* bar, volatile LAS unsigned* st) {
    XcdBarrier b; b.bar = bar; b.x = xb_xcc_id(); b.st = st;
    if (threadIdx.x == 0) (void)xb_add(&bar[XB_XCNT(b.x)], 1u);
    return b;
}
__device__ __forceinline__ void xcd_barrier_complete(unsigned* bar, unsigned x, unsigned& nloc, unsigned& nx) {
    const unsigned G = gridDim.x * gridDim.y * gridDim.z;
    unsigned sum, cnt, mine, sp = 0u;
    for (;;) {
        sum = 0u; cnt = 0u; mine = 0u;
#pragma unroll
        for (unsigned j = 0; j < 16; ++j) { const unsigned c = xb_ld(&bar[XB_XCNT(j)]); sum += c; cnt += (c > 0u) ? 1u : 0u; mine = (j == x) ? c : mine; }
        if (sum == G) break;
        __builtin_amdgcn_s_sleep(1);
        if ((++sp & 255u) == 0u) { if (xb_ld(&bar[XB_TMO])) break; if (sp > XB_SPIN_CAP) { atomicAdd(&bar[XB_TMO], 1u); break; } }
    }
    nloc = mine > 0u ? mine : 1u; nx = cnt > 0u ? cnt : 1u;
}

__device__ __forceinline__ void xcd_barrier(const XcdBarrier& b) {
    asm volatile("s_waitcnt vmcnt(0)" ::: "memory");
    __syncthreads();
    if (threadIdx.x == 0) {
        unsigned* bar = b.bar;
        __builtin_amdgcn_s_waitcnt(0);
        unsigned nloc = b.st[0], nx = b.st[1];
        if (nloc == 0u) { xcd_barrier_complete(bar, b.x, nloc, nx); b.st[0] = nloc; b.st[1] = nx; }
        const unsigned old = xb_add(&bar[XB_XSUB(b.x)], 1u);
        const unsigned gen = old / nloc;
        if (old + 1u == (gen + 1u) * nloc) {
            __builtin_amdgcn_fence(__ATOMIC_RELEASE, "agent");
            asm volatile("s_waitcnt vmcnt(0)" ::: "memory");
            const unsigned og = xb_add(&bar[XB_TOP], 1u);
            const unsigned tg = og / nx;
            if (og + 1u == (tg + 1u) * nx) xb_add(&bar[XB_TOPGEN], 1u);
            else XB_SPIN(xb_ld(&bar[XB_TOPGEN]) == tg, bar);
            __builtin_amdgcn_fence(__ATOMIC_ACQUIRE, "agent");
            xb_add(&bar[XB_XGEN(b.x)], 1u);
            asm volatile("s_waitcnt vmcnt(0)" ::: "memory");
        } else {
            XB_SPIN(xb_ld(&bar[XB_XGEN(b.x)]) == gen, bar);
            __builtin_amdgcn_fence(__ATOMIC_ACQUIRE, "agent");
            asm volatile("s_waitcnt vmcnt(0)" ::: "memory");
        }
    }
    __syncthreads();
}


__device__ __forceinline__ int win_src_col(int n) {
    if (n < 256) return 896 + n;
    if (n < 640) return 2304 + (n - 256);
    if (n < 1024) return 3104 + (n - 640);
    if (n < 1280) return n - 1024;
    if (n < 1536) return 256 + (n - 1280);
    if (n < 1792) return 512 + (n - 1536);
    if (n < 2176) return 1152 + (n - 1792);
    if (n < 2560) return 1536 + (n - 2176);
    if (n < 2944) return 1920 + (n - 2560);
    if (n < 3008) return 768 + (n - 2944);
    if (n < 3072) return 832 + (n - 3008);
    if (n < 3328) return 2688 + (n - 3072);
    if (n < 3456) return 2944 + (n - 3328);
    if (n < 3488) return 3072 + (n - 3456);
    return -1;
}
__device__ __forceinline__ int win_blk(int nb) { const int tile = nb >> 3, d = nb & 7; return (tile >= 7 && tile <= 9) ? tile * 8 + 2 * (d & 3) + (d >> 2) : nb; }
__device__ __forceinline__ void p0_tr_item(const float* W, int ldw, int src_n0, int K, bf16* WT, int dst_row0, int k0, const float* kscale, LAS float* scr, int lane) {
#pragma unroll 8
    for (int i = 0; i < 32; ++i) { const int kk = 2 * i + (lane >> 5);
        float v = src_n0 >= 0 ? W[(size_t)(k0 + kk) * ldw + src_n0 + (lane & 31)] : 0.f;
        if (kscale) v *= kscale[k0 + kk];
        scr[kk * 33 + (lane & 31)] = v; }
    LDS_WAIT(); asm volatile("" ::: "memory");
    const int c = lane & 7;
#pragma unroll
    for (int j = 0; j < 4; ++j) { const int n = (lane >> 3) + 8 * j; const LAS float* s = scr + (8 * c) * 33 + n;
        u32x4 o; o.x = pk2(s[0 * 33], s[1 * 33]); o.y = pk2(s[2 * 33], s[3 * 33]); o.z = pk2(s[4 * 33], s[5 * 33]); o.w = pk2(s[6 * 33], s[7 * 33]);
        *(u32x4*)(WT + (size_t)(dst_row0 + n) * K + k0 + 8 * c) = o; }
    LDS_WAIT(); asm volatile("" ::: "memory");
}

__device__ __forceinline__ void phase_p0a(CArgs& a, LAS unsigned char* lds, int vcu, int G, int tid, int wave, int lane) {
    unsigned char* ws = a.ws;
    if (vcu < 96) {
        const int l = vcu / 48, n0 = (vcu % 48) * 64;
        LAS float* tab = (LAS float*)lds;
        LAS float* red = tab + 9216;
        for (int i = tid; i < 9216; i += 512) { const int j = i >> 10, k = i & 1023; const float c = j == 0 ? a.in[8][k] : a.in[7][(j - 1) * 1024 + k]; tab[i] = silu_f(c); }
        __syncthreads();
        float acc[9];
#pragma unroll
        for (int j = 0; j < 9; ++j) acc[j] = 0.f;
        const float* wm = a.in[9] + (size_t)l * 1024 * 3072 + n0 + lane;
        for (int kk = 0; kk < 128; ++kk) { const int k = wave * 128 + kk; const float wv = wm[(size_t)k * 3072];
#pragma unroll
            for (int j = 0; j < 9; ++j) acc[j] += tab[j * 1024 + k] * wv; }
#pragma unroll
        for (int j = 0; j < 9; ++j) red[(wave * 9 + j) * 64 + lane] = acc[j];
        __syncthreads();
        float* mod = (float*)(ws + WS_MOD);
        for (int i = tid; i < 576; i += 512) { const int j = i >> 6, ln = i & 63; float s = 0.f;
#pragma unroll
            for (int w = 0; w < 8; ++w) s += red[(w * 9 + j) * 64 + ln];
            mod[(size_t)(l * 9 + j) * 3072 + n0 + ln] = s + a.in[10][l * 3072 + n0 + ln]; }
        __syncthreads();
    }
    LAS float* scr = (LAS float*)(lds + 57344 + wave * 8704);
    const int gw = vcu * 8 + wave, NGW = G * 8;
    bf16* WIN = (bf16*)(ws + WS_WIN); bf16* WOUT = (bf16*)(ws + WS_WOUT); bf16* WUQ = (bf16*)(ws + WS_WUQ); bf16* WUKV = (bf16*)(ws + WS_WUKV); bf16* LORA = (bf16*)(ws + WS_LORA);
    for (int it = gw; it < 4912; it += NGW) {
        int r = it;
        if (r < 3584) { const int l = r / 1792, q = r % 1792, kb = q / 112, nb = q % 112;
            p0_tr_item(a.in[12] + (size_t)l * 1024 * 3488, 3488, win_src_col(32 * win_blk(nb)), 1024, WIN + (size_t)l * 3584 * 1024, 32 * nb, 64 * kb, nullptr, scr, lane); continue; } r -= 3584;
        if (r < 1024) { const int l = r / 512, q = r % 512, kb = q / 32, nb = q % 32;
            p0_tr_item(a.in[13] + (size_t)l * 1024 * 1024, 1024, 32 * nb, 1024, WOUT + (size_t)l * 1024 * 1024, 32 * nb, 64 * kb, nullptr, scr, lane); continue; } r -= 1024;
        if (r < 144) { const int l = r / 72, q = r % 72, kb = q / 18, nb = q % 18;
            p0_tr_item(a.in[29] + (size_t)l * 256 * 576, 576, 32 * nb, 256, WUQ + (size_t)l * 576 * 256, 32 * nb, 64 * kb, a.in[27] + l * 256, scr, lane); continue; } r -= 144;
        if (r < 48) { const int l = r / 24, q = r % 24, kb = q / 12, nb = q % 12;
            p0_tr_item(a.in[30] + (size_t)l * 128 * 384, 384, 32 * nb, 128, WUKV + (size_t)l * 768 * 128, 32 * nb, 64 * kb, nullptr, scr, lane); continue; } r -= 48;
        if (r < 48) { const int l = r / 24, q = r % 24, kb = q / 12, nb = q % 12;
            p0_tr_item(a.in[31] + (size_t)l * 128 * 384, 384, 32 * nb, 128, WUKV + (size_t)l * 768 * 128, 384 + 32 * nb, 64 * kb, nullptr, scr, lane); continue; } r -= 48;
        { const int which = r / 32, q = r % 32, ld = q / 8, nb = q % 8;
          const int l = ld >> 1, d = ld & 1;
          p0_tr_item(a.in[which ? 18 : 16] + (size_t)ld * 64 * 256, 256, 32 * nb, 64, LORA + (size_t)(((l * 2 + which) * 2 + d) * 256) * 64, 32 * nb, 0, nullptr, scr, lane); }
    }
    {
        const size_t gt = (size_t)vcu * 512 + tid, NT = (size_t)G * 512;
        for (int w = 0; w < 2; ++w) { const float* src = a.in[3 + w]; bf16* dst = (bf16*)(ws + (w ? WS_NACV : WS_NACK));
            for (size_t c = gt; c < 393216; c += NT) { const f32x4 v0 = *(const f32x4*)(src + c * 8), v1 = *(const f32x4*)(src + c * 8 + 4);
                u32x4 o; o.x = pk2(v0[0], v0[1]); o.y = pk2(v0[2], v0[3]); o.z = pk2(v1[0], v1[1]); o.w = pk2(v1[2], v1[3]); *(u32x4*)(dst + c * 8) = o; } }
    }
}

__device__ __forceinline__ void phase_norm(CArgs& a, int l, int vcu, int G, int wave, int lane) {
    const int gw = vcu * 8 + wave, NGW = G * 8;
    const float* mod = (const float*)(a.ws + WS_MOD) + (size_t)l * 9 * 3072;
    const float* nw = a.in[11] + l * 1024;
    bf16* H = (bf16*)(a.ws + WS_H);
    for (int tok = gw; tok < NTOK; tok += NGW) {
        const float* xr = (l == 0) ? x_row0(a, tok) : a.out + OUT_Y + (size_t)tok * DM;
        const float* md = mod + mod_idx(tok) * 3072;
        f32x4 v[4]; float s = 0.f;
#pragma unroll
        for (int j = 0; j < 4; ++j) { v[j] = *(const f32x4*)(xr + 4 * lane + 256 * j); s += (v[j][0] * v[j][0] + v[j][1] * v[j][1]) + (v[j][2] * v[j][2] + v[j][3] * v[j][3]); }
        s = wave64_sum(s);
        const float rstd = __builtin_amdgcn_rsqf(s * (1.f / 1024.f) + EPS);
#pragma unroll
        for (int j = 0; j < 4; ++j) { const int c = 4 * lane + 256 * j;
            const f32x4 g = *(const f32x4*)(nw + c), sh = *(const f32x4*)(md + c), sc = *(const f32x4*)(md + 1024 + c);
            f32x4 o = ((v[j] * rstd) * g) * (sc + 1.0f) + sh;
            u32x2 w; w.x = pk2(o[0], o[1]); w.y = pk2(o[2], o[3]);
            *(u32x2*)(H + (size_t)tok * DM + c) = w; }
    }
}

__device__ __forceinline__ void phase_l1_tables(CArgs& a, int vcu, int G, int tid, int wave, int lane) {
    const float* mod1 = (const float*)(a.ws + WS_MOD) + (size_t)9 * 3072;
    const float* nw1 = a.in[11] + 1024;
    float* S1 = (float*)(a.ws + WS_S1T); float* C1 = (float*)(a.ws + WS_C1);
    if (vcu == 0 && wave == 0) {
        for (int l = 0; l < 2; ++l) { float mq = 0.f, mk = 0.f;
            for (int i = lane; i < 96; i += 64) { mq = fmaxf(mq, fabsf(a.in[32][l * 96 + i])); mk = fmaxf(mk, fabsf(a.in[33][l * 96 + i])); }
            mq = xor32_max(mq); mk = xor32_max(mk);
#pragma unroll
            for (int o = 16; o > 0; o >>= 1) { mq = fmaxf(mq, __shfl_xor(mq, o)); mk = fmaxf(mk, __shfl_xor(mk, o)); }
            if (lane == 0) ((float*)(a.ws + WS_ABND))[l] = 96.f * mq * mk * (MLA_SCALE * LOG2E); }
    }
    for (int i = vcu * 512 + tid; i < 9216; i += G * 512) { const int b = i >> 10, k = i & 1023; S1[i] = nw1[k] * (1.0f + mod1[b * 3072 + 1024 + k]); }
    const bf16* W1 = (const bf16*)(a.ws + WS_WIN) + (size_t)NPROJ * DM;
    for (int n = vcu * 8 + wave; n < NPROJ; n += G * 8) {
        const bf16x8 w0 = *(const bf16x8*)(W1 + (size_t)n * DM + 16 * lane), w1 = *(const bf16x8*)(W1 + (size_t)n * DM + 16 * lane + 8);
        float wf[16];
#pragma unroll
        for (int q = 0; q < 8; ++q) { wf[q] = bf2f((unsigned short)w0[q]); wf[8 + q] = bf2f((unsigned short)w1[q]); }
#pragma unroll 1
        for (int b = 0; b < 9; ++b) { const float* sh = mod1 + b * 3072 + 16 * lane; float s = 0.f;
#pragma unroll
            for (int q = 0; q < 4; ++q) { const f32x4 v = *(const f32x4*)(sh + 4 * q); s += (v[0] * wf[4 * q] + v[1] * wf[4 * q + 1]) + (v[2] * wf[4 * q + 2] + v[3] * wf[4 * q + 3]); }
            s = wave64_sum(s);
            if (lane == 0) C1[b * NPROJ + n] = s; }
    }
}

__device__ __forceinline__ bf16x8 ld8(const bf16* p) { return *(const bf16x8*)p; }
__device__ __forceinline__ f32x16 mfma32(bf16x8 x, bf16x8 y, f32x16 c) { return __builtin_amdgcn_mfma_f32_32x32x16_bf16(x, y, c, 0, 0, 0); }
__device__ __forceinline__ bf16x8 pack8(const float* f) { u32x4 w; w.x = pk2(f[0], f[1]); w.y = pk2(f[2], f[3]); w.z = pk2(f[4], f[5]); w.w = pk2(f[6], f[7]); return __builtin_bit_cast(bf16x8, w); }
__device__ __forceinline__ void st4bf(bf16* p, float x0, float x1, float x2, float x3) { u32x2 w; w.x = pk2(x0, x1); w.y = pk2(x2, x3); *(u32x2*)p = w; }

__device__ __forceinline__ void rope_tables(float (&cs)[8], float (&sn)[8], bool latent, int tok, int hi) {
    if (latent) { const int tp = (tok - NTC) & 4095; const float prow = (float)(tp >> 6), pcol = (float)(tp & 63);
#pragma unroll
        for (int r = 0; r < 8; ++r) { const float f = (float)((r & 3) + 4 * hi); const float inv = __builtin_amdgcn_exp2f(-f * 1.6609640474436812f);
            float rev = (r < 4 ? prow : pcol) * inv * 0.15915494309189535f; rev = rev - floorf(rev);
            cs[r] = __builtin_amdgcn_cosf(rev); sn[r] = __builtin_amdgcn_sinf(rev); } }
    else {
#pragma unroll
        for (int r = 0; r < 8; ++r) { cs[r] = 1.f; sn[r] = 0.f; } }
}
__device__ __forceinline__ void st32blk(bf16* rowp, const float* v, int hi) {
#pragma unroll
    for (int k = 0; k < 4; k += 2) {
        u32x2 A, B; A.x = pk2(v[4 * k], v[4 * k + 1]); A.y = pk2(v[4 * k + 2], v[4 * k + 3]); B.x = pk2(v[4 * k + 4], v[4 * k + 5]); B.y = pk2(v[4 * k + 6], v[4 * k + 7]);
        const auto r0 = __builtin_amdgcn_permlane32_swap(A.x, B.x, false, false); const auto r1 = __builtin_amdgcn_permlane32_swap(A.y, B.y, false, false);
        u32x4 w; w.x = r0[0]; w.y = r1[0]; w.z = r0[1]; w.w = r1[1];
        *(u32x4*)(rowp + 8 * k + 8 * hi) = w;
    }
}
constexpr int P2_RQ = 528, P2_RKV = 272;
__device__ __forceinline__ void p2_q_job(CArgs& a, int l, LAS unsigned char* lds, int tile, int hp, int tid) {
    asm volatile("" : "+v"(tid));
    const int lane = tid & 63, wave = __builtin_amdgcn_readfirstlane(tid >> 6), r32 = lane & 31, hi = lane >> 5;
    const bf16* Wuq = (const bf16*)(a.ws + WS_WUQ) + (size_t)l * 576 * 256;
    const bool latent = tile >= NTC / 256;
    const unsigned tok = tile * 256 + wave * 32 + r32;
    const bf16* PB = (const bf16*)(a.ws + WS_PB);
    bf16x8 xq[16]; float ss = 0.f;
    { const bf16* pp = PB + tok * LDB + CB_CQ + 8 * hi;
#pragma unroll
      for (int s = 0; s < 16; ++s) { xq[s] = ld8(pp + 16 * s); ss += ss8(xq[s]); } }
    ss = xor32_sum(ss);
    const float rstd_cq = __builtin_amdgcn_rsqf(ss * (1.f / 256.f) + EPS);
    const float* qn = a.in[32] + l * 96;
    bf16* Qrow = (bf16*)(a.ws + WS_Q) + (size_t)tok * 576;
    bf16x8 wreg[6];
    const int wrow = tid >> 5, wc = tid & 31;
    unsigned wso = wrow * 256 + wc * 8; asm volatile("" : "+v"(wso));
#pragma unroll
    for (int i = 0; i < 6; ++i) wreg[i] = ld8(Wuq + ((2 * hp) * 96 + 16 * i) * 256 + wso);
#pragma unroll 1
    for (int hh = 0; hh < 2; ++hh) {
        const int head = 2 * hp + hh;
        __syncthreads();
#pragma unroll
        for (int i = 0; i < 6; ++i) *(LAS bf16x8*)(lds + (wrow + 16 * i) * P2_RQ + wc * 16) = wreg[i];
        if (hh == 0) {
#pragma unroll
            for (int i = 0; i < 6; ++i) wreg[i] = ld8(Wuq + ((2 * hp + 1) * 96 + 16 * i) * 256 + wso);
        }
        __syncthreads();
        f32x16 acc[3];
#pragma unroll
        for (int b = 0; b < 3; ++b) { acc[b] = (f32x16){};
            LAS const unsigned char* wl = lds + (32 * b + r32) * P2_RQ + 16 * hi;
#pragma unroll
            for (int s = 0; s < 16; ++s) acc[b] = mfma32(*(LAS const bf16x8*)(wl + 32 * s), xq[s], acc[b]); }
        float q2 = 0.f;
#pragma unroll
        for (int b = 0; b < 3; ++b)
#pragma unroll
            for (int r = 0; r < 16; ++r) q2 += acc[b][r] * acc[b][r];
        q2 = xor32_sum(q2) * (rstd_cq * rstd_cq);
        const float rq = (__builtin_amdgcn_rsqf(q2 * (1.f / 96.f) + EPS)) * (MLA_SCALE * LOG2E) * rstd_cq;
#pragma unroll
        for (int b = 0; b < 3; ++b)
#pragma unroll
            for (int g = 0; g < 4; ++g) { const f32x4 w4 = *(const f32x4*)(qn + b * 32 + 8 * g + 4 * hi);
#pragma unroll
                for (int i = 0; i < 4; ++i) acc[b][4 * g + i] *= rq * w4[i]; }
        { int tk = (int)tok; asm volatile("" : "+v"(tk)); float cs[8], sn[8]; rope_tables(cs, sn, latent, tk, hi);
#pragma unroll
          for (int r = 0; r < 8; ++r) { const float x1 = acc[2][r], x2 = acc[2][r + 8]; acc[2][r] = x1 * cs[r] - x2 * sn[r]; acc[2][r + 8] = x2 * cs[r] + x1 * sn[r]; } }
#pragma unroll
        for (int b = 0; b < 3; ++b) { float v[16];
#pragma unroll
            for (int r = 0; r < 16; ++r) v[r] = acc[b][r];
            st32blk(Qrow + head * 96 + b * 32, v, hi); }
    }
}
__device__ __forceinline__ void p2_kv_job(CArgs& a, int l, LAS unsigned char* lds, int tile, int part, int tid) {
    asm volatile("" : "+v"(tid));
    const int lane = tid & 63, wave = __builtin_amdgcn_readfirstlane(tid >> 6), r32 = lane & 31, hi = lane >> 5;
    unsigned char* ws = a.ws;
    const bf16* Wukv = (const bf16*)(ws + WS_WUKV) + (size_t)l * 768 * 128;
    const bool is_cc = tile >= 160;
    const bool latent = !is_cc && tile >= NTC / 256;
    const bool context = !is_cc && !latent;
    const unsigned tok = (is_cc ? (tile - 160) * 256 : tile * 256) + wave * 32 + r32;
    { const int rb = part < 2 ? 192 * part : 384 + 192 * (part - 2); const int wrow = tid >> 4, wc = tid & 15;
      bf16x8 wreg[6];
      unsigned wso = wrow * 128 + wc * 8; asm volatile("" : "+v"(wso));
#pragma unroll
      for (int i = 0; i < 6; ++i) wreg[i] = ld8(Wukv + (rb + 32 * i) * 128 + wso);
      __syncthreads();
#pragma unroll
      for (int i = 0; i < 6; ++i) *(LAS bf16x8*)(lds + (wrow + 32 * i) * P2_RKV + wc * 16) = wreg[i]; }
    bf16* Kd = (bf16*)(ws + (is_cc ? WS_CK : WS_MK)) + (size_t)tok * 576; bf16* Vd = (bf16*)(ws + (is_cc ? WS_CV : WS_MV)) + (size_t)tok * 384;
    bf16x8 xk[8]; float kr[16]; float kr2 = 0.f;
    if (!is_cc) {
        const bf16* PB = (const bf16*)(ws + WS_PB);
        const unsigned pbo = tok * LDB + 8 * hi;
        float ss = 0.f;
        { const bf16* pp = PB + pbo + CB_CKV;
#pragma unroll
          for (int s = 0; s < 8; ++s) { xk[s] = ld8(pp + 16 * s); ss += ss8(xk[s]); } }
        ss = xor32_sum(ss);
        const float rstd = __builtin_amdgcn_rsqf(ss * (1.f / 128.f) + EPS);
        const float* gk = a.in[28] + l * 128;
        const unsigned cb = tok >> 8, ct = tok & 255;
        float* ckv_out = a.out + OUT_CKV; const unsigned co = ((cb * 2 + l) * 256 + ct) * 128 + 8 * hi;
        const bool wr_cache = context && part == 0;
#pragma unroll
        for (int s = 0; s < 8; ++s) { float f[8];
            const f32x4 g0 = *(const f32x4*)(gk + 16 * s + 8 * hi), g1 = *(const f32x4*)(gk + 16 * s + 8 * hi + 4);
#pragma unroll
            for (int j = 0; j < 8; ++j) f[j] = bf2f((unsigned short)xk[s][j]) * rstd * (j < 4 ? g0[j & 3] : g1[j & 3]);
            if (wr_cache) { *(f32x4*)(ckv_out + co + 16 * s) = (f32x4){f[0], f[1], f[2], f[3]}; *(f32x4*)(ckv_out + co + (16 * s + 4)) = (f32x4){f[4], f[5], f[6], f[7]}; }
            xk[s] = pack8(f); }
        float* kr_out = a.out + OUT_KROPE; const unsigned kro = ((cb * 2 + l) * 256 + ct) * 32 + 4 * hi;
#pragma unroll
        for (int g = 0; g < 4; ++g) { const u32x2 w = *(const u32x2*)(PB + pbo + (CB_KR + 8 * g) - 4 * hi);
            kr[4 * g] = lo_f(w.x); kr[4 * g + 1] = hi_f(w.x); kr[4 * g + 2] = lo_f(w.y); kr[4 * g + 3] = hi_f(w.y);
            if (wr_cache) *(f32x4*)(kr_out + kro + 8 * g) = (f32x4){kr[4 * g], kr[4 * g + 1], kr[4 * g + 2], kr[4 * g + 3]}; }
    } else {
        const unsigned b = tok >> 9, p = tok & 511;
        const float* src = a.in[5]; const unsigned so = ((b * 2 + l) * 512 + p) * 128 + 8 * hi;
#pragma unroll
        for (int s = 0; s < 8; ++s) { const f32x4 v0 = *(const f32x4*)(src + so + 16 * s), v1 = *(const f32x4*)(src + so + (16 * s + 4));
            float f[8] = {v0[0], v0[1], v0[2], v0[3], v1[0], v1[1], v1[2], v1[3]}; xk[s] = pack8(f); }
        const float* ksrc = a.in[6]; const unsigned kso = ((b * 2 + l) * 512 + p) * 32 + 4 * hi;
#pragma unroll
        for (int g = 0; g < 4; ++g) { const f32x4 v = *(const f32x4*)(ksrc + kso + 8 * g); kr[4 * g] = v[0]; kr[4 * g + 1] = v[1]; kr[4 * g + 2] = v[2]; kr[4 * g + 3] = v[3]; }
    }
#pragma unroll
    for (int r = 0; r < 16; ++r) kr2 += kr[r] * kr[r];
    kr2 = xor32_sum(kr2);
    const float* kn = a.in[33] + l * 96;
    __syncthreads();
    if (part < 2) {
#pragma unroll 1
        for (int hh = 0; hh < 3; ++hh) {
            const int head = 3 * part + hh;
            f32x16 acc[2];
#pragma unroll
            for (int b = 0; b < 2; ++b) { acc[b] = (f32x16){};
                LAS const unsigned char* wl = lds + (64 * hh + 32 * b + r32) * P2_RKV + 16 * hi;
#pragma unroll
                for (int s = 0; s < 8; ++s) acc[b] = mfma32(*(LAS const bf16x8*)(wl + 32 * s), xk[s], acc[b]); }
            float k2 = 0.f;
#pragma unroll
            for (int b = 0; b < 2; ++b)
#pragma unroll
                for (int r = 0; r < 16; ++r) k2 += acc[b][r] * acc[b][r];
            k2 = xor32_sum(k2);
            const float rk = __builtin_amdgcn_rsqf((k2 + kr2) * (1.f / 96.f) + EPS);
#pragma unroll
            for (int b = 0; b < 2; ++b) { float v[16];
#pragma unroll
                for (int g = 0; g < 4; ++g) { const f32x4 w4 = *(const f32x4*)(kn + b * 32 + 8 * g + 4 * hi);
#pragma unroll
                    for (int i = 0; i < 4; ++i) v[4 * g + i] = acc[b][4 * g + i] * rk * w4[i]; }
                st32blk(Kd + head * 96 + b * 32, v, hi); }
            float kv[16];
#pragma unroll
            for (int g = 0; g < 4; ++g) { const f32x4 w4 = *(const f32x4*)(kn + 64 + 8 * g + 4 * hi);
#pragma unroll
                for (int i = 0; i < 4; ++i) kv[4 * g + i] = kr[4 * g + i] * rk * w4[i]; }
            { int tk = (int)tok; asm volatile("" : "+v"(tk)); float cs[8], sn[8]; rope_tables(cs, sn, latent, tk, hi);
#pragma unroll
              for (int r = 0; r < 8; ++r) { const float x1 = kv[r], x2 = kv[r + 8]; kv[r] = x1 * cs[r] - x2 * sn[r]; kv[r + 8] = x2 * cs[r] + x1 * sn[r]; } }
            st32blk(Kd + head * 96 + 64, kv, hi);
        }
    } else {
#pragma unroll 1
        for (int nb = 0; nb < 6; ++nb) {
            f32x16 acc = (f32x16){};
            LAS const unsigned char* wl = lds + (32 * nb + r32) * P2_RKV + 16 * hi;
#pragma unroll
            for (int s = 0; s < 8; ++s) acc = mfma32(*(LAS const bf16x8*)(wl + 32 * s), xk[s], acc);
            float v[16];
#pragma unroll
            for (int r = 0; r < 16; ++r) v[r] = acc[r];
            st32blk(Vd + 192 * (part - 2) + nb * 32, v, hi);
        }
    }
}

__device__ __forceinline__ void p2_na_token(CArgs& a, int l, int tok, int lane) {
    asm volatile("" : "+v"(lane));
    bf16* row = (bf16*)(a.ws + WS_PA) + (size_t)tok * LDA;
    const bool context = tok < NTC;
    const int cb = tok >> 8, ct = tok & 255;
    float* nak = a.out + OUT_NAK + ((size_t)(cb * 2 + l) * 256 + ct) * 384;
    float* nav = a.out + OUT_NAV + ((size_t)(cb * 2 + l) * 256 + ct) * 384;
    const float* qw = a.in[24] + l * 64; const float* kw = a.in[25] + l * 64;
#pragma unroll
    for (int i = 0; i < 3; ++i) {
        const int e = 4 * lane + 256 * i;
        const u32x2 w = *(const u32x2*)(row + CA_QN + e);
        float f[4] = {lo_f(w.x), hi_f(w.x), lo_f(w.y), hi_f(w.y)};
        float s = (f[0] * f[0] + f[1] * f[1]) + (f[2] * f[2] + f[3] * f[3]);
        s = row16_sum(s);
        const float rs = __builtin_amdgcn_rsqf(s * (1.f / 64.f) + EPS);
        const bool isq = e < 384; const int d = e & 63;
        const float* gw = isq ? qw : kw; const float sc = isq ? rs * (0.125f * LOG2E) : rs;
        float o[4];
#pragma unroll
        for (int j = 0; j < 4; ++j) o[j] = f[j] * sc * gw[d + j];
        st4bf(row + CA_QN + e, o[0], o[1], o[2], o[3]);
        if (context && !isq) *(f32x4*)(nak + (e - 384)) = (f32x4){o[0], o[1], o[2], o[3]};
    }
    if (context) {
#pragma unroll
        for (int i = 0; i < 2; ++i) { const int e = 4 * lane + 256 * i;
            if (e < 384) { const u32x2 w = *(const u32x2*)(row + CA_VN + e); *(f32x4*)(nav + e) = (f32x4){lo_f(w.x), hi_f(w.x), lo_f(w.y), hi_f(w.y)}; } }
    }
}

__device__ __forceinline__ void phase_p2(CArgs& a, int l, LAS unsigned char* lds, int vcu, int G, int tid, int wave, int lane, bool dry) {
    for (int jid = vcu; jid < 1184; jid += G) { if (jid < 480) p2_q_job(a, l, lds, jid / 3, jid % 3, tid); else { const int v = jid - 480; p2_kv_job(a, l, lds, v >> 2, v & 3, tid); } }
    __syncthreads();
    (void)dry; (void)wave; (void)lane;
}

struct AttnSeg { const bf16* K; const bf16* V; int ks, vs, nt; };
constexpr int ATT_KVB = 20480;
constexpr int ATT_BIAS_OFF = 2 * ATT_KVB;
typedef LAS const unsigned char* ldsc_t;
__device__ __forceinline__ s16x4 vtr(ldsc_t p) { typedef short v4i16_t __attribute__((ext_vector_type(4))); return __builtin_bit_cast(s16x4, __builtin_amdgcn_ds_read_tr16_b64_v4i16((LAS v4i16_t*)p)); }

__device__ __forceinline__ float max3f(float a, float b, float c) { float r; asm("v_max3_f32 %0, %1, %2, %3" : "=v"(r) : "v"(a), "v"(b), "v"(c)); return r; }
__device__ __forceinline__ float max2f(float a, float b) { float r; asm("v_max_f32_e32 %0, %1, %2" : "=v"(r) : "v"(a), "v"(b)); return r; }
template <int DK, bool LOCAL_OK>
__device__ __forceinline__ void attn_unit(LAS unsigned char* lds, const bf16* Qp, int qs, AttnSeg s0, AttnSeg s1, bf16* Gp, int gs,
                                          const bool local_rt, const float* rpb, int r0, int kr_lo, int tid, bool dry, bool fast) {
    asm volatile("" : "+v"(tid));
    const bool LOCAL = LOCAL_OK && local_rt;
    constexpr int NS = DK / 16;
    constexpr int KB = 64 * DK * 2;
    const int lane = tid & 63, wave = __builtin_amdgcn_readfirstlane(tid >> 6), r32 = lane & 31, hi = lane >> 5;
    bf16x8 qf[NS];
    { const bf16* qrow = Qp + (size_t)(wave * 32 + r32) * qs + 8 * hi;
#pragma unroll
      for (int s = 0; s < NS; ++s) qf[s] = ld8(qrow + 16 * s); }
    int my_row = 0, my_rs = 0, jbase = 0, lbase = 0;
    if (LOCAL) {
        LAS float* bt = (LAS float*)(lds + ATT_BIAS_OFF);
        if (tid < 480) { const int row = tid >> 1, half = tid & 1; const int L = row / 15, dr = row - L * 15;
#pragma unroll
            for (int q = 0; q < 17; ++q) { const int j = 17 * half + q, dc = j - 1; const bool ok = dc >= L && dc < L + 16 && dc >= 0 && dc <= 30;
                bt[row * 34 + j] = ok ? rpb[dr * 31 + (ok ? dc : 0)] * LOG2E : -1e30f; } }
        my_row = r0 + (wave >> 1); my_rs = min(max(my_row - 4, 0), 56);
        const int qcol = 32 * (wave & 1) + r32, cs_ = min(max(qcol - 8, 0), 48);
        jbase = 16 - qcol + 4 * hi;
        lbase = (cs_ - qcol + 15) * 510;
    }
    const int nt = s0.nt + s1.nt;
    const int vkey = 16 * (wave & 3) + (lane >> 2), vch = 4 * (wave >> 2) + (lane & 3);
    bf16x8 kreg0, kreg1, vreg;
    auto stage_load = [&](int t) {
        const bool in0 = t < s0.nt; const int tt = in0 ? t : t - s0.nt;
        const bf16* Kb = in0 ? s0.K : s1.K; const bf16* Vb = in0 ? s0.V : s1.V; const int ks = in0 ? s0.ks : s1.ks, vs = in0 ? s0.vs : s1.vs;
        const bf16* kp = Kb + (size_t)(tt * 64 + lane) * ks;
        kreg0 = ld8(kp + wave * 8);
        if (DK == 96 && wave < 4) kreg1 = ld8(kp + (wave + 8) * 8);
        vreg = ld8(Vb + (size_t)(tt * 64 + vkey) * vs + vch * 8);
    };
    auto stage_write = [&](int buf) {
        LAS unsigned char* kb = lds + buf * ATT_KVB;
        *(LAS bf16x8*)(kb + wave * 1024 + lane * 16) = kreg0;
        if (DK == 96 && wave < 4) *(LAS bf16x8*)(kb + (wave + 8) * 1024 + lane * 16) = kreg1;
        *(LAS bf16x8*)(kb + KB + wave * 1024 + lane * 16) = vreg;
    };
    float m = 0.f, lsum = 0.f;
    f32x16 o0 = (f32x16){}, o1 = (f32x16){}, negm = (f32x16){};
    stage_load(0); stage_write(0);
    __syncthreads();
    if (!LOCAL_OK && fast) {
    const f32x16 zero16 = (f32x16){};
    for (int t = 0; t < nt; ++t) {
        if (t + 1 < nt) stage_load(t + 1);
        ldsc_t kb = (ldsc_t)(lds + (t & 1) * ATT_KVB);
        f32x16 p0, p1;
        __builtin_amdgcn_s_setprio(1);
        __builtin_amdgcn_iglp_opt(1);
        bf16x8 kf0[NS], kf1[NS];
#pragma unroll
        for (int s = 0; s < NS; ++s) { kf0[s] = *(LAS const bf16x8*)(kb + (2 * s + hi) * 1024 + r32 * 16); kf1[s] = *(LAS const bf16x8*)(kb + (2 * s + hi) * 1024 + r32 * 16 + 512); }
        __builtin_amdgcn_sched_barrier(0);
        p0 = mfma32(kf0[0], qf[0], zero16);
#pragma unroll
        for (int s = 1; s < NS; ++s) p0 = mfma32(kf0[s], qf[s], p0);
        p1 = mfma32(kf1[0], qf[0], zero16);
#pragma unroll
        for (int s = 1; s < NS; ++s) p1 = mfma32(kf1[s], qf[s], p1);
        __builtin_amdgcn_s_setprio(0);
        ldsc_t vp = kb + KB + ((lane >> 4) & 1) * 32 + (lane & 3) * 8 + (4 * hi + ((lane & 15) >> 2)) * 64;
        s16x4 va[8], vb[8];
#pragma unroll
        for (int i = 0; i < 8; ++i) { va[i] = vtr(vp + (i >> 2) * 4096 + (i & 3) * 1024); vb[i] = vtr(vp + (i >> 2) * 4096 + (i & 3) * 1024 + 512); }
#define ATT_VF(i) ((bf16x8){va[i][0], va[i][1], va[i][2], va[i][3], vb[i][0], vb[i][1], vb[i][2], vb[i][3]})
        float ps = 0.f; float e0[16], e1[16];
#pragma unroll
        for (int r = 0; r < 16; ++r) { e0[r] = __builtin_amdgcn_exp2f(p0[r]); ps += e0[r]; }
        const bf16x8 pa0 = pack8(e0), pa1 = pack8(e0 + 8);
        __builtin_amdgcn_sched_barrier(0);
        o0 = mfma32(ATT_VF(0), pa0, o0); o1 = mfma32(ATT_VF(4), pa0, o1);
        o0 = mfma32(ATT_VF(1), pa1, o0); o1 = mfma32(ATT_VF(5), pa1, o1);
        __builtin_amdgcn_sched_barrier(0);
#pragma unroll
        for (int r = 0; r < 16; ++r) { e1[r] = __builtin_amdgcn_exp2f(p1[r]); ps += e1[r]; }
        lsum += ps;
        const bf16x8 pa2 = pack8(e1), pa3 = pack8(e1 + 8);
        __builtin_amdgcn_sched_barrier(0);
        o0 = mfma32(ATT_VF(2), pa2, o0); o1 = mfma32(ATT_VF(6), pa2, o1);
        o0 = mfma32(ATT_VF(3), pa3, o0); o1 = mfma32(ATT_VF(7), pa3, o1);
#undef ATT_VF
        if (t + 1 < nt) stage_write((t + 1) & 1);
        __syncthreads();
    }
    } else
    for (int t = 0; t < nt; ++t) {
        if (t + 1 < nt) stage_load(t + 1);
        bool active = true; int dr = 0;
        if (LOCAL && t >= s0.nt) { const int kr = kr_lo + (t - s0.nt); active = (kr >= my_rs) && (kr < my_rs + 8); dr = kr - my_row + 7; }
        if (active) {
            ldsc_t kb = (ldsc_t)(lds + (t & 1) * ATT_KVB);
            f32x16 p0, p1;
            __builtin_amdgcn_s_setprio(1);
            __builtin_amdgcn_iglp_opt(1);
            bf16x8 kf0[NS], kf1[NS];
#pragma unroll
            for (int s = 0; s < NS; ++s) { kf0[s] = *(LAS const bf16x8*)(kb + (2 * s + hi) * 1024 + r32 * 16); kf1[s] = *(LAS const bf16x8*)(kb + (2 * s + hi) * 1024 + r32 * 16 + 512); }
            __builtin_amdgcn_sched_barrier(0);
#pragma unroll
            for (int s = 0; s < NS; ++s) {
                if (s == 0) { p0 = mfma32(kf0[0], qf[0], negm); p1 = mfma32(kf1[0], qf[0], negm); }
                else { p0 = mfma32(kf0[s], qf[s], p0); p1 = mfma32(kf1[s], qf[s], p1); }
            }
            __builtin_amdgcn_s_setprio(0);
            if (LOCAL && t >= s0.nt) {
                LAS const float* bt = (LAS const float*)(lds + ATT_BIAS_OFF) + lbase + dr * 34;
#pragma unroll
                for (int r = 0; r < 16; ++r) {
                    const int j0 = min(max(jbase + (r & 3) + 8 * (r >> 2), 0), 33), j1 = min(max(jbase + (r & 3) + 8 * (r >> 2) + 32, 0), 33);
                    p0[r] += bt[j0]; p1[r] += bt[j1];
                }
            }
            float mxa = max3f(p0[0], p0[1], p1[0]), mxb = max3f(p0[2], p0[3], p1[1]); mxa = max3f(mxa, p1[2], p1[3]);
#pragma unroll
            for (int r = 4; r < 16; r += 4) { mxa = max3f(mxa, p0[r], p0[r + 1]); mxb = max3f(mxb, p0[r + 2], p0[r + 3]); mxa = max3f(mxa, p1[r], p1[r + 1]); mxb = max3f(mxb, p1[r + 2], p1[r + 3]); }
            float mx = max2f(mxa, mxb);
            { const auto rr = __builtin_amdgcn_permlane32_swap(__float_as_uint(mx), __float_as_uint(mx), false, false); mx = max2f(__uint_as_float(rr[0]), __uint_as_float(rr[1])); }
            if (t == 0 || !__all(mx <= 8.0f)) {
                const float d = t == 0 ? mx : fmaxf(mx, 0.f); const float al = __builtin_amdgcn_exp2f(-d);
#pragma unroll
                for (int r = 0; r < 16; ++r) { o0[r] *= al; o1[r] *= al; p0[r] -= d; p1[r] -= d; }
                lsum *= al; m += d;
#pragma unroll
                for (int r = 0; r < 16; ++r) negm[r] = -m;
            }
            ldsc_t vp = kb + KB + ((lane >> 4) & 1) * 32 + (lane & 3) * 8 + (4 * hi + ((lane & 15) >> 2)) * 64;
            s16x4 va[8], vb[8];
#pragma unroll
            for (int i = 0; i < 8; ++i) { va[i] = vtr(vp + (i >> 2) * 4096 + (i & 3) * 1024); vb[i] = vtr(vp + (i >> 2) * 4096 + (i & 3) * 1024 + 512); }
#define ATT_VF(i) ((bf16x8){va[i][0], va[i][1], va[i][2], va[i][3], vb[i][0], vb[i][1], vb[i][2], vb[i][3]})
            float ps = 0.f; float e0[16], e1[16];
#pragma unroll
            for (int r = 0; r < 16; ++r) { e0[r] = __builtin_amdgcn_exp2f(p0[r]); ps += e0[r]; }
            const bf16x8 pa0 = pack8(e0), pa1 = pack8(e0 + 8);
            __builtin_amdgcn_sched_barrier(0);
            o0 = mfma32(ATT_VF(0), pa0, o0); o1 = mfma32(ATT_VF(4), pa0, o1);
            o0 = mfma32(ATT_VF(1), pa1, o0); o1 = mfma32(ATT_VF(5), pa1, o1);
            __builtin_amdgcn_sched_barrier(0);
#pragma unroll
            for (int r = 0; r < 16; ++r) { e1[r] = __builtin_amdgcn_exp2f(p1[r]); ps += e1[r]; }
            lsum += ps;
            const bf16x8 pa2 = pack8(e1), pa3 = pack8(e1 + 8);
            __builtin_amdgcn_sched_barrier(0);
            o0 = mfma32(ATT_VF(2), pa2, o0); o1 = mfma32(ATT_VF(6), pa2, o1);
            o0 = mfma32(ATT_VF(3), pa3, o0); o1 = mfma32(ATT_VF(7), pa3, o1);
#undef ATT_VF
        }
        if (t + 1 < nt) stage_write((t + 1) & 1);
        __syncthreads();
    }
    const float inv = 1.0f / xor32_sum(lsum);
    if (!dry) {
    bf16* grow = Gp + (size_t)(wave * 32 + r32) * gs;
#pragma unroll
    for (int g = 0; g < 4; ++g) {
        { bf16* p = grow + 8 * g + 4 * hi; const u32x2 w = *(const u32x2*)p;
          st4bf(p, o0[4 * g] * inv * silu_f(lo_f(w.x)), o0[4 * g + 1] * inv * silu_f(hi_f(w.x)), o0[4 * g + 2] * inv * silu_f(lo_f(w.y)), o0[4 * g + 3] * inv * silu_f(hi_f(w.y))); }
        { bf16* p = grow + 32 + 8 * g + 4 * hi; const u32x2 w = *(const u32x2*)p;
          st4bf(p, o1[4 * g] * inv * silu_f(lo_f(w.x)), o1[4 * g + 1] * inv * silu_f(hi_f(w.x)), o1[4 * g + 2] * inv * silu_f(lo_f(w.y)), o1[4 * g + 3] * inv * silu_f(hi_f(w.y))); }
    }
    } else { asm volatile("" :: "v"(o0), "v"(o1), "v"(inv)); }
    __syncthreads();
}

constexpr int ATT_UNITS = 1920;
__device__ __forceinline__ void attn_dispatch(CArgs& a, int l, int u, LAS unsigned char* lds, int tid, int dmode) {
    const bool dry = dmode != 0;
    unsigned char* ws = a.ws;
    bf16* PA = (bf16*)(ws + WS_PA);
    if (u < 768 || (u >= 1536 && u < 1728)) {
        AttnSeg s0, s1; int tok0, h;
        if (u < 768) { const int b = u / 96, qb = u % 16; h = (u / 16) % 6; tok0 = NTC + b * TL + qb * 256;
            s0 = AttnSeg{(const bf16*)(ws + WS_CK) + (size_t)(b * 512) * 576 + h * 96, (const bf16*)(ws + WS_CV) + (size_t)(b * 512) * 384 + h * 64, 576, 384, 8};
            s1 = AttnSeg{(const bf16*)(ws + WS_MK) + (size_t)(NTC + b * TL) * 576 + h * 96, (const bf16*)(ws + WS_MV) + (size_t)(NTC + b * TL) * 384 + h * 64, 576, 384, 64};
        } else { const int v = u - 1536; const int b = v / 6; h = v % 6; tok0 = b * TC;
            s0 = AttnSeg{(const bf16*)(ws + WS_MK) + (size_t)tok0 * 576 + h * 96, (const bf16*)(ws + WS_MV) + (size_t)tok0 * 384 + h * 64, 576, 384, 4};
            s1 = AttnSeg{s0.K, s0.V, 576, 384, 0}; }
        attn_unit<96, false>(lds, (const bf16*)(ws + WS_Q) + (size_t)tok0 * 576 + h * 96, 576, s0, s1, PA + (size_t)tok0 * LDA + CA_GM + h * 64, LDA, false, nullptr, 0, 0, tid, dry, ((const float*)(ws + WS_ABND))[l] <= 60.0f);
    } else {
        AttnSeg s0, s1; int tok0, h, r0 = 0, kr_lo = 0; bool local = false;
        if (u < 1536) { const int v = u - 768; const int b = v / 96, rg = v % 16; h = (v / 16) % 6; tok0 = NTC + b * TL + rg * 256; r0 = rg * 4; local = true;
            kr_lo = min(max(r0 - 4, 0), 56); const int kr_hi = min(max(r0 + 3 - 4, 0), 56) + 8;
            s0 = AttnSeg{(const bf16*)(ws + WS_NACK) + ((size_t)(b * 2 + l) * 512) * 384 + h * 64, (const bf16*)(ws + WS_NACV) + ((size_t)(b * 2 + l) * 512) * 384 + h * 64, 384, 384, 8};
            const bf16* kb = PA + (size_t)(NTC + b * TL + kr_lo * 64) * LDA;
            s1 = AttnSeg{kb + CA_KN + h * 64, kb + CA_VN + h * 64, LDA, LDA, kr_hi - kr_lo};
        } else { const int v = u - 1728; const int b = v / 6; h = v % 6; tok0 = b * TC;
            const bf16* kb = PA + (size_t)tok0 * LDA;
            s0 = AttnSeg{kb + CA_KN + h * 64, kb + CA_VN + h * 64, LDA, LDA, 4};
            s1 = AttnSeg{s0.K, s0.V, LDA, LDA, 0}; }
        attn_unit<64, true>(lds, PA + (size_t)tok0 * LDA + CA_QN + h * 64, LDA, s0, s1, PA + (size_t)tok0 * LDA + CA_GN + h * 64, LDA, local, a.in[26] + (size_t)(l * 6 + h) * 15 * 31, r0, kr_lo, tid, dry, false);
    }
}

constexpr int SC_R = 0, SC_V = 4096, SC_NK = 8192, SC_W = 12288, SC_BB = 16384, SC_KD = 20480, SC_KC = 24576, SC_AA = 28672, SC_YB = 32768;
constexpr int SC_NT = 36864, SC_RT = SC_NT + 2176, SC_BT = SC_RT + 2176, SC_KT = SC_BT + 2176;
constexpr int SC_BHT = SC_KT + 2176, SC_KHT = SC_BHT + 2560, SC_VT = SC_KHT + 2560;
constexpr int SC_GC = SC_VT + 2560;
constexpr int SC_A1 = SC_GC + 256;
constexpr int SC_A2 = SC_A1 + 1024, SC_B1 = SC_A2 + 640, SC_B2 = SC_B1 + 640;
constexpr int SC_TW = SC_B2 + 640;
constexpr int SC_CW = SC_TW + 4 * 640;
constexpr int SC_YP = SC_CW + 12 * 256;
constexpr int SC_GC2 = SC_YP + 2048;
constexpr int SC_GX = SC_GC2 + 256;
constexpr int SCAN_SLOT = SC_GX + 1024;
static_assert(2 * SCAN_SLOT <= 131072, "scan LDS map");
__device__ __forceinline__ float dot4(f32x4 x, f32x4 y) { return (x[0] * y[0] + x[1] * y[1]) + (x[2] * y[2] + x[3] * y[3]); }
__device__ __forceinline__ f32x4 ldbf4(const bf16* p) { const u32x2 w = *(const u32x2*)p; return (f32x4){lo_f(w.x), hi_f(w.x), lo_f(w.y), hi_f(w.y)}; }
__device__ __forceinline__ f32x4 cvbf4(u32x2 w) { return (f32x4){lo_f(w.x), hi_f(w.x), lo_f(w.y), hi_f(w.y)}; }
__device__ __forceinline__ float tanh_f(float x) { return 1.f - 2.f * rcp_f(1.f + __expf(2.f * x)); }
__device__ __forceinline__ u32x2 pk4(f32x4 v) { u32x2 w; w.x = pk2(v[0], v[1]); w.y = pk2(v[2], v[3]); return w; }
__device__ __forceinline__ bf16x8 cat8(u32x2 lo, u32x2 hi) { u32x4 w; w.x = lo.x; w.y = lo.y; w.z = hi.x; w.w = hi.y; return __builtin_bit_cast(bf16x8, w); }
__device__ __forceinline__ f32x4 mfma16(bf16x8 x, bf16x8 y, f32x4 c) { return __builtin_amdgcn_mfma_f32_16x16x32_bf16(x, y, c, 0, 0, 0); }
__device__ __forceinline__ u32x2 lds8(LAS const unsigned char* p) { return *(LAS const u32x2*)p; }

__device__ __forceinline__ unsigned char* scan_yp(unsigned char* ws, int jobid) { return jobid < 704 ? ws + WS_YPA + (size_t)jobid * 32768 : ws + WS_YPB + (size_t)(jobid - 704) * 32768; }
__device__ __forceinline__ void scan_job(CArgs& a, int l, LAS unsigned char* slot, bool lat, int b, int d, int h, int c, int jt, int w4, int lane, int mode, int hw) {
    const bool PH1 = lat && c > 0;
    asm volatile("" : "+v"(jt), "+v"(lane));
    (void)mode;
    unsigned char* ws = a.ws;
    const int T = lat ? TL : TC, tokbase = lat ? NTC + b * TL : b * TC;
    const int chain = b * 8 + d * 4 + h;
    const bf16* PA = (const bf16*)(ws + WS_PA);
    const int g4 = lane >> 4, j16 = lane & 15;
    const int tokl = jt >> 4, cg = jt & 15;
    LAS float* fCW = (LAS float*)(slot + SC_CW);
    for (int i = jt; i < 12 * 64; i += 256) { const int rw = i >> 6, ch = i & 63; float v;
        if (rw < 9) v = a.in[14][(size_t)l * 3 * 768 + (rw % 3) * 768 + (rw / 3) * 256 + h * 64 + ch];
        else if (rw == 9) v = a.in[19][l * 256 + h * 64 + ch]; else if (rw == 10) v = a.in[20][l * 256 + h * 64 + ch]; else v = a.in[21][(l * 4 + h) * 64 + ch];
        fCW[i] = v; }
    const bf16* lora_w = (const bf16*)(ws + WS_LORA) + (size_t)(((l * 2 + 0) * 2 + d) * 256 + h * 64 + 16 * w4 + j16) * 64 + 8 * g4;
    const bf16* lora_a = (const bf16*)(ws + WS_LORA) + (size_t)(((l * 2 + 1) * 2 + d) * 256 + h * 64 + 16 * w4 + j16) * 64 + 8 * g4;
    const bf16x8 lw0 = ld8(lora_w), lw1 = ld8(lora_w + 32), la0 = ld8(lora_a), la1 = ld8(lora_a + 32);
    const float w0c = a.in[15][(l * 2 + d) * 256 + h * 64 + 16 * w4 + j16];
    const float a0c = a.in[17][(l * 2 + d) * 256 + h * 64 + 16 * w4 + j16];
    f32x4 S[4], P[4];
    {
        const float* src = nullptr;
        if (!PH1 && lat) src = a.in[2] + (size_t)((((b * 2 + l) * 2 + d) * 4 + h)) * 4096;
#pragma unroll
        for (int blk = 0; blk < 4; ++blk) {
            S[blk] = src ? *(const f32x4*)(src + (16 * w4 + j16) * 64 + 16 * blk + 4 * g4) : (f32x4){0.f, 0.f, 0.f, 0.f};
#pragma unroll
            for (int q = 0; q < 4; ++q) P[blk][q] = (PH1 && (16 * w4 + j16 == 16 * blk + 4 * g4 + q)) ? 1.f : 0.f;
        }
    }
    LAS float* fR = (LAS float*)(slot + SC_R); LAS float* fV = (LAS float*)(slot + SC_V); LAS float* fNK = (LAS float*)(slot + SC_NK); LAS float* fW = (LAS float*)(slot + SC_W);
    LAS float* fBB = (LAS float*)(slot + SC_BB); LAS float* fKD = (LAS float*)(slot + SC_KD); LAS float* fKC = (LAS float*)(slot + SC_KC); LAS float* fAA = (LAS float*)(slot + SC_AA);
    LAS float* fYB = (LAS float*)(slot + SC_YB); LAS float* fGC = (LAS float*)(slot + SC_GC); LAS float* fA1 = (LAS float*)(slot + SC_A1);
    LAS unsigned char* TWw = slot + SC_TW + w4 * 640;
    u32x2 q_r[3], q_k[3], q_v[3]; bf16x8 q_wd0, q_wd1, q_ad0, q_ad1;
    auto issue_loads = [&](int sub) {
        const int tau0 = c * SCAN_L + sub * 16;
        { const int tau = tau0 + tokl; const int t = d ? T - 1 - tau : tau; const bf16* row = PA + ((size_t)tokbase + t) * LDA + h * 64 + 4 * cg;
          const bool hp = t > 0, hn = t + 1 < T; const u32x2 z = (u32x2){0u, 0u};
          q_r[0] = hp ? *(const u32x2*)(row - LDA + CA_R) : z; q_r[1] = *(const u32x2*)(row + CA_R); q_r[2] = hn ? *(const u32x2*)(row + LDA + CA_R) : z;
          q_k[0] = hp ? *(const u32x2*)(row - LDA + CA_K) : z; q_k[1] = *(const u32x2*)(row + CA_K); q_k[2] = hn ? *(const u32x2*)(row + LDA + CA_K) : z;
          q_v[0] = hp ? *(const u32x2*)(row - LDA + CA_V) : z; q_v[1] = *(const u32x2*)(row + CA_V); q_v[2] = hn ? *(const u32x2*)(row + LDA + CA_V) : z; }
        { const int tau2 = tau0 + j16; const int t2 = d ? T - 1 - tau2 : tau2; const bf16* row2 = PA + ((size_t)tokbase + t2) * LDA;
          q_wd0 = ld8(row2 + CA_WD + 8 * g4); q_wd1 = ld8(row2 + CA_WD + 32 + 8 * g4); q_ad0 = ld8(row2 + CA_AD + 8 * g4); q_ad1 = ld8(row2 + CA_AD + 32 + 8 * g4); }
    };
    auto stage_a = [&](int sa) {
    {
#define CWR(rw) (*(LAS const f32x4*)(fCW + (rw) * 64 + 4 * cg))
        const f32x4 r_c = cvbf4(q_r[0]) * CWR(0) + cvbf4(q_r[1]) * CWR(1) + cvbf4(q_r[2]) * CWR(2);
        const f32x4 k_c = cvbf4(q_k[0]) * CWR(3) + cvbf4(q_k[1]) * CWR(4) + cvbf4(q_k[2]) * CWR(5);
        const f32x4 v_c = cvbf4(q_v[0]) * CWR(6) + cvbf4(q_v[1]) * CWR(7) + cvbf4(q_v[2]) * CWR(8);
        const f32x4 kk = k_c * CWR(9);
        float ss = dot4(kk, kk); ss = row16_sum(ss);
        const float inv = __builtin_amdgcn_rsqf(fmaxf(ss, 1e-24f));
        const int o = tokl * 64 + 4 * cg;
        *(LAS f32x4*)(fR + o) = r_c; *(LAS f32x4*)(fV + o) = v_c; *(LAS f32x4*)(fNK + o) = kk * (-inv); *(LAS f32x4*)(fKC + o) = k_c;
    }
    {
        f32x4 accw = (f32x4){0.f, 0.f, 0.f, 0.f}, acca = (f32x4){0.f, 0.f, 0.f, 0.f}; float dq[4];
        accw = mfma16(q_wd0, lw0, accw); accw = mfma16(q_wd1, lw1, accw);
        acca = mfma16(q_ad0, la0, acca); acca = mfma16(q_ad1, la1, acca);
#pragma unroll
        for (int q = 0; q < 4; ++q) {
            const float x = -(w0c + accw[q]);
            const float sp = fmaxf(x, 0.f) + __logf(1.f + __expf(-fabsf(x)));
            const float decay = __expf(-__expf(-sp - 0.5f));
            const float av = sigmoid_f(a0c + acca[q]);
            const int o = (4 * g4 + q) * 64 + 16 * w4 + j16;
            dq[q] = decay; fAA[o] = av;
        }
        dq[1] *= dq[0]; dq[2] *= dq[1]; dq[3] *= dq[2];
        LAS float* gx = (LAS float*)(slot + SC_GX + w4 * 256);
        gx[g4 * 16 + j16] = dq[3];
        LDS_WAIT();
        const float G0 = gx[j16], G1 = gx[16 + j16], G2 = gx[32 + j16], G3 = gx[48 + j16];
        const float E = g4 == 0 ? 1.f : (g4 == 1 ? G0 : (g4 == 2 ? G0 * G1 : G0 * G1 * G2));
#pragma unroll
        for (int q = 0; q < 4; ++q) fW[(4 * g4 + q) * 64 + 16 * w4 + j16] = E * dq[q];
        if (g4 == 0) ((LAS float*)(slot + ((sa & 1) ? SC_GC2 : SC_GC)))[16 * w4 + j16] = (G0 * G1) * (G2 * G3);
    }
    };
    auto flush_y = [&](int sf) {
        const int tauf = c * SCAN_L + sf * 16 + tokl; const int tf_ = d ? T - 1 - tauf : tauf; const size_t tokf = (size_t)tokbase + tf_;
        const f32x4 y4 = *(LAS const f32x4*)(fYB + tokl * 64 + 4 * cg);
        st4bf((bf16*)(ws + WS_Y) + tokf * 512 + d * 256 + h * 64 + 4 * cg, y4[0], y4[1], y4[2], y4[3]);
        if (PH1) *(u32x2*)(scan_yp(ws, chain * 15 + c - 1) + sf * 2048 + jt * 8) = *(LAS const u32x2*)(slot + SC_YP + jt * 8);
    };
    issue_loads(0);
    __syncthreads();
    stage_a(0);
    if (SCAN_L > 16) issue_loads(1);
#pragma unroll 1
    for (int sub = 0; sub < SCAN_L / 16; ++sub) {
        const int tau0 = c * SCAN_L + sub * 16;
        const int tau = tau0 + tokl; const int t = d ? T - 1 - tau : tau; const size_t tok = (size_t)tokbase + t;
        __syncthreads();
        if (sub > 0) flush_y(sub - 1);
        {
            const int o = tokl * 64 + 4 * cg;
            const f32x4 a4 = *(LAS const f32x4*)(fAA + o), nk4 = *(LAS const f32x4*)(fNK + o), kc4 = *(LAS const f32x4*)(fKC + o), r4 = *(LAS const f32x4*)(fR + o);
            const f32x4 bb = -(nk4 * a4);
            const f32x4 kd = kc4 * ((a4 - 1.0f) * CWR(10) + 1.0f);
            *(LAS f32x4*)(fBB + o) = bb; *(LAS f32x4*)(fKD + o) = kd;
            { float cf = dot4(r4 * kd, CWR(11)); cf = row16_sum(cf);
              if (cg == 0) ((float*)(ws + WS_CC))[(tok * 2 + d) * 4 + h] = cf; }
            const f32x4 gi = *(LAS const f32x4*)(fW + o);
            const f32x4 gm = tokl > 0 ? *(LAS const f32x4*)(fW + o - 64) : (f32x4){1.f, 1.f, 1.f, 1.f};
            const f32x4 ig = (f32x4){rcp_f(gi[0]), rcp_f(gi[1]), rcp_f(gi[2]), rcp_f(gi[3])};
            const int ob = (tokl * 68 + 4 * cg) * 2;
            *(LAS u32x2*)(slot + SC_NT + ob) = pk4(gm * nk4); *(LAS u32x2*)(slot + SC_RT + ob) = pk4(gi * r4);
            *(LAS u32x2*)(slot + SC_BT + ob) = pk4(bb * ig);  *(LAS u32x2*)(slot + SC_KT + ob) = pk4(kd * ig);
        }
        __syncthreads();
        {
            const int k = jt & 63, ig = jt >> 6;
            const float g = ((LAS const float*)(slot + ((sub & 1) ? SC_GC2 : SC_GC)))[k];
            f32x4 bh, kh, vt;
#pragma unroll
            for (int e = 0; e < 4; ++e) { const int i = 4 * ig + e; const float sc = g * rcp_f(fW[i * 64 + k]); bh[e] = fBB[i * 64 + k] * sc; kh[e] = fKD[i * 64 + k] * sc; vt[e] = fV[i * 64 + k]; }
            const int ob = (k * 20 + 4 * ig) * 2;
            *(LAS u32x2*)(slot + SC_BHT + ob) = pk4(bh); *(LAS u32x2*)(slot + SC_KHT + ob) = pk4(kh); *(LAS u32x2*)(slot + SC_VT + ob) = pk4(vt);
        }
        {
            const int pi = (w4 - hw) & 3;
            LAS const unsigned char* Xa = slot + ((pi < 2) ? SC_NT : SC_RT) + (j16 * 68 + 4 * g4) * 2;
            LAS const unsigned char* Yb = slot + ((pi & 1) ? SC_KT : SC_BT) + (j16 * 68 + 4 * g4) * 2;
            f32x4 acc = (f32x4){0.f, 0.f, 0.f, 0.f};
            acc = mfma16(cat8(lds8(Xa), lds8(Xa + 32)), cat8(lds8(Yb), lds8(Yb + 32)), acc);
            acc = mfma16(cat8(lds8(Xa + 64), lds8(Xa + 96)), cat8(lds8(Yb + 64), lds8(Yb + 96)), acc);
#pragma unroll
            for (int q = 0; q < 4; ++q) { const int i = 4 * g4 + q; const bool keep = (pi < 2) ? (j16 < i) : (j16 <= i); const float v = keep ? acc[q] : 0.f;
                if (pi == 0) fA1[i * 16 + j16] = v;
                else *(LAS unsigned short*)(slot + (pi == 1 ? SC_A2 : (pi == 2 ? SC_B1 : SC_B2)) + (i * 20 + j16) * 2) = (unsigned short)(pk2(v, 0.f) & 0xffffu); }
            if (pi == 0) {
                LDS_WAIT();
                const int cT = lane >> 2, pT = lane & 3;
                f32x4 ts = (f32x4){0.f, 0.f, 0.f, 0.f};
#pragma unroll
                for (int i = 0; i < 16; ++i) { const f32x4 a4 = *(LAS const f32x4*)(fA1 + i * 16 + 4 * pT);
                    float part = dot4(a4, ts); part += dpp_f<0xB1>(part); part += dpp_f<0x4E>(part);
                    const float tic = part + (i == cT ? 1.f : 0.f);
                    if (pT == (i >> 2)) ts[i & 3] = tic; }
#pragma unroll
                for (int e = 0; e < 4; ++e) *(LAS unsigned short*)(slot + SC_TW + ((4 * pT + e) * 20 + cT) * 2) = (unsigned short)(pk2(ts[e], 0.f) & 0xffffu);
            }
        }
        __syncthreads();
        {
            const u32x2 z2 = (u32x2){0u, 0u};
            LAS const unsigned char* ntp = slot + SC_NT + (j16 * 68 + 4 * g4) * 2;
            LAS const unsigned char* rtp = slot + SC_RT + (j16 * 68 + 4 * g4) * 2;
            const bf16x8 nta0 = cat8(lds8(ntp), lds8(ntp + 32)), nta1 = cat8(lds8(ntp + 64), lds8(ntp + 96));
            const bf16x8 rta0 = cat8(lds8(rtp), lds8(rtp + 32)), rta1 = cat8(lds8(rtp + 64), lds8(rtp + 96));
            const u32x2 vf = lds8(slot + SC_VT + ((16 * w4 + j16) * 20 + 4 * g4) * 2);
            const bf16x8 a2f = cat8(lds8(slot + SC_A2 + (j16 * 20 + 4 * g4) * 2), z2);
            const bf16x8 b12 = cat8(lds8(slot + SC_B1 + (j16 * 20 + 4 * g4) * 2), lds8(slot + SC_B2 + (j16 * 20 + 4 * g4) * 2));
            const bf16x8 tf = cat8(lds8(slot + SC_TW + (j16 * 20 + 4 * g4) * 2), z2);
            const f32x4 z4 = (f32x4){0.f, 0.f, 0.f, 0.f};
            f32x4 gc[4];
#pragma unroll
            for (int blk = 0; blk < 4; ++blk) gc[blk] = *(LAS const f32x4*)((LAS const float*)(slot + ((sub & 1) ? SC_GC2 : SC_GC)) + 16 * blk + 4 * g4);
            bf16x8 af[4];
#pragma unroll
            for (int blk = 0; blk < 4; ++blk) af[blk] = cat8(lds8(slot + SC_BHT + ((16 * blk + j16) * 20 + 4 * g4) * 2), lds8(slot + SC_KHT + ((16 * blk + j16) * 20 + 4 * g4) * 2));
            {
                const bf16x8 sb0 = cat8(pk4(S[0]), pk4(S[1])), sb1 = cat8(pk4(S[2]), pk4(S[3]));
                f32x4 X = mfma16(nta0, sb0, z4); X = mfma16(nta1, sb1, X); X = mfma16(a2f, cat8(vf, z2), X);
                const f32x4 Z = mfma16(tf, cat8(pk4(X), z2), z4);
                const bf16x8 zv = cat8(pk4(Z), vf);
#pragma unroll
                for (int blk = 0; blk < 4; ++blk) S[blk] = mfma16(af[blk], zv, S[blk] * gc[blk]);
                { f32x4 Y = mfma16(rta0, sb0, z4); Y = mfma16(rta1, sb1, Y); Y = mfma16(b12, zv, Y);
#pragma unroll
                  for (int q = 0; q < 4; ++q) fYB[(4 * g4 + q) * 64 + 16 * w4 + j16] = Y[q]; }
            }
            if (PH1) {
                const bf16x8 pb0 = cat8(pk4(P[0]), pk4(P[1])), pb1 = cat8(pk4(P[2]), pk4(P[3]));
                f32x4 X = mfma16(nta0, pb0, z4); X = mfma16(nta1, pb1, X);
                const f32x4 Z = mfma16(tf, cat8(pk4(X), z2), z4);
                const bf16x8 zp = cat8(pk4(Z), z2);
#pragma unroll
                for (int blk = 0; blk < 4; ++blk) P[blk] = mfma16(af[blk], zp, P[blk] * gc[blk]);
                f32x4 Yp = mfma16(rta0, pb0, z4); Yp = mfma16(rta1, pb1, Yp); Yp = mfma16(b12, zp, Yp);
#pragma unroll
                for (int q = 0; q < 4; ++q) *(LAS unsigned short*)(slot + SC_YP + ((4 * g4 + q) * 64 + 16 * w4 + j16) * 2) = (unsigned short)(pk2(Yp[q], 0.f) & 0xffffu);
            }
        }
        if (sub + 1 < SCAN_L / 16) { stage_a(sub + 1); if (sub + 2 < SCAN_L / 16) issue_loads(sub + 2); }
    }
    __syncthreads();
    flush_y(SCAN_L / 16 - 1);
    if (PH1) {
        if (c < 15) {
            float* Pg = (float*)(ws + WS_SCAN) + (size_t)(chain * 14 + c - 1) * 2 * 4096; float* Qg = Pg + 4096;
#pragma unroll
            for (int blk = 0; blk < 4; ++blk) { const int o = (16 * w4 + j16) * 64 + 16 * blk + 4 * g4; *(f32x4*)(Pg + o) = P[blk]; *(f32x4*)(Qg + o) = S[blk]; }
        }
    } else {
        float* st = lat ? (float*)(ws + WS_S1) + (size_t)chain * 4096 : a.out + OUT_STATE + (size_t)((((b * 2 + l) * 2 + d) * 4 + h)) * 4096;
#pragma unroll
        for (int blk = 0; blk < 4; ++blk) *(f32x4*)(st + (16 * w4 + j16) * 64 + 16 * blk + 4 * g4) = S[blk];
    }
}

__device__ __forceinline__ void phase_scan1(CArgs& a, int l, LAS unsigned char* lds, int vcu, int G, int tid, int wave, int lane, int mode) {
    const int hw = wave >> 2, w4 = wave & 3, jt = tid & 255;
    for (int p = vcu; p < 640; p += G) {
        const int jid = 2 * p + hw;
        if (jid < 1024) { const int chain = jid >> 4, c = jid & 15; scan_job(a, l, lds + hw * SCAN_SLOT, true, chain >> 3, (chain >> 2) & 1, chain & 3, c, jt, w4, lane, mode, hw); }
        else { const int chain = jid - 1024; scan_job(a, l, lds + hw * SCAN_SLOT, false, chain >> 3, (chain >> 2) & 1, chain & 3, 0, jt, w4, lane, mode, hw); }
        __syncthreads();
    }
}
__device__ __forceinline__ void phase_scan2(CArgs& a, int l, LAS unsigned char* lds, int vcu, int G, int tid) {
    for (int chain = vcu; chain < 64; chain += G) {
        LAS float* Sl = (LAS float*)lds;
        LAS float* Pl = (LAS float*)(lds + 20480);
        const int row = tid >> 3, jc = tid & 7;
        const float* s0 = (const float*)(a.ws + WS_S1) + (size_t)chain * 4096 + row * 64 + 8 * jc;
        __syncthreads();
#pragma unroll
        for (int q = 0; q < 8; ++q) Sl[row * 65 + 8 * jc + q] = s0[q];
        f32x4 p0, p1, o0, o1;
        { const float* Pg = (const float*)(a.ws + WS_SCAN) + (size_t)(chain * 14) * 2 * 4096; const float* Qg = Pg + 4096;
          p0 = *(const f32x4*)(Pg + tid * 8); p1 = *(const f32x4*)(Pg + tid * 8 + 4); o0 = *(const f32x4*)(Qg + row * 64 + 8 * jc); o1 = *(const f32x4*)(Qg + row * 64 + 8 * jc + 4); }
        for (int c = 0; c < 14; ++c) {
            float* Pg = (float*)(a.ws + WS_SCAN) + (size_t)(chain * 14 + c) * 2 * 4096; float* Qg = Pg + 4096;
            *(LAS f32x4*)(Pl + tid * 8) = p0; *(LAS f32x4*)(Pl + tid * 8 + 4) = p1;
            f32x4 a0 = o0, a1 = o1;
            if (c + 1 < 14) { const float* Pn = Pg + 2 * 4096; const float* Qn = Pn + 4096;
                p0 = *(const f32x4*)(Pn + tid * 8); p1 = *(const f32x4*)(Pn + tid * 8 + 4); o0 = *(const f32x4*)(Qn + row * 64 + 8 * jc); o1 = *(const f32x4*)(Qn + row * 64 + 8 * jc + 4); }
            __syncthreads();
#pragma unroll 8
            for (int k = 0; k < 64; ++k) { const float s = Sl[row * 65 + k]; a0 += *(LAS const f32x4*)(Pl + k * 64 + 8 * jc) * s; a1 += *(LAS const f32x4*)(Pl + k * 64 + 8 * jc + 4) * s; }
            __syncthreads();
#pragma unroll
            for (int q = 0; q < 4; ++q) { Sl[row * 65 + 8 * jc + q] = a0[q]; Sl[row * 65 + 8 * jc + 4 + q] = a1[q]; }
            *(f32x4*)(Qg + row * 64 + 8 * jc) = a0; *(f32x4*)(Qg + row * 64 + 8 * jc + 4) = a1;
        }
        __syncthreads();
    }
}
__device__ __forceinline__ void phase_scan3(CArgs& a, int l, LAS unsigned char* lds, int vcu, int G, int tid, int wave, int lane, int mode) {
    (void)mode; (void)l;
    const int hw = wave >> 2, w4 = wave & 3, jt = tid & 255, g4 = lane >> 4, j16 = lane & 15, tokl = jt >> 4, cg = jt & 15;
    unsigned char* ws = a.ws;
    LAS float* fYB = (LAS float*)(lds + hw * 16384);
    for (int p = vcu; p < 480; p += G) {
        const int jid = 2 * p + hw; const int chain = jid / 15, c = 1 + jid % 15;
        const int b = chain >> 3, d = (chain >> 2) & 1, h = chain & 3;
        const float* ss = c == 1 ? (const float*)(ws + WS_S1) + (size_t)chain * 4096 : (const float*)(ws + WS_SCAN) + ((size_t)(chain * 14 + c - 2) * 2 + 1) * 4096;
        f32x4 S[4];
#pragma unroll
        for (int blk = 0; blk < 4; ++blk) S[blk] = *(const f32x4*)(ss + (16 * w4 + j16) * 64 + 16 * blk + 4 * g4);
        const bf16x8 sb0 = cat8(pk4(S[0]), pk4(S[1])), sb1 = cat8(pk4(S[2]), pk4(S[3]));
        const unsigned char* yp = scan_yp(ws, jid);
        bf16* Y = (bf16*)(ws + WS_Y);
#pragma unroll 1
        for (int sg = 0; sg < SCAN_L / 64; ++sg) {
            bf16x8 ya[4][2];
#pragma unroll
            for (int u = 0; u < 4; ++u) { const unsigned char* yr = yp + (4 * sg + u) * 2048 + (j16 * 64 + 4 * g4) * 2;
                ya[u][0] = cat8(*(const u32x2*)yr, *(const u32x2*)(yr + 32)); ya[u][1] = cat8(*(const u32x2*)(yr + 64), *(const u32x2*)(yr + 96)); }
            f32x4 yl[4]; bf16* yptr[4];
#pragma unroll
            for (int u = 0; u < 4; ++u) { const int tau = c * SCAN_L + (4 * sg + u) * 16 + tokl; const int t = d ? TL - 1 - tau : tau; const size_t tok = (size_t)NTC + b * TL + t;
                yptr[u] = Y + tok * 512 + d * 256 + h * 64 + 4 * cg; yl[u] = ldbf4(yptr[u]); }
#pragma unroll
            for (int u = 0; u < 4; ++u) { f32x4 C = mfma16(ya[u][0], sb0, (f32x4){0.f, 0.f, 0.f, 0.f}); C = mfma16(ya[u][1], sb1, C);
#pragma unroll
                for (int q = 0; q < 4; ++q) fYB[u * 1024 + (4 * g4 + q) * 64 + 16 * w4 + j16] = C[q]; }
            __syncthreads();
#pragma unroll
            for (int u = 0; u < 4; ++u) { const f32x4 y4 = yl[u] + *(LAS const f32x4*)(fYB + u * 1024 + tokl * 64 + 4 * cg); st4bf(yptr[u], y4[0], y4[1], y4[2], y4[3]); }
            __syncthreads();
        }
    }
}
__device__ __forceinline__ void phase_finish(CArgs& a, int l, int vcu, int G, int wave, int lane, bool dry) {
    const int gw = vcu * 8 + wave, NGW = G * 8;
    bf16* PA = (bf16*)(a.ws + WS_PA);
    const bf16* Y = (const bf16*)(a.ws + WS_Y); const float* CC = (const float*)(a.ws + WS_CC);
    const f32x4 lnw = *(const f32x4*)(a.in[22] + l * 256 + 4 * lane), lnb = *(const f32x4*)(a.in[23] + l * 256 + 4 * lane);
    const float* cw = a.in[14] + (size_t)l * 3 * 768 + 512 + 4 * lane;
    const f32x4 c0 = *(const f32x4*)cw, c1 = *(const f32x4*)(cw + 768), c2 = *(const f32x4*)(cw + 1536);
    const int head = lane >> 4;
    for (int tok0 = gw; tok0 < NTOK; tok0 += 2 * NGW) {
        f32x4 vp[2], vc[2], vn[2], yf[2], yb[2], gg[2]; float cfa[2], cfb[2]; bf16* rowp[2]; bool ok[2];
#pragma unroll
        for (int u = 0; u < 2; ++u) {
            const int tok = tok0 + u * NGW; ok[u] = tok < NTOK; const int tk = ok[u] ? tok : tok0;
            int t, T; if (tk < NTC) { t = tk & 255; T = TC; } else { t = (tk - NTC) & 4095; T = TL; }
            bf16* row = PA + (size_t)tk * LDA; rowp[u] = row;
            const f32x4 z = (f32x4){0.f, 0.f, 0.f, 0.f};
            vp[u] = t > 0 ? ldbf4(row - LDA + CA_V + 4 * lane) : z; vc[u] = ldbf4(row + CA_V + 4 * lane); vn[u] = t + 1 < T ? ldbf4(row + LDA + CA_V + 4 * lane) : z;
            yf[u] = ldbf4(Y + (size_t)tk * 512 + 4 * lane); yb[u] = ldbf4(Y + (size_t)tk * 512 + 256 + 4 * lane);
            cfa[u] = CC[((size_t)tk * 2 + 0) * 4 + head]; cfb[u] = CC[((size_t)tk * 2 + 1) * 4 + head];
            gg[u] = ldbf4(row + CA_GR + 4 * lane);
        }
#pragma unroll
        for (int u = 0; u < 2; ++u) {
            const f32x4 v_c = vp[u] * c0 + vc[u] * c1 + vn[u] * c2;
            const f32x4 o = yf[u] + yb[u];
            const float mu = row16_sum((o[0] + o[1]) + (o[2] + o[3])) * (1.f / 64.f);
            const f32x4 dlt = o - mu;
            const float var = row16_sum(dot4(dlt, dlt)) * (1.f / 64.f);
            const float rs = __builtin_amdgcn_rsqf(var + GN_EPS);
            const f32x4 on = dlt * rs * lnw + lnb + v_c * (cfa[u] + cfb[u]);
            const f32x4 g = gg[u];
            if (dry) { asm volatile("" :: "v"(on), "v"(g)); continue; }
            if (ok[u]) st4bf(rowp[u] + CA_GR + 4 * lane, on[0] * silu_f(g[0]), on[1] * silu_f(g[1]), on[2] * silu_f(g[2]), on[3] * silu_f(g[3]));
        }
    }
}

constexpr int NWAVES = 8;
#ifndef OUT_STAGGER_TICKS
#define OUT_STAGGER_TICKS 0
#endif
constexpr int RING_BYTES = 131072, LDSCTL_OFF = RING_BYTES, LDS_BYTES = 147456;
constexpr int N_PHASES = 2 + 8 * 2 - 1;

__global__ void __launch_bounds__(NWAVES * 64, 2) mk_fwd(Args args_) {
    extern __shared__ __attribute__((aligned(16))) unsigned char lds_raw[];
    LAS unsigned char* lds = (LAS unsigned char*)lds_raw;
    const int tid0 = threadIdx.x;
    const int G = gridDim.x; const int bx0 = blockIdx.x;
    const int vcu0 = (G % 8 == 0) ? (bx0 % 8) * (G / 8) + bx0 / 8 : bx0;
#define PHASE_IDS CArgs* ap_ = (CArgs*)__builtin_amdgcn_kernarg_segment_ptr(); asm volatile("" : "+s"(ap_)); CArgs& args = *ap_; int tid = tid0; asm volatile("" : "+v"(tid)); int vcu = vcu0, bx = bx0; asm volatile("" : "+s"(vcu), "+s"(bx)); (void)bx; const int lane = tid & 63; const int wave = __builtin_amdgcn_readfirstlane(tid >> 6); (void)lane; (void)wave;
    volatile LAS unsigned* MISC = (volatile LAS unsigned*)(lds + LDSCTL_OFF);
    for (int u = tid0; u < (LDS_BYTES - LDSCTL_OFF) / 4; u += NWAVES * 64) ((LAS unsigned*)(lds + LDSCTL_OFF))[u] = 0u;
    __syncthreads();
    XcdBarrier bar; bar.bar = (unsigned*)(args_.ws + WS_CTL) + 4096; bar.x = 0; bar.st = nullptr;
    const bool multi = (args_.ph_hi - args_.ph_lo) > 1;
    if (multi) bar = xcd_barrier_post((unsigned*)(args_.ws + WS_CTL) + 4096, MISC + 8);
    const int lo = args_.ph_lo, hi = args_.ph_hi;
#ifndef PH_MASK
#define PH_MASK 0x3ff
#endif
#define PHB(k) ((k) < 2 ? (k) : 2 + (((k) - 2) & 7))
#define IN(k) (((PH_MASK >> PHB(k)) & 1) && lo <= (k) && (k) < hi)
#define SEAM(k) do { if (IN(k) && IN((k) + 1)) { XcdBarrier b2_ = bar; asm volatile("" : "+s"(b2_.bar)); xcd_barrier(b2_); if (PROBE_DUP == 16) { xcd_barrier(b2_); xcd_barrier(b2_); } } } while (0)

    const int ATT_MOVED_LO = 768, ATT_MOVED_HI = (G == 256) ? 768 + 384 + 256 : 768;
#define REPS(id) int reps_ = 1 + (PROBE_DUP == (id) ? 1 : 0); asm volatile("" : "+s"(reps_));
    if (IN(0)) { PHASE_IDS phase_p0a(args, lds, vcu, G, tid, wave, lane); } SEAM(0);
    if (IN(1)) { PHASE_IDS phase_l1_tables(args, vcu, G, tid, wave, lane); REPS(7) for (int rep = 0; rep < reps_; ++rep) phase_norm(args, 0, vcu, G, wave, lane); } SEAM(1);
#pragma unroll 1
    for (int L = 0; L < 2; ++L) {
        const int pb = 2 + 8 * L;
        if (IN(pb + 0)) { PHASE_IDS
            pg8::Gemm g{(const pg8::bf16_t*)(args.ws + WS_H), (const pg8::bf16_t*)(args.ws + WS_WIN) + (size_t)L * NPROJ * DM, NTOK, NPROJ, DM, DM};
            pg8::StaticOrder S; S.init(NTOK, NPROJ, G, bx);
            if (L == 0 || G != 256) {
                pg8::EpiProjT<false> E{ap_, nullptr, L};
                REPS(1) for (int rep = 0; rep < reps_; ++rep) pg8::gemm_phase<pg8::EpiProjT<false>, pg8::StaticOrder, true, true>(lds, g, S, E);
            } else {
                LAS float* T = (LAS float*)(lds + LDSCTL_OFF + 8192);
                pg8::Unit u0; (void)S.next(0, u0);
                const float* part = (const float*)(args.ws + WS_PART);
#pragma unroll 1
                for (int j = 0; j < 4; ++j) { const int pm = u0.pm + 8 * j;
                    if (tid == 0) ((LAS int*)T)[j] = pm < NTOK / 256 ? pm : -1;
                    if (pm < NTOK / 256 && tid < 256) { float s = 0.f;
#pragma unroll 8
                        for (int q = 0; q < 32; ++q) s += part[(size_t)q * NTOK + pm * 256 + tid];
                        T[64 + 256 * j + tid] = __builtin_amdgcn_rsqf(s * (1.f / 1024.f) + EPS); } }
                __syncthreads();
                pg8::EpiProjT<true> E{ap_, T, L};
                pg8::gemm_phase<pg8::EpiProjT<true>, pg8::StaticOrder, true, true>(lds, g, S, E);
            }
        } SEAM(pb + 0);
        if (IN(pb + 1)) { PHASE_IDS REPS(2) for (int rep = 0; rep < reps_; ++rep) phase_p2(args, L, lds, vcu, G, tid, wave, lane, rep + 1 < reps_); } SEAM(pb + 1);
        if (IN(pb + 2)) { PHASE_IDS
            { REPS(3) for (int rep = 0; rep < reps_; ++rep) phase_scan1(args, L, lds, vcu, G, tid, wave, lane, 0); }
            if (G == 256 && vcu >= 128) { for (int k = 0; k < 2; ++k) attn_dispatch(args, L, ATT_MOVED_LO + 384 + 2 * (vcu - 128) + k, lds, tid, 0); }
        } SEAM(pb + 2);
        if (IN(pb + 3)) { PHASE_IDS phase_scan2(args, L, lds, vcu, G, tid);
            if (G == 256 && vcu >= 64) { for (int k = 0; k < 2; ++k) attn_dispatch(args, L, ATT_MOVED_LO + 2 * (vcu - 64) + k, lds, tid, 0); } } SEAM(pb + 3);
        if (IN(pb + 4)) { PHASE_IDS
            { REPS(5) for (int rep = 0; rep < reps_; ++rep) phase_scan3(args, L, lds, vcu, G, tid, wave, lane, 0); }
            {
                unsigned* ctr = (unsigned*)(args.ws + WS_CTL) + 2048 + 64 * L; const int nrest = ATT_UNITS - ATT_MOVED_HI;
                for (int it = 0;; ++it) {
                    int u = vcu + it * G;
                    if (u >= 768) {
                        if (tid == 0) MISC[16] = __hip_atomic_fetch_add(ctr, 1u, __ATOMIC_RELAXED, __HIP_MEMORY_SCOPE_AGENT);
                        __syncthreads(); const int idx = (int)MISC[16]; __syncthreads();
                        if (idx >= nrest) break;
                        u = ATT_MOVED_HI + idx;
                    }
                    attn_dispatch(args, L, u, lds, tid, 0);
                } }
        } SEAM(pb + 4);
        if (IN(pb + 5)) { PHASE_IDS REPS(8) for (int rep = 0; rep < reps_; ++rep) phase_finish(args, L, vcu, G, wave, lane, rep + 1 < reps_); } SEAM(pb + 5);
        if (IN(pb + 6)) { PHASE_IDS (void)tid;
            pg8::Gemm g{(const pg8::bf16_t*)(args.ws + WS_PA), (const pg8::bf16_t*)(args.ws + WS_WOUT) + (size_t)L * DM * DM, NTOK, DM, DM, LDA};
            pg8::StaticOrder S; S.init(NTOK, DM, G, bx);
            if (G == 256) {
                pg8::HalfOrder S2{bx};
                if (L == 0) {
                    pg8::EpiOut0 E{args.in[0], args.in[1], args.out + OUT_Y, (const float*)(args.ws + WS_MOD), (const float*)(args.ws + WS_S1T), (pg8::bf16_t*)(args.ws + WS_H), (float*)(args.ws + WS_PART)};
                    pg8::gemm_phase<pg8::EpiOut0, pg8::HalfOrder, true, true>(lds, g, S2, E);
                } else {
                    pg8::EpiOut E{args.out + OUT_Y, args.out + OUT_Y + (size_t)NTC * DM, args.out + OUT_Y, (const float*)(args.ws + WS_MOD) + (size_t)9 * 3072};
                    pg8::gemm_phase<pg8::EpiOut, pg8::HalfOrder, true, true>(lds, g, S2, E);
                }
            } else {
                const float* x0 = L == 0 ? args.in[0] : args.out + OUT_Y; const float* x1 = L == 0 ? args.in[1] : args.out + OUT_Y + (size_t)NTC * DM;
                pg8::EpiOut E{x0, x1, args.out + OUT_Y, (const float*)(args.ws + WS_MOD) + (size_t)L * 9 * 3072};
                pg8::gemm_phase<pg8::EpiOut, pg8::StaticOrder, true, true>(lds, g, S, E);
            }
        } SEAM(pb + 6);
        if (L == 0 && G != 256) { if (IN(pb + 7)) { PHASE_IDS phase_norm(args, 1, vcu, G, wave, lane); } SEAM(pb + 7); }
    }
#undef IN
#undef SEAM
}

extern "C" void kernel_launch(void* const* d_in, const int* in_sizes, int n_in, void* d_out, int out_size, void* d_ws, size_t ws_size, hipStream_t stream) {
    static int grid = 0;
    if (grid == 0) {
        if (n_in != 34 || ws_size < WS_END) { fprintf(stderr, "kernel_launch: expected 34 inputs and >= %zu bytes of workspace (got %d, %zu)\n", (size_t)WS_END, n_in, ws_size); grid = -1; return; }
        int dev = 0, cus = 0;
        if (hipGetDevice(&dev) != hipSuccess || hipDeviceGetAttribute(&cus, hipDeviceAttributeMultiprocessorCount, dev) != hipSuccess) { grid = -1; return; }
        if (hipFuncSetAttribute((const void*)mk_fwd, hipFuncAttributeMaxDynamicSharedMemorySize, LDS_BYTES) != hipSuccess) { fprintf(stderr, "kernel_launch: hipFuncSetAttribute failed\n"); grid = -1; return; }
        int per_cu = 0;
        if (hipOccupancyMaxActiveBlocksPerMultiprocessor(&per_cu, (const void*)mk_fwd, NWAVES * 64, LDS_BYTES) != hipSuccess || per_cu < 1) fprintf(stderr, "kernel_launch: occupancy query reports %d\n", per_cu);
        (void)hipGetLastError();
        grid = cus;
    }
    if (grid < 0) return;
    (void)hipMemsetAsync((char*)d_ws + WS_CTL, 0, CTL_ZERO_BYTES, stream);
    Args a{};
    for (int i = 0; i < 34; ++i) a.in[i] = (const float*)d_in[i];
    a.out = (float*)d_out; a.ws = (unsigned char*)d_ws;
#if MK_ONE_LAUNCH
    a.ph_lo = 0; a.ph_hi = N_PHASES;
    hipLaunchKernelGGL(mk_fwd, dim3(grid), dim3(NWAVES * 64), LDS_BYTES, stream, a);
#else
    for (int p = 0; p < N_PHASES; ++p) { a.ph_lo = p; a.ph_hi = p + 1; hipLaunchKernelGGL(mk_fwd, dim3(grid), dim3(NWAVES * 64), LDS_BYTES, stream, a); }
#endif
}
```

```cpp
#include <hip/hip_runtime.h>
#include <cstdio>
#include <cstdint>

#ifndef PROBE_DUP
#define PROBE_DUP 0
#endif
#ifndef MK_ONE_LAUNCH
#define MK_ONE_LAUNCH 1
#endif

#define GAS __attribute__((address_space(1)))
#define LAS __attribute__((address_space(3)))
typedef unsigned short bf16;
typedef short bf16x8 __attribute__((ext_vector_type(8)));
typedef short s16x4 __attribute__((ext_vector_type(4)));
typedef float f32x2 __attribute__((ext_vector_type(2)));
typedef float f32x4 __attribute__((ext_vector_type(4)));
typedef float f32x16 __attribute__((ext_vector_type(16)));
typedef unsigned u32x2 __attribute__((ext_vector_type(2)));
typedef unsigned u32x4 __attribute__((ext_vector_type(4)));
typedef __bf16 bf16x2_t __attribute__((ext_vector_type(2)));

constexpr int DM = 1024;
constexpr int NTC = 8192, NTL = 32768, NTOK = 40960;
constexpr int TC = 256, TL = 4096;
constexpr int NPROJ = 3584;
constexpr int LDA = 3072, LDB = 512;
constexpr int CA_GR = 0, CA_GN = 256, CA_GM = 640, CA_R = 1024, CA_K = 1280, CA_V = 1536, CA_QN = 1792, CA_KN = 2176, CA_VN = 2560, CA_WD = 2944, CA_AD = 3008;
constexpr int CB_CQ = 0, CB_CKV = 256, CB_KR = 384;
constexpr float LOG2E = 1.4426950408889634f;
constexpr float EPS = 1e-6f, GN_EPS = 64e-5f;
constexpr float MLA_SCALE = 0.10206207261596575f;
constexpr int SCAN_L = 256;
constexpr int NCHUNK_L = TL / SCAN_L;

constexpr size_t MiB = 1u << 20;
constexpr size_t WS_CTL = 0, CTL_ZERO_BYTES = 1 * MiB;
constexpr size_t WS_MOD = 1 * MiB;
constexpr size_t WS_S1T = WS_MOD + 256 * 1024;
constexpr size_t WS_C1 = WS_MOD + 320 * 1024;
constexpr size_t WS_ABND = WS_MOD + 480 * 1024;
constexpr size_t WS_WIN = 2 * MiB;
constexpr size_t WS_WOUT = 16 * MiB;
constexpr size_t WS_WUQ = 20 * MiB;
constexpr size_t WS_WUKV = 21 * MiB;
constexpr size_t WS_LORA = 21 * MiB + 512 * 1024;
constexpr size_t WS_NACK = 22 * MiB, WS_NACV = 28 * MiB;
constexpr size_t WS_CK = 34 * MiB, WS_CV = 39 * MiB;
constexpr size_t WS_CC = 42 * MiB;
constexpr size_t WS_Q = 44 * MiB;
constexpr size_t WS_Y = 90 * MiB;
constexpr size_t WS_PART = WS_Y;
constexpr size_t WS_H = 130 * MiB;
constexpr size_t WS_MK = WS_H, WS_MV = WS_H + 45 * MiB;
constexpr size_t WS_PB = 210 * MiB;
constexpr size_t WS_SCAN = WS_PB;
constexpr size_t WS_PA = 250 * MiB;
constexpr size_t WS_S1 = WS_PB + 28 * MiB;
constexpr size_t WS_YPB = WS_PB + 29 * MiB;
constexpr size_t WS_YPA = 490 * MiB;
constexpr size_t WS_END = 512 * MiB;

constexpr size_t OUT_Y = 0, OUT_STATE = 41943040, OUT_NAK = 44040192, OUT_NAV = 50331648, OUT_CKV = 56623104, OUT_KROPE = 58720256;

struct Args { const float* in[34]; float* out; unsigned char* ws; int ph_lo, ph_hi; };
typedef const __attribute__((address_space(4))) Args CArgs;

__device__ __forceinline__ float bf2f(unsigned short b) { return __uint_as_float(((unsigned)b) << 16); }
__device__ __forceinline__ unsigned pk2(float lo, float hi) { f32x2 v = {lo, hi}; bf16x2_t b = __builtin_convertvector(v, bf16x2_t); return __builtin_bit_cast(unsigned, b); }
__device__ __forceinline__ float lo_f(unsigned u) { return __uint_as_float(u << 16); }
__device__ __forceinline__ float hi_f(unsigned u) { return __uint_as_float(u & 0xffff0000u); }
__device__ __forceinline__ int crow(int r, int hi) { return (r & 3) + 8 * (r >> 2) + 4 * hi; }
__device__ __forceinline__ float rcp_f(float x) { return __builtin_amdgcn_rcpf(x); }
__device__ __forceinline__ float silu_f(float x) { return x * rcp_f(1.f + __expf(-x)); }
__device__ __forceinline__ float sigmoid_f(float x) { return rcp_f(1.f + __expf(-x)); }
template <int CTRL> __device__ __forceinline__ float dpp_f(float x) { return __int_as_float(__builtin_amdgcn_update_dpp(0, __float_as_int(x), CTRL, 0xf, 0xf, true)); }
__device__ __forceinline__ float row16_sum(float x) { x += dpp_f<0xB1>(x); x += dpp_f<0x4E>(x); x += dpp_f<0x141>(x); x += dpp_f<0x140>(x); return x; }
__device__ __forceinline__ float xor32_sum(float x) { const auto r = __builtin_amdgcn_permlane32_swap(__float_as_uint(x), __float_as_uint(x), false, false); return __uint_as_float(r[0]) + __uint_as_float(r[1]); }
__device__ __forceinline__ float xor32_max(float x) { const auto r = __builtin_amdgcn_permlane32_swap(__float_as_uint(x), __float_as_uint(x), false, false); return fmaxf(__uint_as_float(r[0]), __uint_as_float(r[1])); }
__device__ __forceinline__ float wave64_sum(float x) { x = row16_sum(x); const auto r = __builtin_amdgcn_permlane16_swap(__float_as_uint(x), __float_as_uint(x), false, false); x = __uint_as_float(r[0]) + __uint_as_float(r[1]); return xor32_sum(x); }
__device__ __forceinline__ float ss8(bf16x8 v) { float s = 0.f;
#pragma unroll
    for (int j = 0; j < 8; ++j) { const float f = bf2f((unsigned short)v[j]); s += f * f; } return s; }
#define LDS_WAIT() asm volatile("s_waitcnt lgkmcnt(0)" ::: "memory")
#define VM_WAIT() asm volatile("s_waitcnt vmcnt(0)" ::: "memory")

__device__ __forceinline__ const float* x_row0(CArgs& a, int tok) { return tok < NTC ? a.in[0] + (size_t)tok * DM : a.in[1] + (size_t)(tok - NTC) * DM; }
__device__ __forceinline__ int mod_idx(int tok) { return tok < NTC ? 0 : 1 + ((tok - NTC) >> 12); }

namespace pg8 {
#define PG8_LAS __attribute__((address_space(3)))
typedef unsigned short bf16_t;
typedef short bf16x8 __attribute__((ext_vector_type(8)));
typedef float f32x4 __attribute__((ext_vector_type(4)));
typedef unsigned u32x4 __attribute__((ext_vector_type(4)));
constexpr int BM = 256, BK = 64, HALF = 128, HTB = HALF * BK * 2  , STAGE_BYTES = 8 * HTB, NXCD = 8, WGM = 8;

__host__ __device__ __forceinline__ int lds_byte(int r, int c) { const int st = (r >> 4) * 2 + (c >> 5), rr = r & 15, cc = c & 31, ob = rr * 64 + cc * 2; return st * 1024 + (ob ^ (((ob >> 9) & 1) << 5)); }
__host__ __device__ __forceinline__ void stage_rc(int b, int& R, int& C) { const int st = b / 1024, sb = b % 1024, swz = sb ^ (((sb >> 9) & 1) << 5); R = (st >> 1) * 16 + swz / 64; C = (st & 1) * 32 + (swz % 64) / 2; }
__host__ __device__ __forceinline__ int perm32(int rho) { const int n = rho >> 4, i = rho & 15; return 8 * (i >> 2) + 4 * n + (i & 3); }

struct Unit { int pm, pn, bh; };
struct Gemm { const bf16_t* A; const bf16_t* Bt; int M, N, K, lda; };

struct StaticOrder {
    int nM, nN, nwg, G, c;
    __host__ __device__ void init(int M, int N, int G_, int c_) { nM = M / BM; nN = N / BM; nwg = nM * nN; G = G_; c = c_; }
    __host__ __device__ __forceinline__ bool next(int i, Unit& u) const {
        u.bh = 0;
        const long L = (long)i * G + c; if (L >= nwg) return false;
        int wgid = (int)L; { const int q = nwg / NXCD, r = nwg % NXCD, xcd = wgid % NXCD, off = wgid / NXCD; wgid = (xcd < r ? xcd * (q + 1) : r * (q + 1) + (xcd - r) * q) + off; }
        const int nig = WGM * nN, gid = wgid / nig, fm = gid * WGM, gsz = (nM - fm) < WGM ? (nM - fm) : WGM;
        u.pm = fm + ((wgid % nig) % gsz); u.pn = (wgid % nig) / gsz; return true;
    }
    __device__ __forceinline__ void a_ready(const Unit&) const {}
    __device__ __forceinline__ void done(const Unit&) const {}
};

struct HalfOrder {
    int c;
    __host__ __device__ __forceinline__ bool next(int i, Unit& u) const {
        if (i > 2) return false;
        if (i == 2) { const int x = c % NXCD, j = c / NXCD; u.pm = 128 + 4 * x + (j & 3); u.pn = (j >> 2) & 3; u.bh = 1 + (j >> 4); return true; }
        const int L = i * 256 + c; const int wgid = (L % NXCD) * 64 + L / NXCD;
        u.pm = (wgid / 32) * WGM + (wgid % 32) % WGM; u.pn = (wgid % 32) / WGM; u.bh = 0; return true;
    }
    __device__ __forceinline__ void a_ready(const Unit&) const {}
    __device__ __forceinline__ void done(const Unit&) const {}
};
__device__ __forceinline__ unsigned cvt_pk_bf16(float lo, float hi) { unsigned r; asm volatile("v_cvt_pk_bf16_f32 %0, %1, %2" : "=v"(r) : "v"(lo), "v"(hi)); return r; }
struct EpiOut {
    static constexpr bool PERM = false, AFTER_DRAIN = false, PREFETCH = false;
    const float* x0; const float* x1; float* out; const float* mod;
#if PROBE_DUP == 26
    int live;
#endif
    __device__ __forceinline__ void operator()(const f32x4 (&acc)[2][2][4][2], const Unit& u, int wr, int wc, int fr, int fq) const {
#if PROBE_DUP == 26
        if (!live) return;
#endif
        const int rowt = u.pm * BM;
        const int mi = rowt < 8192 ? 0 : 1 + ((rowt - 8192) >> 12);
        const float* gate = mod + mi * 3072 + 2048;
        const int col0 = u.pn * BM + (u.bh == 2 ? HALF : 0) + wc * 32 + 4 * fq;
        const int nbj = u.bh ? 1 : 2;
        f32x4 gv[2][2];
#pragma unroll
        for (int bj = 0; bj < 2; ++bj)
#pragma unroll
            for (int n = 0; n < 2; ++n) gv[bj][n] = *(const f32x4*)(gate + col0 + bj * HALF + n * 16);
#pragma unroll
        for (int ai = 0; ai < 2; ++ai)
#pragma unroll
            for (int m = 0; m < 4; ++m) { const int row = rowt + ai * HALF + wr * 64 + m * 16 + fr;
                const float* xr = row < 8192 ? x0 + (size_t)row * 1024 : x1 + (size_t)(row - 8192) * 1024;
                float* orow = out + (size_t)row * 1024;
#pragma unroll
                for (int bj = 0; bj < 2; ++bj) { if (bj < nbj) {
#pragma unroll
                    for (int n = 0; n < 2; ++n) { const int c = col0 + bj * HALF + n * 16; const f32x4 xv = *(const f32x4*)(xr + c);
                        *(f32x4*)(orow + c) = xv + gv[bj][n] * acc[ai][bj][m][n]; } } } }
    }
};


__device__ __forceinline__ float fq_sum(float x) { const auto r = __builtin_amdgcn_permlane16_swap(__float_as_uint(x), __float_as_uint(x), false, false); x = __uint_as_float(r[0]) + __uint_as_float(r[1]);
    const auto q = __builtin_amdgcn_permlane32_swap(__float_as_uint(x), __float_as_uint(x), false, false); return __uint_as_float(q[0]) + __uint_as_float(q[1]); }
struct EpiOut0 {
    static constexpr bool PERM = true, AFTER_DRAIN = false;
    const float* x0; const float* x1; float* out; const float* mod;
    const float* s1; bf16_t* H; float* part;
    __device__ __forceinline__ void operator()(const f32x4 (&acc)[2][2][4][2], const Unit& u, int wr, int wc, int fr, int fq) const {
        const int rowt = u.pm * BM;
        const int mi = rowt < 8192 ? 0 : 1 + ((rowt - 8192) >> 12);
        const int colb = u.pn * BM + (u.bh == 2 ? HALF : 0) + wc * 32 + 8 * fq;
        const int nbj = u.bh ? 1 : 2;
        const float* gate = mod + mi * 3072 + 2048 + colb; const float* sv = s1 + mi * 1024 + colb;
        f32x4 gv[2][2];
#pragma unroll
        for (int bj = 0; bj < 2; ++bj) { if (bj < nbj) {
#pragma unroll
            for (int n = 0; n < 2; ++n) gv[bj][n] = *(const f32x4*)(gate + bj * HALF + 4 * n); } }
        const int slot = u.pn * 8 + (u.bh == 2 ? 4 : 0) + wc;
        float* pslot = part + (size_t)slot * 40960;
#pragma unroll
        for (int ai = 0; ai < 2; ++ai)
#pragma unroll
            for (int m = 0; m < 4; ++m) { const int row = rowt + ai * HALF + wr * 64 + m * 16 + fr;
                const float* xr = (row < 8192 ? x0 + (size_t)row * 1024 : x1 + (size_t)(row - 8192) * 1024) + colb;
                float* orow = out + (size_t)row * 1024 + colb; bf16_t* hrow = H + (size_t)row * 1024 + colb;
                float s = 0.f;
#pragma unroll
                for (int bj = 0; bj < 2; ++bj) { if (bj < nbj) {
                    const f32x4 y0 = *(const f32x4*)(xr + bj * HALF) + gv[bj][0] * acc[ai][bj][m][0], y1 = *(const f32x4*)(xr + bj * HALF + 4) + gv[bj][1] * acc[ai][bj][m][1];
                    *(f32x4*)(orow + bj * HALF) = y0; *(f32x4*)(orow + bj * HALF + 4) = y1;
                    s += ((y0[0] * y0[0] + y0[1] * y0[1]) + (y0[2] * y0[2] + y0[3] * y0[3])) + ((y1[0] * y1[0] + y1[1] * y1[1]) + (y1[2] * y1[2] + y1[3] * y1[3]));
                    const f32x4 a0 = y0 * *(const f32x4*)(sv + bj * HALF), a1 = y1 * *(const f32x4*)(sv + bj * HALF + 4);
                    u32x4 w; w.x = cvt_pk_bf16(a0[0], a0[1]); w.y = cvt_pk_bf16(a0[2], a0[3]); w.z = cvt_pk_bf16(a1[0], a1[1]); w.w = cvt_pk_bf16(a1[2], a1[3]);
                    *(u32x4*)(hrow + bj * HALF) = w; } }
                const float t = fq_sum(s);
                if (fq == 0) { pslot[row] = t; if (u.bh == 0) pslot[4 * 40960 + row] = 0.f; } }
    }
};
template <bool L1>
struct EpiProjT {
    static constexpr bool PERM = true, AFTER_DRAIN = false;
    CArgs* ap; PG8_LAS const float* T; int l;
    __device__ __forceinline__ void operator()(const f32x4 (&acc)[2][2][4][2], const Unit& u, int wr, int wc, int fr, int fq) const {
        CArgs* ap_ = ap; asm volatile("" : "+s"(ap_)); CArgs& a = *ap_;
        bf16_t* PA = (bf16_t*)(a.ws + WS_PA); bf16_t* PB = (bf16_t*)(a.ws + WS_PB); const float* c1 = (const float*)(a.ws + WS_C1);
        const float* qw = a.in[24] + l * 64; const float* kw = a.in[25] + l * 64; float* nak = a.out + OUT_NAK; float* nav = a.out + OUT_NAV;
        const int rowt = u.pm * BM; const int row0 = rowt + wr * 64 + fr;
        const int col0 = wc * 32 + 8 * fq;
        f32x4 cv[2][2]; const PG8_LAS float* rs = T;
        if constexpr (L1) {
            const int mi = rowt < 8192 ? 0 : 1 + ((rowt - 8192) >> 12);
            const PG8_LAS int* Tp = (const PG8_LAS int*)T;
            const int j = (u.pm == Tp[1]) ? 1 : ((u.pm == Tp[2]) ? 2 : ((u.pm == Tp[3]) ? 3 : 0));
            rs = T + 64 + 256 * j + wr * 64 + fr;
            const float* cp = c1 + mi * 3584 + u.pn * 256 + col0;
#pragma unroll
            for (int bj = 0; bj < 2; ++bj)
#pragma unroll
                for (int n = 0; n < 2; ++n) cv[bj][n] = *(const f32x4*)(cp + bj * HALF + 4 * n);
        }
        const bool ctx = rowt < 8192;
        if (u.pn >= 7 && u.pn <= 9) {
            const int hq = 4 * (u.pn - 7) + wc; const bool isq = hq < 6;
            const float* gwp = (isq ? qw : kw) + 8 * fq; const float sc0 = isq ? 0.125f * 1.4426950408889634f : 1.0f;
            f32x4 gv[2][2];
#pragma unroll
            for (int bj = 0; bj < 2; ++bj)
#pragma unroll
                for (int n = 0; n < 2; ++n) gv[bj][n] = *(const f32x4*)(gwp + 32 * bj + 4 * n) * sc0;
            const int ncol = 1792 + 64 * hq + 8 * fq;
#pragma unroll
            for (int ai = 0; ai < 2; ++ai)
#pragma unroll
                for (int m = 0; m < 4; ++m) { const int row = row0 + ai * HALF + m * 16;
                    f32x4 v[2][2]; float ss = 0.f;
#pragma unroll
                    for (int bj = 0; bj < 2; ++bj)
#pragma unroll
                        for (int n = 0; n < 2; ++n) { f32x4 x = acc[ai][bj][m][n]; if constexpr (L1) x = x * rs[ai * HALF + m * 16] + cv[bj][n];
                            v[bj][n] = x; ss += (x[0] * x[0] + x[1] * x[1]) + (x[2] * x[2] + x[3] * x[3]); }
                    ss = fq_sum(ss);
                    const float r = __builtin_amdgcn_rsqf(ss * (1.f / 64.f) + 1e-6f);
                    bf16_t* rowp = PA + (size_t)row * 3072 + ncol;
                    float* kc = nak + ((size_t)((row >> 8) * 2 + l) * 256 + (row & 255)) * 384 + (hq - 6) * 64 + 8 * fq;
#pragma unroll
                    for (int bj = 0; bj < 2; ++bj) { const f32x4 o0 = v[bj][0] * r * gv[bj][0], o1 = v[bj][1] * r * gv[bj][1];
                        u32x4 w; w.x = cvt_pk_bf16(o0[0], o0[1]); w.y = cvt_pk_bf16(o0[2], o0[3]); w.z = cvt_pk_bf16(o1[0], o1[1]); w.w = cvt_pk_bf16(o1[2], o1[3]);
                        *(u32x4*)(rowp + 32 * bj) = w;
                        if (ctx && !isq) { *(f32x4*)(kc + 32 * bj) = o0; *(f32x4*)(kc + 32 * bj + 4) = o1; } } }
            return;
        }
        bf16_t* base; int ldc;
        if (u.pn < 12) { base = PA + u.pn * 256; ldc = 3072; } else { base = PB + (u.pn - 12) * 256; ldc = 512; }
        const bool vtile = ctx && (u.pn == 10 || u.pn == 11);
        const bool wdt = u.pn == 11 && wc < 2;
#pragma unroll
        for (int ai = 0; ai < 2; ++ai)
#pragma unroll
            for (int m = 0; m < 4; ++m) { const int row = row0 + ai * HALF + m * 16; bf16_t* rowp = base + (size_t)row * ldc + col0;
                float* vc = nav + ((size_t)((row >> 8) * 2 + l) * 256 + (row & 255)) * 384 + (u.pn - 10) * 256 + col0;
#pragma unroll
                for (int bj = 0; bj < 2; ++bj) { f32x4 v0 = acc[ai][bj][m][0], v1 = acc[ai][bj][m][1];
                    if constexpr (L1) { const float r = rs[ai * HALF + m * 16]; v0 = v0 * r + cv[bj][0]; v1 = v1 * r + cv[bj][1]; }
                    if (wdt && bj == 1) {
#pragma unroll
                        for (int i = 0; i < 4; ++i) { v0[i] = 1.f - 2.f * __builtin_amdgcn_rcpf(1.f + __expf(2.f * v0[i])); v1[i] = 1.f - 2.f * __builtin_amdgcn_rcpf(1.f + __expf(2.f * v1[i])); } }
                    u32x4 w; w.x = cvt_pk_bf16(v0[0], v0[1]); w.y = cvt_pk_bf16(v0[2], v0[3]); w.z = cvt_pk_bf16(v1[0], v1[1]); w.w = cvt_pk_bf16(v1[2], v1[3]);
                    *(u32x4*)(rowp + bj * HALF) = w;
                    if (vtile && (u.pn == 10 || bj == 0)) { *(f32x4*)(vc + bj * HALF) = v0; *(f32x4*)(vc + bj * HALF + 4) = v1; } } }
    }
};
template <class Epi, class Sched, bool ALIGN_EPI = false, bool SP2 = false>
__device__ __forceinline__ void gemm_phase(PG8_LAS unsigned char* lds, const Gemm g, const Sched& S, const Epi& E) {
    int tid_ = threadIdx.x; asm volatile("" : "+v"(tid_));
    const int tid = tid_, wid = __builtin_amdgcn_readfirstlane(tid >> 6), lane = tid & 63, wr = wid >> 2, wc = wid & 3, fr = lane & 15, fq = lane >> 4;
    const int K = g.K, nt = K / BK;
    unsigned voffA[2], voffB[2];
#pragma unroll
    for (int i = 0; i < 2; ++i) { int R, C; stage_rc(tid * 16 + i * 8192, R, C); const int Rb = Epi::PERM ? ((R & ~31) + perm32(R & 31)) : R;
        voffA[i] = (unsigned)(R * g.lda + C) * 2u; voffB[i] = (unsigned)(Rb * K + C) * 2u; }
    const size_t kstep = (size_t)(BK * 2);
    const size_t hstepA = (size_t)HALF * g.lda * 2, hstepB = (size_t)HALF * K * 2;
    const size_t tstepA = 2 * hstepA, tstepB = 2 * hstepB;
    const unsigned ldsw = (unsigned)wid * 1024u;
    const int aoff = lds_byte(wr * 64 + fr, fq * 8), boff = lds_byte(wc * 32 + fr, fq * 8);
#define PG8_SA(b, h) (((b) * 2 + (h)) * HTB)
#define PG8_SB(b, h) ((4 + (b) * 2 + (h)) * HTB)
#define PG8_STAGE(bufoff, gbase, voff) do { _Pragma("unroll") for (int _i = 0; _i < 2; ++_i) \
        __builtin_amdgcn_global_load_lds((const unsigned*)((const char*)(gbase) + (voff)[_i]), (PG8_LAS unsigned*)(lds + (bufoff) + ldsw + _i * 8192), 16, 0, 0); } while (0)
#define PG8_LDA(dst, b, h) do { _Pragma("unroll") for (int m = 0; m < 4; ++m) _Pragma("unroll") for (int k = 0; k < 2; ++k) dst[m][k] = *(const PG8_LAS bf16x8*)(lds + PG8_SA(b, h) + aoff + m * 2048 + k * 1024); } while (0)
#define PG8_LDB(dst, b, h) do { _Pragma("unroll") for (int n = 0; n < 2; ++n) _Pragma("unroll") for (int k = 0; k < 2; ++k) dst[n][k] = *(const PG8_LAS bf16x8*)(lds + PG8_SB(b, h) + boff + n * 2048 + k * 1024); } while (0)
#define PG8_MMA(ai, bj, At, Bt) do { __builtin_amdgcn_s_setprio(1); _Pragma("unroll") for (int m = 0; m < 4; ++m) _Pragma("unroll") for (int n = 0; n < 2; ++n) _Pragma("unroll") for (int k = 0; k < 2; ++k) \
        acc[ai][bj][m][n] = __builtin_amdgcn_mfma_f32_16x16x32_bf16(Bt[n][k], At[m][k], acc[ai][bj][m][n], 0, 0, 0); __builtin_amdgcn_s_setprio(0); } while (0)
#define PG8_WAIT_V(n) asm volatile("s_waitcnt vmcnt(" #n ")" ::: "memory")
#define PG8_WAIT_L(n) asm volatile("s_waitcnt lgkmcnt(" #n ")" ::: "memory")
#define PG8_BAR __builtin_amdgcn_s_barrier()
#define PG8_SCHED __builtin_amdgcn_sched_barrier(0)
    Unit cur, nxt; int ui = 0;
    if (!S.next(0, cur)) return;
    f32x4 acc[2][2][4][2];
#pragma unroll
    for (int a = 0; a < 2; ++a)
#pragma unroll
        for (int b = 0; b < 2; ++b)
#pragma unroll
            for (int m = 0; m < 4; ++m)
#pragma unroll
                for (int n = 0; n < 2; ++n) acc[a][b][m][n] = (f32x4){0.f, 0.f, 0.f, 0.f};
    bf16x8 At[4][2], B0[2][2], B1[2][2];
    const char* cA = (const char*)g.A + (size_t)cur.pm * tstepA; const char* cB = (const char*)g.Bt + (size_t)cur.pn * tstepB + (cur.bh == 2 ? hstepB : (size_t)0);
    S.a_ready(cur);
    if constexpr (SP2) {
        PG8_STAGE(PG8_SB(0, 0), cB, voffB); PG8_STAGE(PG8_SB(0, 1), cB + hstepB, voffB); PG8_STAGE(PG8_SA(0, 0), cA, voffA); PG8_STAGE(PG8_SA(0, 1), cA + hstepA, voffA);
        if (wr == 1) PG8_BAR;
        PG8_WAIT_V(2); PG8_BAR;
        PG8_STAGE(PG8_SB(1, 0), cB + kstep, voffB); PG8_STAGE(PG8_SA(1, 0), cA + kstep, voffA); PG8_STAGE(PG8_SB(1, 1), cB + hstepB + kstep, voffB);
        PG8_WAIT_V(6); PG8_BAR;
    } else {
        PG8_STAGE(PG8_SB(0, 0), cB, voffB); PG8_STAGE(PG8_SA(0, 0), cA, voffA); PG8_STAGE(PG8_SB(0, 1), cB + hstepB, voffB); PG8_STAGE(PG8_SA(0, 1), cA + hstepA, voffA);
        if (wr == 1) PG8_BAR;
        PG8_WAIT_V(4); PG8_BAR;
        PG8_STAGE(PG8_SB(1, 0), cB + kstep, voffB); PG8_STAGE(PG8_SA(1, 0), cA + kstep, voffA); PG8_STAGE(PG8_SB(1, 1), cB + hstepB + kstep, voffB);
        PG8_WAIT_V(6); PG8_BAR;
    }
    for (;;) {
        const bool has_next = S.next(ui + 1, nxt);
        const char* nA = has_next ? (const char*)g.A + (size_t)nxt.pm * tstepA : cA; const char* nB = has_next ? (const char*)g.Bt + (size_t)nxt.pn * tstepB + (nxt.bh == 2 ? hstepB : (size_t)0) : cB;
        const bool full = cur.bh == 0;
        for (int t = 0; t < nt; t += 2) {
            const bool last = (t == nt - 2);
            const char* a1 = cA + (size_t)(t + 1) * kstep;
            const char* a2 = last ? nA : cA + (size_t)(t + 2) * kstep; const char* b2 = last ? nB : cB + (size_t)(t + 2) * kstep;
            const char* a3 = a2 + kstep; const char* b3 = b2 + kstep;
            if (last && has_next) S.a_ready(nxt);
            if constexpr (SP2) {
            PG8_LDB(B0, 0, 0); PG8_LDB(B1, 0, 1); PG8_SCHED; PG8_LDA(At, 0, 0); PG8_STAGE(PG8_SA(1, 1), a1 + hstepA, voffA);
            PG8_WAIT_V(8); PG8_WAIT_L(0); PG8_BAR; PG8_MMA(0, 0, At, B0); if (full) PG8_MMA(0, 1, At, B1); PG8_BAR; PG8_SCHED;
            PG8_LDA(At, 0, 1); PG8_STAGE(PG8_SB(0, 0), b2, voffB); PG8_STAGE(PG8_SB(0, 1), b2 + hstepB, voffB); PG8_STAGE(PG8_SA(0, 0), a2, voffA);
            PG8_WAIT_V(8); PG8_WAIT_L(0); PG8_BAR; PG8_MMA(1, 0, At, B0); if (full) PG8_MMA(1, 1, At, B1); PG8_BAR; PG8_SCHED;
            PG8_LDB(B0, 1, 0); PG8_LDB(B1, 1, 1); PG8_SCHED; PG8_LDA(At, 1, 0); PG8_STAGE(PG8_SA(0, 1), a2 + hstepA, voffA);
            PG8_WAIT_V(8); PG8_WAIT_L(0); PG8_BAR; PG8_MMA(0, 0, At, B0); if (full) PG8_MMA(0, 1, At, B1); PG8_BAR; PG8_SCHED;
            PG8_LDA(At, 1, 1); PG8_STAGE(PG8_SB(1, 0), b3, voffB); PG8_STAGE(PG8_SB(1, 1), b3 + hstepB, voffB); PG8_STAGE(PG8_SA(1, 0), a3, voffA);
            PG8_WAIT_V(8); PG8_WAIT_L(0); PG8_BAR; PG8_MMA(1, 0, At, B0); if (full) PG8_MMA(1, 1, At, B1); PG8_BAR; PG8_SCHED;
            } else {
            PG8_LDB(B0, 0, 0); PG8_SCHED; PG8_LDA(At, 0, 0); PG8_STAGE(PG8_SA(1, 1), a1 + hstepA, voffA);
            PG8_WAIT_L(8); PG8_BAR; PG8_WAIT_L(0); PG8_MMA(0, 0, At, B0); PG8_BAR; PG8_SCHED;
            PG8_LDB(B1, 0, 1); PG8_STAGE(PG8_SB(0, 0), b2, voffB);
            PG8_BAR; PG8_WAIT_L(0); PG8_MMA(0, 1, At, B1); PG8_BAR;
            PG8_LDA(At, 0, 1); PG8_STAGE(PG8_SA(0, 0), a2, voffA);
            PG8_BAR; PG8_WAIT_L(0); PG8_MMA(1, 0, At, B0); PG8_BAR; PG8_SCHED;
            PG8_STAGE(PG8_SB(0, 1), b2 + hstepB, voffB);
            PG8_WAIT_V(6); PG8_BAR; PG8_MMA(1, 1, At, B1); PG8_BAR;
            PG8_LDB(B0, 1, 0); PG8_SCHED; PG8_LDA(At, 1, 0); PG8_STAGE(PG8_SA(0, 1), a2 + hstepA, voffA);
            PG8_WAIT_L(8); PG8_BAR; PG8_WAIT_L(0); PG8_MMA(0, 0, At, B0); PG8_BAR; PG8_SCHED;
            PG8_LDB(B1, 1, 1); PG8_STAGE(PG8_SB(1, 0), b3, voffB);
            PG8_BAR; PG8_WAIT_L(0); PG8_MMA(0, 1, At, B1); PG8_BAR;
            PG8_LDA(At, 1, 1); PG8_STAGE(PG8_SA(1, 0), a3, voffA);
            PG8_BAR; PG8_WAIT_L(0); PG8_MMA(1, 0, At, B0); PG8_BAR; PG8_SCHED;
            PG8_STAGE(PG8_SB(1, 1), b3 + hstepB, voffB);
            PG8_WAIT_V(6); PG8_BAR; PG8_MMA(1, 1, At, B1); PG8_BAR;
            }
        }
        if constexpr (ALIGN_EPI) { if (wr == 0) PG8_BAR; }
        if constexpr (!Epi::AFTER_DRAIN) { E(acc, cur, wr, wc, fr, fq); S.done(cur); }
        if (!has_next) break;
#pragma unroll
        for (int a = 0; a < 2; ++a)
#pragma unroll
            for (int b = 0; b < 2; ++b)
#pragma unroll
                for (int m = 0; m < 4; ++m)
#pragma unroll
                    for (int n = 0; n < 2; ++n) acc[a][b][m][n] = (f32x4){0.f, 0.f, 0.f, 0.f};
        cur = nxt; cA = nA; cB = nB; ++ui;
        if constexpr (ALIGN_EPI) { if (wr == 1) PG8_BAR; }
    }
    PG8_WAIT_V(0);
    if constexpr (!ALIGN_EPI) { if (wr == 0) PG8_BAR; }
    PG8_BAR;
    if constexpr (Epi::AFTER_DRAIN) { E.fused(acc, cur, wr, wc, fr, fq, lds, wid, lane); S.done(cur); }
#undef PG8_SA
#undef PG8_SB
#undef PG8_STAGE
#undef PG8_LDA
#undef PG8_LDB
#undef PG8_MMA
#undef PG8_WAIT_V
#undef PG8_WAIT_L
#undef PG8_BAR
#undef PG8_SCHED
}
}
#define XB_TMO      128
#define XB_XCNT(j)  (256  + 64 * (j))
#define XB_XSUB(j)  (1280 + 64 * (j))
#define XB_XGEN(j)  (2304 + 64 * (j))
#define XB_TOP      3328
#define XB_TOPGEN   3392
#define XCD_BAR_WORDS 3456
#define XB_SPIN_CAP (1u << 18)

__device__ __forceinline__ unsigned xb_ld(unsigned* p)              { return __hip_atomic_load(p, __ATOMIC_RELAXED, __HIP_MEMORY_SCOPE_AGENT); }
__device__ __forceinline__ unsigned xb_add(unsigned* p, unsigned v) { return __hip_atomic_fetch_add(p, v, __ATOMIC_RELAXED, __HIP_MEMORY_SCOPE_AGENT); }
__device__ __forceinline__ unsigned xb_xcc_id() { return (unsigned)__builtin_amdgcn_s_getreg((3 << 11) | 20) & 0xFu; }
#define XB_SPIN(cond, bar) do { unsigned _sp = 0; while (cond) { __builtin_amdgcn_s_sleep(1); \
    if ((++_sp & 255u) == 0u) { if (xb_ld(&(bar)[XB_TMO])) break; if (_sp > XB_SPIN_CAP) { atomicAdd(&(bar)[XB_TMO], 1u); break; } } } } while (0)

struct XcdBarrier {
    unsigned* bar; unsigned x;
    volatile LAS unsigned* st;
};

__device__ __forceinline__ XcdBarrier xcd_barrier_post(unsigned* bar, volatile LAS unsigned* st) {
    XcdBarrier b; b.bar = bar; b.x = xb_xcc_id(); b.st = st;
    if (threadIdx.x == 0) (void)xb_add(&bar[XB_XCNT(b.x)], 1u);
    return b;
}
__device__ __forceinline__ void xcd_barrier_complete(unsigned* bar, unsigned x, unsigned& nloc, unsigned& nx) {
    const unsigned G = gridDim.x * gridDim.y * gridDim.z;
    unsigned sum, cnt, mine, sp = 0u;
    for (;;) {
        sum = 0u; cnt = 0u; mine = 0u;
#pragma unroll
        for (unsigned j = 0; j < 16; ++j) { const unsigned c = xb_ld(&bar[XB_XCNT(j)]); sum += c; cnt += (c > 0u) ? 1u : 0u; mine = (j == x) ? c : mine; }
        if (sum == G) break;
        __builtin_amdgcn_s_sleep(1);
        if ((++sp & 255u) == 0u) { if (xb_ld(&bar[XB_TMO])) break; if (sp > XB_SPIN_CAP) { atomicAdd(&bar[XB_TMO], 1u); break; } }
    }
    nloc = mine > 0u ? mine : 1u; nx = cnt > 0u ? cnt : 1u;
}

__device__ __forceinline__ void xcd_barrier(const XcdBarrier& b) {
    asm volatile("s_waitcnt vmcnt(0)" ::: "memory");
    __syncthreads();
    if (threadIdx.x == 0) {
        unsigned* bar = b.bar;
        __builtin_amdgcn_s_waitcnt(0);
        unsigned nloc = b.st[0], nx = b.st[1];
        if (nloc == 0u) { xcd_barrier_complete(bar, b.x, nloc, nx); b.st[0] = nloc; b.st[1] = nx; }
        const unsigned old = xb_add(&bar[XB_XSUB(b.x)], 1u);
        const unsigned gen = old / nloc;
        if (old + 1u == (gen + 1u) * nloc) {
            __builtin_amdgcn_fence(__ATOMIC_RELEASE, "agent");
            asm volatile("s_waitcnt vmcnt(0)" ::: "memory");
            const unsigned og = xb_add(&bar[XB_TOP], 1u);
            const unsigned tg = og / nx;
            if (og + 1u == (tg + 1u) * nx) xb_add(&bar[XB_TOPGEN], 1u);
            else XB_SPIN(xb_ld(&bar[XB_TOPGEN]) == tg, bar);
            __builtin_amdgcn_fence(__ATOMIC_ACQUIRE, "agent");
            xb_add(&bar[XB_XGEN(b.x)], 1u);
            asm volatile("s_waitcnt vmcnt(0)" ::: "memory");
        } else {
            XB_SPIN(xb_ld(&bar[XB_XGEN(b.x)]) == gen, bar);
            __builtin_amdgcn_fence(__ATOMIC_ACQUIRE, "agent");
            asm volatile("s_waitcnt vmcnt(0)" ::: "memory");
        }
    }
    __syncthreads();
}


__device__ __forceinline__ int win_src_col(int n) {
    if (n < 256) return 896 + n;
    if (n < 640) return 2304 + (n - 256);
    if (n < 1024) return 3104 + (n - 640);
    if (n < 1280) return n - 1024;
    if (n < 1536) return 256 + (n - 1280);
    if (n < 1792) return 512 + (n - 1536);
    if (n < 2176) return 1152 + (n - 1792);
    if (n < 2560) return 1536 + (n - 2176);
    if (n < 2944) return 1920 + (n - 2560);
    if (n < 3008) return 768 + (n - 2944);
    if (n < 3072) return 832 + (n - 3008);
    if (n < 3328) return 2688 + (n - 3072);
    if (n < 3456) return 2944 + (n - 3328);
    if (n < 3488) return 3072 + (n - 3456);
    return -1;
}
__device__ __forceinline__ int win_blk(int nb) { const int tile = nb >> 3, d = nb & 7; return (tile >= 7 && tile <= 9) ? tile * 8 + 2 * (d & 3) + (d >> 2) : nb; }
__device__ __forceinline__ void p0_tr_item(const float* W, int ldw, int src_n0, int K, bf16* WT, int dst_row0, int k0, const float* kscale, LAS float* scr, int lane) {
#pragma unroll 8
    for (int i = 0; i < 32; ++i) { const int kk = 2 * i + (lane >> 5);
        float v = src_n0 >= 0 ? W[(size_t)(k0 + kk) * ldw + src_n0 + (lane & 31)] : 0.f;
        if (kscale) v *= kscale[k0 + kk];
        scr[kk * 33 + (lane & 31)] = v; }
    LDS_WAIT(); asm volatile("" ::: "memory");
    const int c = lane & 7;
#pragma unroll
    for (int j = 0; j < 4; ++j) { const int n = (lane >> 3) + 8 * j; const LAS float* s = scr + (8 * c) * 33 + n;
        u32x4 o; o.x = pk2(s[0 * 33], s[1 * 33]); o.y = pk2(s[2 * 33], s[3 * 33]); o.z = pk2(s[4 * 33], s[5 * 33]); o.w = pk2(s[6 * 33], s[7 * 33]);
        *(u32x4*)(WT + (size_t)(dst_row0 + n) * K + k0 + 8 * c) = o; }
    LDS_WAIT(); asm volatile("" ::: "memory");
}

__device__ __forceinline__ void phase_p0a(CArgs& a, LAS unsigned char* lds, int vcu, int G, int tid, int wave, int lane) {
    unsigned char* ws = a.ws;
    if (vcu < 96) {
        const int l = vcu / 48, n0 = (vcu % 48) * 64;
        LAS float* tab = (LAS float*)lds;
        LAS float* red = tab + 9216;
        for (int i = tid; i < 9216; i += 512) { const int j = i >> 10, k = i & 1023; const float c = j == 0 ? a.in[8][k] : a.in[7][(j - 1) * 1024 + k]; tab[i] = silu_f(c); }
        __syncthreads();
        float acc[9];
#pragma unroll
        for (int j = 0; j < 9; ++j) acc[j] = 0.f;
        const float* wm = a.in[9] + (size_t)l * 1024 * 3072 + n0 + lane;
        for (int kk = 0; kk < 128; ++kk) { const int k = wave * 128 + kk; const float wv = wm[(size_t)k * 3072];
#pragma unroll
            for (int j = 0; j < 9; ++j) acc[j] += tab[j * 1024 + k] * wv; }
#pragma unroll
        for (int j = 0; j < 9; ++j) red[(wave * 9 + j) * 64 + lane] = acc[j];
        __syncthreads();
        float* mod = (float*)(ws + WS_MOD);
        for (int i = tid; i < 576; i += 512) { const int j = i >> 6, ln = i & 63; float s = 0.f;
#pragma unroll
            for (int w = 0; w < 8; ++w) s += red[(w * 9 + j) * 64 + ln];
            mod[(size_t)(l * 9 + j) * 3072 + n0 + ln] = s + a.in[10][l * 3072 + n0 + ln]; }
        __syncthreads();
    }
    LAS float* scr = (LAS float*)(lds + 57344 + wave * 8704);
    const int gw = vcu * 8 + wave, NGW = G * 8;
    bf16* WIN = (bf16*)(ws + WS_WIN); bf16* WOUT = (bf16*)(ws + WS_WOUT); bf16* WUQ = (bf16*)(ws + WS_WUQ); bf16* WUKV = (bf16*)(ws + WS_WUKV); bf16* LORA = (bf16*)(ws + WS_LORA);
    for (int it = gw; it < 4912; it += NGW) {
        int r = it;
        if (r < 3584) { const int l = r / 1792, q = r % 1792, kb = q / 112, nb = q % 112;
            p0_tr_item(a.in[12] + (size_t)l * 1024 * 3488, 3488, win_src_col(32 * win_blk(nb)), 1024, WIN + (size_t)l * 3584 * 1024, 32 * nb, 64 * kb, nullptr, scr, lane); continue; } r -= 3584;
        if (r < 1024) { const int l = r / 512, q = r % 512, kb = q / 32, nb = q % 32;
            p0_tr_item(a.in[13] + (size_t)l * 1024 * 1024, 1024, 32 * nb, 1024, WOUT + (size_t)l * 1024 * 1024, 32 * nb, 64 * kb, nullptr, scr, lane); continue; } r -= 1024;
        if (r < 144) { const int l = r / 72, q = r % 72, kb = q / 18, nb = q % 18;
            p0_tr_item(a.in[29] + (size_t)l * 256 * 576, 576, 32 * nb, 256, WUQ + (size_t)l * 576 * 256, 32 * nb, 64 * kb, a.in[27] + l * 256, scr, lane); continue; } r -= 144;
        if (r < 48) { const int l = r / 24, q = r % 24, kb = q / 12, nb = q % 12;
            p0_tr_item(a.in[30] + (size_t)l * 128 * 384, 384, 32 * nb, 128, WUKV + (size_t)l * 768 * 128, 32 * nb, 64 * kb, nullptr, scr, lane); continue; } r -= 48;
        if (r < 48) { const int l = r / 24, q = r % 24, kb = q / 12, nb = q % 12;
            p0_tr_item(a.in[31] + (size_t)l * 128 * 384, 384, 32 * nb, 128, WUKV + (size_t)l * 768 * 128, 384 + 32 * nb, 64 * kb, nullptr, scr, lane); continue; } r -= 48;
        { const int which = r / 32, q = r % 32, ld = q / 8, nb = q % 8;
          const int l = ld >> 1, d = ld & 1;
          p0_tr_item(a.in[which ? 18 : 16] + (size_t)ld * 64 * 256, 256, 32 * nb, 64, LORA + (size_t)(((l * 2 + which) * 2 + d) * 256) * 64, 32 * nb, 0, nullptr, scr, lane); }
    }
    {
        const size_t gt = (size_t)vcu * 512 + tid, NT = (size_t)G * 512;
        for (int w = 0; w < 2; ++w) { const float* src = a.in[3 + w]; bf16* dst = (bf16*)(ws + (w ? WS_NACV : WS_NACK));
            for (size_t c = gt; c < 393216; c += NT) { const f32x4 v0 = *(const f32x4*)(src + c * 8), v1 = *(const f32x4*)(src + c * 8 + 4);
                u32x4 o; o.x = pk2(v0[0], v0[1]); o.y = pk2(v0[2], v0[3]); o.z = pk2(v1[0], v1[1]); o.w = pk2(v1[2], v1[3]); *(u32x4*)(dst + c * 8) = o; } }
    }
}

__device__ __forceinline__ void phase_norm(CArgs& a, int l, int vcu, int G, int wave, int lane) {
    const int gw = vcu * 8 + wave, NGW = G * 8;
    const float* mod = (const float*)(a.ws + WS_MOD) + (size_t)l * 9 * 3072;
    const float* nw = a.in[11] + l * 1024;
    bf16* H = (bf16*)(a.ws + WS_H);
    for (int tok = gw; tok < NTOK; tok += NGW) {
        const float* xr = (l == 0) ? x_row0(a, tok) : a.out + OUT_Y + (size_t)tok * DM;
        const float* md = mod + mod_idx(tok) * 3072;
        f32x4 v[4]; float s = 0.f;
#pragma unroll
        for (int j = 0; j < 4; ++j) { v[j] = *(const f32x4*)(xr + 4 * lane + 256 * j); s += (v[j][0] * v[j][0] + v[j][1] * v[j][1]) + (v[j][2] * v[j][2] + v[j][3] * v[j][3]); }
        s = wave64_sum(s);
        const float rstd = __builtin_amdgcn_rsqf(s * (1.f / 1024.f) + EPS);
#pragma unroll
        for (int j = 0; j < 4; ++j) { const int c = 4 * lane + 256 * j;
            const f32x4 g = *(const f32x4*)(nw + c), sh = *(const f32x4*)(md + c), sc = *(const f32x4*)(md + 1024 + c);
            f32x4 o = ((v[j] * rstd) * g) * (sc + 1.0f) + sh;
            u32x2 w; w.x = pk2(o[0], o[1]); w.y = pk2(o[2], o[3]);
            *(u32x2*)(H + (size_t)tok * DM + c) = w; }
    }
}

__device__ __forceinline__ void phase_l1_tables(CArgs& a, int vcu, int G, int tid, int wave, int lane) {
    const float* mod1 = (const float*)(a.ws + WS_MOD) + (size_t)9 * 3072;
    const float* nw1 = a.in[11] + 1024;
    float* S1 = (float*)(a.ws + WS_S1T); float* C1 = (float*)(a.ws + WS_C1);
    if (vcu == 0 && wave == 0) {
        for (int l = 0; l < 2; ++l) { float mq = 0.f, mk = 0.f;
            for (int i = lane; i < 96; i += 64) { mq = fmaxf(mq, fabsf(a.in[32][l * 96 + i])); mk = fmaxf(mk, fabsf(a.in[33][l * 96 + i])); }
            mq = xor32_max(mq); mk = xor32_max(mk);
#pragma unroll
            for (int o = 16; o > 0; o >>= 1) { mq = fmaxf(mq, __shfl_xor(mq, o)); mk = fmaxf(mk, __shfl_xor(mk, o)); }
            if (lane == 0) ((float*)(a.ws + WS_ABND))[l] = 96.f * mq * mk * (MLA_SCALE * LOG2E); }
    }
    for (int i = vcu * 512 + tid; i < 9216; i += G * 512) { const int b = i >> 10, k = i & 1023; S1[i] = nw1[k] * (1.0f + mod1[b * 3072 + 1024 + k]); }
    const bf16* W1 = (const bf16*)(a.ws + WS_WIN) + (size_t)NPROJ * DM;
    for (int n = vcu * 8 + wave; n < NPROJ; n += G * 8) {
        const bf16x8 w0 = *(const bf16x8*)(W1 + (size_t)n * DM + 16 * lane), w1 = *(const bf16x8*)(W1 + (size_t)n * DM + 16 * lane + 8);
        float wf[16];
#pragma unroll
        for (int q = 0; q < 8; ++q) { wf[q] = bf2f((unsigned short)w0[q]); wf[8 + q] = bf2f((unsigned short)w1[q]); }
#pragma unroll 1
        for (int b = 0; b < 9; ++b) { const float* sh = mod1 + b * 3072 + 16 * lane; float s = 0.f;
#pragma unroll
            for (int q = 0; q < 4; ++q) { const f32x4 v = *(const f32x4*)(sh + 4 * q); s += (v[0] * wf[4 * q] + v[1] * wf[4 * q + 1]) + (v[2] * wf[4 * q + 2] + v[3] * wf[4 * q + 3]); }
            s = wave64_sum(s);
            if (lane == 0) C1[b * NPROJ + n] = s; }
    }
}

__device__ __forceinline__ bf16x8 ld8(const bf16* p) { return *(const bf16x8*)p; }
__device__ __forceinline__ f32x16 mfma32(bf16x8 x, bf16x8 y, f32x16 c) { return __builtin_amdgcn_mfma_f32_32x32x16_bf16(x, y, c, 0, 0, 0); }
__device__ __forceinline__ bf16x8 pack8(const float* f) { u32x4 w; w.x = pk2(f[0], f[1]); w.y = pk2(f[2], f[3]); w.z = pk2(f[4], f[5]); w.w = pk2(f[6], f[7]); return __builtin_bit_cast(bf16x8, w); }
__device__ __forceinline__ void st4bf(bf16* p, float x0, float x1, float x2, float x3) { u32x2 w; w.x = pk2(x0, x1); w.y = pk2(x2, x3); *(u32x2*)p = w; }

__device__ __forceinline__ void rope_tables(float (&cs)[8], float (&sn)[8], bool latent, int tok, int hi) {
    if (latent) { const int tp = (tok - NTC) & 4095; const float prow = (float)(tp >> 6), pcol = (float)(tp & 63);
#pragma unroll
        for (int r = 0; r < 8; ++r) { const float f = (float)((r & 3) + 4 * hi); const float inv = __builtin_amdgcn_exp2f(-f * 1.6609640474436812f);
            float rev = (r < 4 ? prow : pcol) * inv * 0.15915494309189535f; rev = rev - floorf(rev);
            cs[r] = __builtin_amdgcn_cosf(rev); sn[r] = __builtin_amdgcn_sinf(rev); } }
    else {
#pragma unroll
        for (int r = 0; r < 8; ++r) { cs[r] = 1.f; sn[r] = 0.f; } }
}
__device__ __forceinline__ void st32blk(bf16* rowp, const float* v, int hi) {
#pragma unroll
    for (int k = 0; k < 4; k += 2) {
        u32x2 A, B; A.x = pk2(v[4 * k], v[4 * k + 1]); A.y = pk2(v[4 * k + 2], v[4 * k + 3]); B.x = pk2(v[4 * k + 4], v[4 * k + 5]); B.y = pk2(v[4 * k + 6], v[4 * k + 7]);
        const auto r0 = __builtin_amdgcn_permlane32_swap(A.x, B.x, false, false); const auto r1 = __builtin_amdgcn_permlane32_swap(A.y, B.y, false, false);
        u32x4 w; w.x = r0[0]; w.y = r1[0]; w.z = r0[1]; w.w = r1[1];
        *(u32x4*)(rowp + 8 * k + 8 * hi) = w;
    }
}
constexpr int P2_RQ = 528, P2_RKV = 272;
__device__ __forceinline__ void p2_q_job(CArgs& a, int l, LAS unsigned char* lds, int tile, int hp, int tid) {
    asm volatile("" : "+v"(tid));
    const int lane = tid & 63, wave = __builtin_amdgcn_readfirstlane(tid >> 6), r32 = lane & 31, hi = lane >> 5;
    const bf16* Wuq = (const bf16*)(a.ws + WS_WUQ) + (size_t)l * 576 * 256;
    const bool latent = tile >= NTC / 256;
    const unsigned tok = tile * 256 + wave * 32 + r32;
    const bf16* PB = (const bf16*)(a.ws + WS_PB);
    bf16x8 xq[16]; float ss = 0.f;
    { const bf16* pp = PB + tok * LDB + CB_CQ + 8 * hi;
#pragma unroll
      for (int s = 0; s < 16; ++s) { xq[s] = ld8(pp + 16 * s); ss += ss8(xq[s]); } }
    ss = xor32_sum(ss);
    const float rstd_cq = __builtin_amdgcn_rsqf(ss * (1.f / 256.f) + EPS);
    const float* qn = a.in[32] + l * 96;
    bf16* Qrow = (bf16*)(a.ws + WS_Q) + (size_t)tok * 576;
    bf16x8 wreg[6];
    const int wrow = tid >> 5, wc = tid & 31;
    unsigned wso = wrow * 256 + wc * 8; asm volatile("" : "+v"(wso));
#pragma unroll
    for (int i = 0; i < 6; ++i) wreg[i] = ld8(Wuq + ((2 * hp) * 96 + 16 * i) * 256 + wso);
#pragma unroll 1
    for (int hh = 0; hh < 2; ++hh) {
        const int head = 2 * hp + hh;
        __syncthreads();
#pragma unroll
        for (int i = 0; i < 6; ++i) *(LAS bf16x8*)(lds + (wrow + 16 * i) * P2_RQ + wc * 16) = wreg[i];
        if (hh == 0) {
#pragma unroll
            for (int i = 0; i < 6; ++i) wreg[i] = ld8(Wuq + ((2 * hp + 1) * 96 + 16 * i) * 256 + wso);
        }
        __syncthreads();
        f32x16 acc[3];
#pragma unroll
        for (int b = 0; b < 3; ++b) { acc[b] = (f32x16){};
            LAS const unsigned char* wl = lds + (32 * b + r32) * P2_RQ + 16 * hi;
#pragma unroll
            for (int s = 0; s < 16; ++s) acc[b] = mfma32(*(LAS const bf16x8*)(wl + 32 * s), xq[s], acc[b]); }
        float q2 = 0.f;
#pragma unroll
        for (int b = 0; b < 3; ++b)
#pragma unroll
            for (int r = 0; r < 16; ++r) q2 += acc[b][r] * acc[b][r];
        q2 = xor32_sum(q2) * (rstd_cq * rstd_cq);
        const float rq = (__builtin_amdgcn_rsqf(q2 * (1.f / 96.f) + EPS)) * (MLA_SCALE * LOG2E) * rstd_cq;
#pragma unroll
        for (int b = 0; b < 3; ++b)
#pragma unroll
            for (int g = 0; g < 4; ++g) { const f32x4 w4 = *(const f32x4*)(qn + b * 32 + 8 * g + 4 * hi);
#pragma unroll
                for (int i = 0; i < 4; ++i) acc[b][4 * g + i] *= rq * w4[i]; }
        { int tk = (int)tok; asm volatile("" : "+v"(tk)); float cs[8], sn[8]; rope_tables(cs, sn, latent, tk, hi);
#pragma unroll
          for (int r = 0; r < 8; ++r) { const float x1 = acc[2][r], x2 = acc[2][r + 8]; acc[2][r] = x1 * cs[r] - x2 * sn[r]; acc[2][r + 8] = x2 * cs[r] + x1 * sn[r]; } }
#pragma unroll
        for (int b = 0; b < 3; ++b) { float v[16];
#pragma unroll
            for (int r = 0; r < 16; ++r) v[r] = acc[b][r];
            st32blk(Qrow + head * 96 + b * 32, v, hi); }
    }
}
__device__ __forceinline__ void p2_kv_job(CArgs& a, int l, LAS unsigned char* lds, int tile, int part, int tid) {
    asm volatile("" : "+v"(tid));
    const int lane = tid & 63, wave = __builtin_amdgcn_readfirstlane(tid >> 6), r32 = lane & 31, hi = lane >> 5;
    unsigned char* ws = a.ws;
    const bf16* Wukv = (const bf16*)(ws + WS_WUKV) + (size_t)l * 768 * 128;
    const bool is_cc = tile >= 160;
    const bool latent = !is_cc && tile >= NTC / 256;
    const bool context = !is_cc && !latent;
    const unsigned tok = (is_cc ? (tile - 160) * 256 : tile * 256) + wave * 32 + r32;
    { const int rb = part < 2 ? 192 * part : 384 + 192 * (part - 2); const int wrow = tid >> 4, wc = tid & 15;
      bf16x8 wreg[6];
      unsigned wso = wrow * 128 + wc * 8; asm volatile("" : "+v"(wso));
#pragma unroll
      for (int i = 0; i < 6; ++i) wreg[i] = ld8(Wukv + (rb + 32 * i) * 128 + wso);
      __syncthreads();
#pragma unroll
      for (int i = 0; i < 6; ++i) *(LAS bf16x8*)(lds + (wrow + 32 * i) * P2_RKV + wc * 16) = wreg[i]; }
    bf16* Kd = (bf16*)(ws + (is_cc ? WS_CK : WS_MK)) + (size_t)tok * 576; bf16* Vd = (bf16*)(ws + (is_cc ? WS_CV : WS_MV)) + (size_t)tok * 384;
    bf16x8 xk[8]; float kr[16]; float kr2 = 0.f;
    if (!is_cc) {
        const bf16* PB = (const bf16*)(ws + WS_PB);
        const unsigned pbo = tok * LDB + 8 * hi;
        float ss = 0.f;
        { const bf16* pp = PB + pbo + CB_CKV;
#pragma unroll
          for (int s = 0; s < 8; ++s) { xk[s] = ld8(pp + 16 * s); ss += ss8(xk[s]); } }
        ss = xor32_sum(ss);
        const float rstd = __builtin_amdgcn_rsqf(ss * (1.f / 128.f) + EPS);
        const float* gk = a.in[28] + l * 128;
        const unsigned cb = tok >> 8, ct = tok & 255;
        float* ckv_out = a.out + OUT_CKV; const unsigned co = ((cb * 2 + l) * 256 + ct) * 128 + 8 * hi;
        const bool wr_cache = context && part == 0;
#pragma unroll
        for (int s = 0; s < 8; ++s) { float f[8];
            const f32x4 g0 = *(const f32x4*)(gk + 16 * s + 8 * hi), g1 = *(const f32x4*)(gk + 16 * s + 8 * hi + 4);
#pragma unroll
            for (int j = 0; j < 8; ++j) f[j] = bf2f((unsigned short)xk[s][j]) * rstd * (j < 4 ? g0[j & 3] : g1[j & 3]);
            if (wr_cache) { *(f32x4*)(ckv_out + co + 16 * s) = (f32x4){f[0], f[1], f[2], f[3]}; *(f32x4*)(ckv_out + co + (16 * s + 4)) = (f32x4){f[4], f[5], f[6], f[7]}; }
            xk[s] = pack8(f); }
        float* kr_out = a.out + OUT_KROPE; const unsigned kro = ((cb * 2 + l) * 256 + ct) * 32 + 4 * hi;
#pragma unroll
        for (int g = 0; g < 4; ++g) { const u32x2 w = *(const u32x2*)(PB + pbo + (CB_KR + 8 * g) - 4 * hi);
            kr[4 * g] = lo_f(w.x); kr[4 * g + 1] = hi_f(w.x); kr[4 * g + 2] = lo_f(w.y); kr[4 * g + 3] = hi_f(w.y);
            if (wr_cache) *(f32x4*)(kr_out + kro + 8 * g) = (f32x4){kr[4 * g], kr[4 * g + 1], kr[4 * g + 2], kr[4 * g + 3]}; }
    } else {
        const unsigned b = tok >> 9, p = tok & 511;
        const float* src = a.in[5]; const unsigned so = ((b * 2 + l) * 512 + p) * 128 + 8 * hi;
#pragma unroll
        for (int s = 0; s < 8; ++s) { const f32x4 v0 = *(const f32x4*)(src + so + 16 * s), v1 = *(const f32x4*)(src + so + (16 * s + 4));
            float f[8] = {v0[0], v0[1], v0[2], v0[3], v1[0], v1[1], v1[2], v1[3]}; xk[s] = pack8(f); }
        const float* ksrc = a.in[6]; const unsigned kso = ((b * 2 + l) * 512 + p) * 32 + 4 * hi;
#pragma unroll
        for (int g = 0; g < 4; ++g) { const f32x4 v = *(const f32x4*)(ksrc + kso + 8 * g); kr[4 * g] = v[0]; kr[4 * g + 1] = v[1]; kr[4 * g + 2] = v[2]; kr[4 * g + 3] = v[3]; }
    }
#pragma unroll
    for (int r = 0; r < 16; ++r) kr2 += kr[r] * kr[r];
    kr2 = xor32_sum(kr2);
    const float* kn = a.in[33] + l * 96;
    __syncthreads();
    if (part < 2) {
#pragma unroll 1
        for (int hh = 0; hh < 3; ++hh) {
            const int head = 3 * part + hh;
            f32x16 acc[2];
#pragma unroll
            for (int b = 0; b < 2; ++b) { acc[b] = (f32x16){};
                LAS const unsigned char* wl = lds + (64 * hh + 32 * b + r32) * P2_RKV + 16 * hi;
#pragma unroll
                for (int s = 0; s < 8; ++s) acc[b] = mfma32(*(LAS const bf16x8*)(wl + 32 * s), xk[s], acc[b]); }
            float k2 = 0.f;
#pragma unroll
            for (int b = 0; b < 2; ++b)
#pragma unroll
                for (int r = 0; r < 16; ++r) k2 += acc[b][r] * acc[b][r];
            k2 = xor32_sum(k2);
            const float rk = __builtin_amdgcn_rsqf((k2 + kr2) * (1.f / 96.f) + EPS);
#pragma unroll
            for (int b = 0; b < 2; ++b) { float v[16];
#pragma unroll
                for (int g = 0; g < 4; ++g) { const f32x4 w4 = *(const f32x4*)(kn + b * 32 + 8 * g + 4 * hi);
#pragma unroll
                    for (int i = 0; i < 4; ++i) v[4 * g + i] = acc[b][4 * g + i] * rk * w4[i]; }
                st32blk(Kd + head * 96 + b * 32, v, hi); }
            float kv[16];
#pragma unroll
            for (int g = 0; g < 4; ++g) { const f32x4 w4 = *(const f32x4*)(kn + 64 + 8 * g + 4 * hi);
#pragma unroll
                for (int i = 0; i < 4; ++i) kv[4 * g + i] = kr[4 * g + i] * rk * w4[i]; }
            { int tk = (int)tok; asm volatile("" : "+v"(tk)); float cs[8], sn[8]; rope_tables(cs, sn, latent, tk, hi);
#pragma unroll
              for (int r = 0; r < 8; ++r) { const float x1 = kv[r], x2 = kv[r + 8]; kv[r] = x1 * cs[r] - x2 * sn[r]; kv[r + 8] = x2 * cs[r] + x1 * sn[r]; } }
            st32blk(Kd + head * 96 + 64, kv, hi);
        }
    } else {
#pragma unroll 1
        for (int nb = 0; nb < 6; ++nb) {
            f32x16 acc = (f32x16){};
            LAS const unsigned char* wl = lds + (32 * nb + r32) * P2_RKV + 16 * hi;
#pragma unroll
            for (int s = 0; s < 8; ++s) acc = mfma32(*(LAS const bf16x8*)(wl + 32 * s), xk[s], acc);
            float v[16];
#pragma unroll
            for (int r = 0; r < 16; ++r) v[r] = acc[r];
            st32blk(Vd + 192 * (part - 2) + nb * 32, v, hi);
        }
    }
}

__device__ __forceinline__ void p2_na_token(CArgs& a, int l, int tok, int lane) {
    asm volatile("" : "+v"(lane));
    bf16* row = (bf16*)(a.ws + WS_PA) + (size_t)tok * LDA;
    const bool context = tok < NTC;
    const int cb = tok >> 8, ct = tok & 255;
    float* nak = a.out + OUT_NAK + ((size_t)(cb * 2 + l) * 256 + ct) * 384;
    float* nav = a.out + OUT_NAV + ((size_t)(cb * 2 + l) * 256 + ct) * 384;
    const float* qw = a.in[24] + l * 64; const float* kw = a.in[25] + l * 64;
#pragma unroll
    for (int i = 0; i < 3; ++i) {
        const int e = 4 * lane + 256 * i;
        const u32x2 w = *(const u32x2*)(row + CA_QN + e);
        float f[4] = {lo_f(w.x), hi_f(w.x), lo_f(w.y), hi_f(w.y)};
        float s = (f[0] * f[0] + f[1] * f[1]) + (f[2] * f[2] + f[3] * f[3]);
        s = row16_sum(s);
        const float rs = __builtin_amdgcn_rsqf(s * (1.f / 64.f) + EPS);
        const bool isq = e < 384; const int d = e & 63;
        const float* gw = isq ? qw : kw; const float sc = isq ? rs * (0.125f * LOG2E) : rs;
        float o[4];
#pragma unroll
        for (int j = 0; j < 4; ++j) o[j] = f[j] * sc * gw[d + j];
        st4bf(row + CA_QN + e, o[0], o[1], o[2], o[3]);
        if (context && !isq) *(f32x4*)(nak + (e - 384)) = (f32x4){o[0], o[1], o[2], o[3]};
    }
    if (context) {
#pragma unroll
        for (int i = 0; i < 2; ++i) { const int e = 4 * lane + 256 * i;
            if (e < 384) { const u32x2 w = *(const u32x2*)(row + CA_VN + e); *(f32x4*)(nav + e) = (f32x4){lo_f(w.x), hi_f(w.x), lo_f(w.y), hi_f(w.y)}; } }
    }
}

__device__ __forceinline__ void phase_p2(CArgs& a, int l, LAS unsigned char* lds, int vcu, int G, int tid, int wave, int lane, bool dry) {
    for (int jid = vcu; jid < 1184; jid += G) { if (jid < 480) p2_q_job(a, l, lds, jid / 3, jid % 3, tid); else { const int v = jid - 480; p2_kv_job(a, l, lds, v >> 2, v & 3, tid); } }
    __syncthreads();
    (void)dry; (void)wave; (void)lane;
}

struct AttnSeg { const bf16* K; const bf16* V; int ks, vs, nt; };
constexpr int ATT_KVB = 20480;
constexpr int ATT_BIAS_OFF = 2 * ATT_KVB;
typedef LAS const unsigned char* ldsc_t;
__device__ __forceinline__ s16x4 vtr(ldsc_t p) { typedef short v4i16_t __attribute__((ext_vector_type(4))); return __builtin_bit_cast(s16x4, __builtin_amdgcn_ds_read_tr16_b64_v4i16((LAS v4i16_t*)p)); }

__device__ __forceinline__ float max3f(float a, float b, float c) { float r; asm("v_max3_f32 %0, %1, %2, %3" : "=v"(r) : "v"(a), "v"(b), "v"(c)); return r; }
__device__ __forceinline__ float max2f(float a, float b) { float r; asm("v_max_f32_e32 %0, %1, %2" : "=v"(r) : "v"(a), "v"(b)); return r; }
template <int DK, bool LOCAL_OK>
__device__ __forceinline__ void attn_unit(LAS unsigned char* lds, const bf16* Qp, int qs, AttnSeg s0, AttnSeg s1, bf16* Gp, int gs,
                                          const bool local_rt, const float* rpb, int r0, int kr_lo, int tid, bool dry, bool fast) {
    asm volatile("" : "+v"(tid));
    const bool LOCAL = LOCAL_OK && local_rt;
    constexpr int NS = DK / 16;
    constexpr int KB = 64 * DK * 2;
    const int lane = tid & 63, wave = __builtin_amdgcn_readfirstlane(tid >> 6), r32 = lane & 31, hi = lane >> 5;
    bf16x8 qf[NS];
    { const bf16* qrow = Qp + (size_t)(wave * 32 + r32) * qs + 8 * hi;
#pragma unroll
      for (int s = 0; s < NS; ++s) qf[s] = ld8(qrow + 16 * s); }
    int my_row = 0, my_rs = 0, jbase = 0, lbase = 0;
    if (LOCAL) {
        LAS float* bt = (LAS float*)(lds + ATT_BIAS_OFF);
        if (tid < 480) { const int row = tid >> 1, half = tid & 1; const int L = row / 15, dr = row - L * 15;
#pragma unroll
            for (int q = 0; q < 17; ++q) { const int j = 17 * half + q, dc = j - 1; const bool ok = dc >= L && dc < L + 16 && dc >= 0 && dc <= 30;
                bt[row * 34 + j] = ok ? rpb[dr * 31 + (ok ? dc : 0)] * LOG2E : -1e30f; } }
        my_row = r0 + (wave >> 1); my_rs = min(max(my_row - 4, 0), 56);
        const int qcol = 32 * (wave & 1) + r32, cs_ = min(max(qcol - 8, 0), 48);
        jbase = 16 - qcol + 4 * hi;
        lbase = (cs_ - qcol + 15) * 510;
    }
    const int nt = s0.nt + s1.nt;
    const int vkey = 16 * (wave & 3) + (lane >> 2), vch = 4 * (wave >> 2) + (lane & 3);
    bf16x8 kreg0, kreg1, vreg;
    auto stage_load = [&](int t) {
        const bool in0 = t < s0.nt; const int tt = in0 ? t : t - s0.nt;
        const bf16* Kb = in0 ? s0.K : s1.K; const bf16* Vb = in0 ? s0.V : s1.V; const int ks = in0 ? s0.ks : s1.ks, vs = in0 ? s0.vs : s1.vs;
        const bf16* kp = Kb + (size_t)(tt * 64 + lane) * ks;
        kreg0 = ld8(kp + wave * 8);
        if (DK == 96 && wave < 4) kreg1 = ld8(kp + (wave + 8) * 8);
        vreg = ld8(Vb + (size_t)(tt * 64 + vkey) * vs + vch * 8);
    };
    auto stage_write = [&](int buf) {
        LAS unsigned char* kb = lds + buf * ATT_KVB;
        *(LAS bf16x8*)(kb + wave * 1024 + lane * 16) = kreg0;
        if (DK == 96 && wave < 4) *(LAS bf16x8*)(kb + (wave + 8) * 1024 + lane * 16) = kreg1;
        *(LAS bf16x8*)(kb + KB + wave * 1024 + lane * 16) = vreg;
    };
    float m = 0.f, lsum = 0.f;
    f32x16 o0 = (f32x16){}, o1 = (f32x16){}, negm = (f32x16){};
    stage_load(0); stage_write(0);
    __syncthreads();
    if (!LOCAL_OK && fast) {
    const f32x16 zero16 = (f32x16){};
    for (int t = 0; t < nt; ++t) {
        if (t + 1 < nt) stage_load(t + 1);
        ldsc_t kb = (ldsc_t)(lds + (t & 1) * ATT_KVB);
        f32x16 p0, p1;
        __builtin_amdgcn_s_setprio(1);
        __builtin_amdgcn_iglp_opt(1);
        bf16x8 kf0[NS], kf1[NS];
#pragma unroll
        for (int s = 0; s < NS; ++s) { kf0[s] = *(LAS const bf16x8*)(kb + (2 * s + hi) * 1024 + r32 * 16); kf1[s] = *(LAS const bf16x8*)(kb + (2 * s + hi) * 1024 + r32 * 16 + 512); }
        __builtin_amdgcn_sched_barrier(0);
        p0 = mfma32(kf0[0], qf[0], zero16);
#pragma unroll
        for (int s = 1; s < NS; ++s) p0 = mfma32(kf0[s], qf[s], p0);
        p1 = mfma32(kf1[0], qf[0], zero16);
#pragma unroll
        for (int s = 1; s < NS; ++s) p1 = mfma32(kf1[s], qf[s], p1);
        __builtin_amdgcn_s_setprio(0);
        ldsc_t vp = kb + KB + ((lane >> 4) & 1) * 32 + (lane & 3) * 8 + (4 * hi + ((lane & 15) >> 2)) * 64;
        s16x4 va[8], vb[8];
#pragma unroll
        for (int i = 0; i < 8; ++i) { va[i] = vtr(vp + (i >> 2) * 4096 + (i & 3) * 1024); vb[i] = vtr(vp + (i >> 2) * 4096 + (i & 3) * 1024 + 512); }
#define ATT_VF(i) ((bf16x8){va[i][0], va[i][1], va[i][2], va[i][3], vb[i][0], vb[i][1], vb[i][2], vb[i][3]})
        float ps = 0.f; float e0[16], e1[16];
#pragma unroll
        for (int r = 0; r < 16; ++r) { e0[r] = __builtin_amdgcn_exp2f(p0[r]); ps += e0[r]; }
        const bf16x8 pa0 = pack8(e0), pa1 = pack8(e0 + 8);
        __builtin_amdgcn_sched_barrier(0);
        o0 = mfma32(ATT_VF(0), pa0, o0); o1 = mfma32(ATT_VF(4), pa0, o1);
        o0 = mfma32(ATT_VF(1), pa1, o0); o1 = mfma32(ATT_VF(5), pa1, o1);
        __builtin_amdgcn_sched_barrier(0);
#pragma unroll
        for (int r = 0; r < 16; ++r) { e1[r] = __builtin_amdgcn_exp2f(p1[r]); ps += e1[r]; }
        lsum += ps;
        const bf16x8 pa2 = pack8(e1), pa3 = pack8(e1 + 8);
        __builtin_amdgcn_sched_barrier(0);
        o0 = mfma32(ATT_VF(2), pa2, o0); o1 = mfma32(ATT_VF(6), pa2, o1);
        o0 = mfma32(ATT_VF(3), pa3, o0); o1 = mfma32(ATT_VF(7), pa3, o1);
#undef ATT_VF
        if (t + 1 < nt) stage_write((t + 1) & 1);
        __syncthreads();
    }
    } else
    for (int t = 0; t < nt; ++t) {
        if (t + 1 < nt) stage_load(t + 1);
        bool active = true; int dr = 0;
        if (LOCAL && t >= s0.nt) { const int kr = kr_lo + (t - s0.nt); active = (kr >= my_rs) && (kr < my_rs + 8); dr = kr - my_row + 7; }
        if (active) {
            ldsc_t kb = (ldsc_t)(lds + (t & 1) * ATT_KVB);
            f32x16 p0, p1;
            __builtin_amdgcn_s_setprio(1);
            __builtin_amdgcn_iglp_opt(1);
            bf16x8 kf0[NS], kf1[NS];
#pragma unroll
            for (int s = 0; s < NS; ++s) { kf0[s] = *(LAS const bf16x8*)(kb + (2 * s + hi) * 1024 + r32 * 16); kf1[s] = *(LAS const bf16x8*)(kb + (2 * s + hi) * 1024 + r32 * 16 + 512); }
            __builtin_amdgcn_sched_barrier(0);
#pragma unroll
            for (int s = 0; s < NS; ++s) {
                if (s == 0) { p0 = mfma32(kf0[0], qf[0], negm); p1 = mfma32(kf1[0], qf[0], negm); }
                else { p0 = mfma32(kf0[s], qf[s], p0); p1 = mfma32(kf1[s], qf[s], p1); }
            }
            __builtin_amdgcn_s_setprio(0);
            if (LOCAL && t >= s0.nt) {
                LAS const float* bt = (LAS const float*)(lds + ATT_BIAS_OFF) + lbase + dr * 34;
#pragma unroll
                for (int r = 0; r < 16; ++r) {
                    const int j0 = min(max(jbase + (r & 3) + 8 * (r >> 2), 0), 33), j1 = min(max(jbase + (r & 3) + 8 * (r >> 2) + 32, 0), 33);
                    p0[r] += bt[j0]; p1[r] += bt[j1];
                }
            }
            float mxa = max3f(p0[0], p0[1], p1[0]), mxb = max3f(p0[2], p0[3], p1[1]); mxa = max3f(mxa, p1[2], p1[3]);
#pragma unroll
            for (int r = 4; r < 16; r += 4) { mxa = max3f(mxa, p0[r], p0[r + 1]); mxb = max3f(mxb, p0[r + 2], p0[r + 3]); mxa = max3f(mxa, p1[r], p1[r + 1]); mxb = max3f(mxb, p1[r + 2], p1[r + 3]); }
            float mx = max2f(mxa, mxb);
            { const auto rr = __builtin_amdgcn_permlane32_swap(__float_as_uint(mx), __float_as_uint(mx), false, false); mx = max2f(__uint_as_float(rr[0]), __uint_as_float(rr[1])); }
            if (t == 0 || !__all(mx <= 8.0f)) {
                const float d = t == 0 ? mx : fmaxf(mx, 0.f); const float al = __builtin_amdgcn_exp2f(-d);
#pragma unroll
                for (int r = 0; r < 16; ++r) { o0[r] *= al; o1[r] *= al; p0[r] -= d; p1[r] -= d; }
                lsum *= al; m += d;
#pragma unroll
                for (int r = 0; r < 16; ++r) negm[r] = -m;
            }
            ldsc_t vp = kb + KB + ((lane >> 4) & 1) * 32 + (lane & 3) * 8 + (4 * hi + ((lane & 15) >> 2)) * 64;
            s16x4 va[8], vb[8];
#pragma unroll
            for (int i = 0; i < 8; ++i) { va[i] = vtr(vp + (i >> 2) * 4096 + (i & 3) * 1024); vb[i] = vtr(vp + (i >> 2) * 4096 + (i & 3) * 1024 + 512); }
#define ATT_VF(i) ((bf16x8){va[i][0], va[i][1], va[i][2], va[i][3], vb[i][0], vb[i][1], vb[i][2], vb[i][3]})
            float ps = 0.f; float e0[16], e1[16];
#pragma unroll
            for (int r = 0; r < 16; ++r) { e0[r] = __builtin_amdgcn_exp2f(p0[r]); ps += e0[r]; }
            const bf16x8 pa0 = pack8(e0), pa1 = pack8(e0 + 8);
            __builtin_amdgcn_sched_barrier(0);
            o0 = mfma32(ATT_VF(0), pa0, o0); o1 = mfma32(ATT_VF(4), pa0, o1);
            o0 = mfma32(ATT_VF(1), pa1, o0); o1 = mfma32(ATT_VF(5), pa1, o1);
            __builtin_amdgcn_sched_barrier(0);
#pragma unroll
            for (int r = 0; r < 16; ++r) { e1[r] = __builtin_amdgcn_exp2f(p1[r]); ps += e1[r]; }
            lsum += ps;
            const bf16x8 pa2 = pack8(e1), pa3 = pack8(e1 + 8);
            __builtin_amdgcn_sched_barrier(0);
            o0 = mfma32(ATT_VF(2), pa2, o0); o1 = mfma32(ATT_VF(6), pa2, o1);
            o0 = mfma32(ATT_VF(3), pa3, o0); o1 = mfma32(ATT_VF(7), pa3, o1);
#undef ATT_VF
        }
        if (t + 1 < nt) stage_write((t + 1) & 1);
        __syncthreads();
    }
    const float inv = 1.0f / xor32_sum(lsum);
    if (!dry) {
    bf16* grow = Gp + (size_t)(wave * 32 + r32) * gs;
#pragma unroll
    for (int g = 0; g < 4; ++g) {
        { bf16* p = grow + 8 * g + 4 * hi; const u32x2 w = *(const u32x2*)p;
          st4bf(p, o0[4 * g] * inv * silu_f(lo_f(w.x)), o0[4 * g + 1] * inv * silu_f(hi_f(w.x)), o0[4 * g + 2] * inv * silu_f(lo_f(w.y)), o0[4 * g + 3] * inv * silu_f(hi_f(w.y))); }
        { bf16* p = grow + 32 + 8 * g + 4 * hi; const u32x2 w = *(const u32x2*)p;
          st4bf(p, o1[4 * g] * inv * silu_f(lo_f(w.x)), o1[4 * g + 1] * inv * silu_f(hi_f(w.x)), o1[4 * g + 2] * inv * silu_f(lo_f(w.y)), o1[4 * g + 3] * inv * silu_f(hi_f(w.y))); }
    }
    } else { asm volatile("" :: "v"(o0), "v"(o1), "v"(inv)); }
    __syncthreads();
}

constexpr int ATT_UNITS = 1920;
__device__ __forceinline__ void attn_dispatch(CArgs& a, int l, int u, LAS unsigned char* lds, int tid, int dmode) {
    const bool dry = dmode != 0;
    unsigned char* ws = a.ws;
    bf16* PA = (bf16*)(ws + WS_PA);
    if (u < 768 || (u >= 1536 && u < 1728)) {
        AttnSeg s0, s1; int tok0, h;
        if (u < 768) { const int b = u / 96, qb = u % 16; h = (u / 16) % 6; tok0 = NTC + b * TL + qb * 256;
            s0 = AttnSeg{(const bf16*)(ws + WS_CK) + (size_t)(b * 512) * 576 + h * 96, (const bf16*)(ws + WS_CV) + (size_t)(b * 512) * 384 + h * 64, 576, 384, 8};
            s1 = AttnSeg{(const bf16*)(ws + WS_MK) + (size_t)(NTC + b * TL) * 576 + h * 96, (const bf16*)(ws + WS_MV) + (size_t)(NTC + b * TL) * 384 + h * 64, 576, 384, 64};
        } else { const int v = u - 1536; const int b = v / 6; h = v % 6; tok0 = b * TC;
            s0 = AttnSeg{(const bf16*)(ws + WS_MK) + (size_t)tok0 * 576 + h * 96, (const bf16*)(ws + WS_MV) + (size_t)tok0 * 384 + h * 64, 576, 384, 4};
            s1 = AttnSeg{s0.K, s0.V, 576, 384, 0}; }
        attn_unit<96, false>(lds, (const bf16*)(ws + WS_Q) + (size_t)tok0 * 576 + h * 96, 576, s0, s1, PA + (size_t)tok0 * LDA + CA_GM + h * 64, LDA, false, nullptr, 0, 0, tid, dry, ((const float*)(ws + WS_ABND))[l] <= 60.0f);
    } else {
        AttnSeg s0, s1; int tok0, h, r0 = 0, kr_lo = 0; bool local = false;
        if (u < 1536) { const int v = u - 768; const int b = v / 96, rg = v % 16; h = (v / 16) % 6; tok0 = NTC + b * TL + rg * 256; r0 = rg * 4; local = true;
            kr_lo = min(max(r0 - 4, 0), 56); const int kr_hi = min(max(r0 + 3 - 4, 0), 56) + 8;
            s0 = AttnSeg{(const bf16*)(ws + WS_NACK) + ((size_t)(b * 2 + l) * 512) * 384 + h * 64, (const bf16*)(ws + WS_NACV) + ((size_t)(b * 2 + l) * 512) * 384 + h * 64, 384, 384, 8};
            const bf16* kb = PA + (size_t)(NTC + b * TL + kr_lo * 64) * LDA;
            s1 = AttnSeg{kb + CA_KN + h * 64, kb + CA_VN + h * 64, LDA, LDA, kr_hi - kr_lo};
        } else { const int v = u - 1728; const int b = v / 6; h = v % 6; tok0 = b * TC;
            const bf16* kb = PA + (size_t)tok0 * LDA;
            s0 = AttnSeg{kb + CA_KN + h * 64, kb + CA_VN + h * 64, LDA, LDA, 4};
            s1 = AttnSeg{s0.K, s0.V, LDA, LDA, 0}; }
        attn_unit<64, true>(lds, PA + (size_t)tok0 * LDA + CA_QN + h * 64, LDA, s0, s1, PA + (size_t)tok0 * LDA + CA_GN + h * 64, LDA, local, a.in[26] + (size_t)(l * 6 + h) * 15 * 31, r0, kr_lo, tid, dry, false);
    }
}

constexpr int SC_R = 0, SC_V = 4096, SC_NK = 8192, SC_W = 12288, SC_BB = 16384, SC_KD = 20480, SC_KC = 24576, SC_AA = 28672, SC_YB = 32768;
constexpr int SC_NT = 36864, SC_RT = SC_NT + 2176, SC_BT = SC_RT + 2176, SC_KT = SC_BT + 2176;
constexpr int SC_BHT = SC_KT + 2176, SC_KHT = SC_BHT + 2560, SC_VT = SC_KHT + 2560;
constexpr int SC_GC = SC_VT + 2560;
constexpr int SC_A1 = SC_GC + 256;
constexpr int SC_A2 = SC_A1 + 1024, SC_B1 = SC_A2 + 640, SC_B2 = SC_B1 + 640;
constexpr int SC_TW = SC_B2 + 640;
constexpr int SC_CW = SC_TW + 4 * 640;
constexpr int SC_YP = SC_CW + 12 * 256;
constexpr int SC_GC2 = SC_YP + 2048;
constexpr int SC_GX = SC_GC2 + 256;
constexpr int SCAN_SLOT = SC_GX + 1024;
static_assert(2 * SCAN_SLOT <= 131072, "scan LDS map");
__device__ __forceinline__ float dot4(f32x4 x, f32x4 y) { return (x[0] * y[0] + x[1] * y[1]) + (x[2] * y[2] + x[3] * y[3]); }
__device__ __forceinline__ f32x4 ldbf4(const bf16* p) { const u32x2 w = *(const u32x2*)p; return (f32x4){lo_f(w.x), hi_f(w.x), lo_f(w.y), hi_f(w.y)}; }
__device__ __forceinline__ f32x4 cvbf4(u32x2 w) { return (f32x4){lo_f(w.x), hi_f(w.x), lo_f(w.y), hi_f(w.y)}; }
__device__ __forceinline__ float tanh_f(float x) { return 1.f - 2.f * rcp_f(1.f + __expf(2.f * x)); }
__device__ __forceinline__ u32x2 pk4(f32x4 v) { u32x2 w; w.x = pk2(v[0], v[1]); w.y = pk2(v[2], v[3]); return w; }
__device__ __forceinline__ bf16x8 cat8(u32x2 lo, u32x2 hi) { u32x4 w; w.x = lo.x; w.y = lo.y; w.z = hi.x; w.w = hi.y; return __builtin_bit_cast(bf16x8, w); }
__device__ __forceinline__ f32x4 mfma16(bf16x8 x, bf16x8 y, f32x4 c) { return __builtin_amdgcn_mfma_f32_16x16x32_bf16(x, y, c, 0, 0, 0); }
__device__ __forceinline__ u32x2 lds8(LAS const unsigned char* p) { return *(LAS const u32x2*)p; }

__device__ __forceinline__ unsigned char* scan_yp(unsigned char* ws, int jobid) { return jobid < 704 ? ws + WS_YPA + (size_t)jobid * 32768 : ws + WS_YPB + (size_t)(jobid - 704) * 32768; }
__device__ __forceinline__ void scan_job(CArgs& a, int l, LAS unsigned char* slot, bool lat, int b, int d, int h, int c, int jt, int w4, int lane, int mode, int hw) {
    const bool PH1 = lat && c > 0;
    asm volatile("" : "+v"(jt), "+v"(lane));
    (void)mode;
    unsigned char* ws = a.ws;
    const int T = lat ? TL : TC, tokbase = lat ? NTC + b * TL : b * TC;
    const int chain = b * 8 + d * 4 + h;
    const bf16* PA = (const bf16*)(ws + WS_PA);
    const int g4 = lane >> 4, j16 = lane & 15;
    const int tokl = jt >> 4, cg = jt & 15;
    LAS float* fCW = (LAS float*)(slot + SC_CW);
    for (int i = jt; i < 12 * 64; i += 256) { const int rw = i >> 6, ch = i & 63; float v;
        if (rw < 9) v = a.in[14][(size_t)l * 3 * 768 + (rw % 3) * 768 + (rw / 3) * 256 + h * 64 + ch];
        else if (rw == 9) v = a.in[19][l * 256 + h * 64 + ch]; else if (rw == 10) v = a.in[20][l * 256 + h * 64 + ch]; else v = a.in[21][(l * 4 + h) * 64 + ch];
        fCW[i] = v; }
    const bf16* lora_w = (const bf16*)(ws + WS_LORA) + (size_t)(((l * 2 + 0) * 2 + d) * 256 + h * 64 + 16 * w4 + j16) * 64 + 8 * g4;
    const bf16* lora_a = (const bf16*)(ws + WS_LORA) + (size_t)(((l * 2 + 1) * 2 + d) * 256 + h * 64 + 16 * w4 + j16) * 64 + 8 * g4;
    const bf16x8 lw0 = ld8(lora_w), lw1 = ld8(lora_w + 32), la0 = ld8(lora_a), la1 = ld8(lora_a + 32);
    const float w0c = a.in[15][(l * 2 + d) * 256 + h * 64 + 16 * w4 + j16];
    const float a0c = a.in[17][(l * 2 + d) * 256 + h * 64 + 16 * w4 + j16];
    f32x4 S[4], P[4];
    {
        const float* src = nullptr;
        if (!PH1 && lat) src = a.in[2] + (size_t)((((b * 2 + l) * 2 + d) * 4 + h)) * 4096;
#pragma unroll
        for (int blk = 0; blk < 4; ++blk) {
            S[blk] = src ? *(const f32x4*)(src + (16 * w4 + j16) * 64 + 16 * blk + 4 * g4) : (f32x4){0.f, 0.f, 0.f, 0.f};
#pragma unroll
            for (int q = 0; q < 4; ++q) P[blk][q] = (PH1 && (16 * w4 + j16 == 16 * blk + 4 * g4 + q)) ? 1.f : 0.f;
        }
    }
    LAS float* fR = (LAS float*)(slot + SC_R); LAS float* fV = (LAS float*)(slot + SC_V); LAS float* fNK = (LAS float*)(slot + SC_NK); LAS float* fW = (LAS float*)(slot + SC_W);
    LAS float* fBB = (LAS float*)(slot + SC_BB); LAS float* fKD = (LAS float*)(slot + SC_KD); LAS float* fKC = (LAS float*)(slot + SC_KC); LAS float* fAA = (LAS float*)(slot + SC_AA);
    LAS float* fYB = (LAS float*)(slot + SC_YB); LAS float* fGC = (LAS float*)(slot + SC_GC); LAS float* fA1 = (LAS float*)(slot + SC_A1);
    LAS unsigned char* TWw = slot + SC_TW + w4 * 640;
    u32x2 q_r[3], q_k[3], q_v[3]; bf16x8 q_wd0, q_wd1, q_ad0, q_ad1;
    auto issue_loads = [&](int sub) {
        const int tau0 = c * SCAN_L + sub * 16;
        { const int tau = tau0 + tokl; const int t = d ? T - 1 - tau : tau; const bf16* row = PA + ((size_t)tokbase + t) * LDA + h * 64 + 4 * cg;
          const bool hp = t > 0, hn = t + 1 < T; const u32x2 z = (u32x2){0u, 0u};
          q_r[0] = hp ? *(const u32x2*)(row - LDA + CA_R) : z; q_r[1] = *(const u32x2*)(row + CA_R); q_r[2] = hn ? *(const u32x2*)(row + LDA + CA_R) : z;
          q_k[0] = hp ? *(const u32x2*)(row - LDA + CA_K) : z; q_k[1] = *(const u32x2*)(row + CA_K); q_k[2] = hn ? *(const u32x2*)(row + LDA + CA_K) : z;
          q_v[0] = hp ? *(const u32x2*)(row - LDA + CA_V) : z; q_v[1] = *(const u32x2*)(row + CA_V); q_v[2] = hn ? *(const u32x2*)(row + LDA + CA_V) : z; }
        { const int tau2 = tau0 + j16; const int t2 = d ? T - 1 - tau2 : tau2; const bf16* row2 = PA + ((size_t)tokbase + t2) * LDA;
          q_wd0 = ld8(row2 + CA_WD + 8 * g4); q_wd1 = ld8(row2 + CA_WD + 32 + 8 * g4); q_ad0 = ld8(row2 + CA_AD + 8 * g4); q_ad1 = ld8(row2 + CA_AD + 32 + 8 * g4); }
    };
    auto stage_a = [&](int sa) {
    {
#define CWR(rw) (*(LAS const f32x4*)(fCW + (rw) * 64 + 4 * cg))
        const f32x4 r_c = cvbf4(q_r[0]) * CWR(0) + cvbf4(q_r[1]) * CWR(1) + cvbf4(q_r[2]) * CWR(2);
        const f32x4 k_c = cvbf4(q_k[0]) * CWR(3) + cvbf4(q_k[1]) * CWR(4) + cvbf4(q_k[2]) * CWR(5);
        const f32x4 v_c = cvbf4(q_v[0]) * CWR(6) + cvbf4(q_v[1]) * CWR(7) + cvbf4(q_v[2]) * CWR(8);
        const f32x4 kk = k_c * CWR(9);
        float ss = dot4(kk, kk); ss = row16_sum(ss);
        const float inv = __builtin_amdgcn_rsqf(fmaxf(ss, 1e-24f));
        const int o = tokl * 64 + 4 * cg;
        *(LAS f32x4*)(fR + o) = r_c; *(LAS f32x4*)(fV + o) = v_c; *(LAS f32x4*)(fNK + o) = kk * (-inv); *(LAS f32x4*)(fKC + o) = k_c;
    }
    {
        f32x4 accw = (f32x4){0.f, 0.f, 0.f, 0.f}, acca = (f32x4){0.f, 0.f, 0.f, 0.f}; float dq[4];
        accw = mfma16(q_wd0, lw0, accw); accw = mfma16(q_wd1, lw1, accw);
        acca = mfma16(q_ad0, la0, acca); acca = mfma16(q_ad1, la1, acca);
#pragma unroll
        for (int q = 0; q < 4; ++q) {
            const float x = -(w0c + accw[q]);
            const float sp = fmaxf(x, 0.f) + __logf(1.f + __expf(-fabsf(x)));
            const float decay = __expf(-__expf(-sp - 0.5f));
            const float av = sigmoid_f(a0c + acca[q]);
            const int o = (4 * g4 + q) * 64 + 16 * w4 + j16;
            dq[q] = decay; fAA[o] = av;
        }
        dq[1] *= dq[0]; dq[2] *= dq[1]; dq[3] *= dq[2];
        LAS float* gx = (LAS float*)(slot + SC_GX + w4 * 256);
        gx[g4 * 16 + j16] = dq[3];
        LDS_WAIT();
        const float G0 = gx[j16], G1 = gx[16 + j16], G2 = gx[32 + j16], G3 = gx[48 + j16];
        const float E = g4 == 0 ? 1.f : (g4 == 1 ? G0 : (g4 == 2 ? G0 * G1 : G0 * G1 * G2));
#pragma unroll
        for (int q = 0; q < 4; ++q) fW[(4 * g4 + q) * 64 + 16 * w4 + j16] = E * dq[q];
        if (g4 == 0) ((LAS float*)(slot + ((sa & 1) ? SC_GC2 : SC_GC)))[16 * w4 + j16] = (G0 * G1) * (G2 * G3);
    }
    };
    auto flush_y = [&](int sf) {
        const int tauf = c * SCAN_L + sf * 16 + tokl; const int tf_ = d ? T - 1 - tauf : tauf; const size_t tokf = (size_t)tokbase + tf_;
        const f32x4 y4 = *(LAS const f32x4*)(fYB + tokl * 64 + 4 * cg);
        st4bf((bf16*)(ws + WS_Y) + tokf * 512 + d * 256 + h * 64 + 4 * cg, y4[0], y4[1], y4[2], y4[3]);
        if (PH1) *(u32x2*)(scan_yp(ws, chain * 15 + c - 1) + sf * 2048 + jt * 8) = *(LAS const u32x2*)(slot + SC_YP + jt * 8);
    };
    issue_loads(0);
    __syncthreads();
    stage_a(0);
    if (SCAN_L > 16) issue_loads(1);
#pragma unroll 1
    for (int sub = 0; sub < SCAN_L / 16; ++sub) {
        const int tau0 = c * SCAN_L + sub * 16;
        const int tau = tau0 + tokl; const int t = d ? T - 1 - tau : tau; const size_t tok = (size_t)tokbase + t;
        __syncthreads();
        if (sub > 0) flush_y(sub - 1);
        {
            const int o = tokl * 64 + 4 * cg;
            const f32x4 a4 = *(LAS const f32x4*)(fAA + o), nk4 = *(LAS const f32x4*)(fNK + o), kc4 = *(LAS const f32x4*)(fKC + o), r4 = *(LAS const f32x4*)(fR + o);
            const f32x4 bb = -(nk4 * a4);
            const f32x4 kd = kc4 * ((a4 - 1.0f) * CWR(10) + 1.0f);
            *(LAS f32x4*)(fBB + o) = bb; *(LAS f32x4*)(fKD + o) = kd;
            { float cf = dot4(r4 * kd, CWR(11)); cf = row16_sum(cf);
              if (cg == 0) ((float*)(ws + WS_CC))[(tok * 2 + d) * 4 + h] = cf; }
            const f32x4 gi = *(LAS const f32x4*)(fW + o);
            const f32x4 gm = tokl > 0 ? *(LAS const f32x4*)(fW + o - 64) : (f32x4){1.f, 1.f, 1.f, 1.f};
            const f32x4 ig = (f32x4){rcp_f(gi[0]), rcp_f(gi[1]), rcp_f(gi[2]), rcp_f(gi[3])};
            const int ob = (tokl * 68 + 4 * cg) * 2;
            *(LAS u32x2*)(slot + SC_NT + ob) = pk4(gm * nk4); *(LAS u32x2*)(slot + SC_RT + ob) = pk4(gi * r4);
            *(LAS u32x2*)(slot + SC_BT + ob) = pk4(bb * ig);  *(LAS u32x2*)(slot + SC_KT + ob) = pk4(kd * ig);
        }
        __syncthreads();
        {
            const int k = jt & 63, ig = jt >> 6;
            const float g = ((LAS const float*)(slot + ((sub & 1) ? SC_GC2 : SC_GC)))[k];
            f32x4 bh, kh, vt;
#pragma unroll
            for (int e = 0; e < 4; ++e) { const int i = 4 * ig + e; const float sc = g * rcp_f(fW[i * 64 + k]); bh[e] = fBB[i * 64 + k] * sc; kh[e] = fKD[i * 64 + k] * sc; vt[e] = fV[i * 64 + k]; }
            const int ob = (k * 20 + 4 * ig) * 2;
            *(LAS u32x2*)(slot + SC_BHT + ob) = pk4(bh); *(LAS u32x2*)(slot + SC_KHT + ob) = pk4(kh); *(LAS u32x2*)(slot + SC_VT + ob) = pk4(vt);
        }
        {
            const int pi = (w4 - hw) & 3;
            LAS const unsigned char* Xa = slot + ((pi < 2) ? SC_NT : SC_RT) + (j16 * 68 + 4 * g4) * 2;
            LAS const unsigned char* Yb = slot + ((pi & 1) ? SC_KT : SC_BT) + (j16 * 68 + 4 * g4) * 2;
            f32x4 acc = (f32x4){0.f, 0.f, 0.f, 0.f};
            acc = mfma16(cat8(lds8(Xa), lds8(Xa + 32)), cat8(lds8(Yb), lds8(Yb + 32)), acc);
            acc = mfma16(cat8(lds8(Xa + 64), lds8(Xa + 96)), cat8(lds8(Yb + 64), lds8(Yb + 96)), acc);
#pragma unroll
            for (int q = 0; q < 4; ++q) { const int i = 4 * g4 + q; const bool keep = (pi < 2) ? (j16 < i) : (j16 <= i); const float v = keep ? acc[q] : 0.f;
                if (pi == 0) fA1[i * 16 + j16] = v;
                else *(LAS unsigned short*)(slot + (pi == 1 ? SC_A2 : (pi == 2 ? SC_B1 : SC_B2)) + (i * 20 + j16) * 2) = (unsigned short)(pk2(v, 0.f) & 0xffffu); }
            if (pi == 0) {
                LDS_WAIT();
                const int cT = lane >> 2, pT = lane & 3;
                f32x4 ts = (f32x4){0.f, 0.f, 0.f, 0.f};
#pragma unroll
                for (int i = 0; i < 16; ++i) { const f32x4 a4 = *(LAS const f32x4*)(fA1 + i * 16 + 4 * pT);
                    float part = dot4(a4, ts); part += dpp_f<0xB1>(part); part += dpp_f<0x4E>(part);
                    const float tic = part + (i == cT ? 1.f : 0.f);
                    if (pT == (i >> 2)) ts[i & 3] = tic; }
#pragma unroll
                for (int e = 0; e < 4; ++e) *(LAS unsigned short*)(slot + SC_TW + ((4 * pT + e) * 20 + cT) * 2) = (unsigned short)(pk2(ts[e], 0.f) & 0xffffu);
            }
        }
        __syncthreads();
        if (sub + 1 < SCAN_L / 16) { stage_a(sub + 1); if (sub + 2 < SCAN_L / 16) issue_loads(sub + 2); }
        {
            const u32x2 z2 = (u32x2){0u, 0u};
            LAS const unsigned char* ntp = slot + SC_NT + (j16 * 68 + 4 * g4) * 2;
            LAS const unsigned char* rtp = slot + SC_RT + (j16 * 68 + 4 * g4) * 2;
            const bf16x8 nta0 = cat8(lds8(ntp), lds8(ntp + 32)), nta1 = cat8(lds8(ntp + 64), lds8(ntp + 96));
            const bf16x8 rta0 = cat8(lds8(rtp), lds8(rtp + 32)), rta1 = cat8(lds8(rtp + 64), lds8(rtp + 96));
            const u32x2 vf = lds8(slot + SC_VT + ((16 * w4 + j16) * 20 + 4 * g4) * 2);
            const bf16x8 a2f = cat8(lds8(slot + SC_A2 + (j16 * 20 + 4 * g4) * 2), z2);
            const bf16x8 b12 = cat8(lds8(slot + SC_B1 + (j16 * 20 + 4 * g4) * 2), lds8(slot + SC_B2 + (j16 * 20 + 4 * g4) * 2));
            const bf16x8 tf = cat8(lds8(slot + SC_TW + (j16 * 20 + 4 * g4) * 2), z2);
            const f32x4 z4 = (f32x4){0.f, 0.f, 0.f, 0.f};
            f32x4 gc[4];
#pragma unroll
            for (int blk = 0; blk < 4; ++blk) gc[blk] = *(LAS const f32x4*)((LAS const float*)(slot + ((sub & 1) ? SC_GC2 : SC_GC)) + 16 * blk + 4 * g4);
            bf16x8 af[4];
#pragma unroll
            for (int blk = 0; blk < 4; ++blk) af[blk] = cat8(lds8(slot + SC_BHT + ((16 * blk + j16) * 20 + 4 * g4) * 2), lds8(slot + SC_KHT + ((16 * blk + j16) * 20 + 4 * g4) * 2));
            {
                const bf16x8 sb0 = cat8(pk4(S[0]), pk4(S[1])), sb1 = cat8(pk4(S[2]), pk4(S[3]));
                f32x4 X = mfma16(nta0, sb0, z4); X = mfma16(nta1, sb1, X); X = mfma16(a2f, cat8(vf, z2), X);
                const f32x4 Z = mfma16(tf, cat8(pk4(X), z2), z4);
                const bf16x8 zv = cat8(pk4(Z), vf);
#pragma unroll
                for (int blk = 0; blk < 4; ++blk) S[blk] = mfma16(af[blk], zv, S[blk] * gc[blk]);
                { f32x4 Y = mfma16(rta0, sb0, z4); Y = mfma16(rta1, sb1, Y); Y = mfma16(b12, zv, Y);
#pragma unroll
                  for (int q = 0; q < 4; ++q) fYB[(4 * g4 + q) * 64 + 16 * w4 + j16] = Y[q]; }
            }
            if (PH1) {
                const bf16x8 pb0 = cat8(pk4(P[0]), pk4(P[1])), pb1 = cat8(pk4(P[2]), pk4(P[3]));
                f32x4 X = mfma16(nta0, pb0, z4); X = mfma16(nta1, pb1, X);
                const f32x4 Z = mfma16(tf, cat8(pk4(X), z2), z4);
                const bf16x8 zp = cat8(pk4(Z), z2);
#pragma unroll
                for (int blk = 0; blk < 4; ++blk) P[blk] = mfma16(af[blk], zp, P[blk] * gc[blk]);
                f32x4 Yp = mfma16(rta0, pb0, z4); Yp = mfma16(rta1, pb1, Yp); Yp = mfma16(b12, zp, Yp);
#pragma unroll
                for (int q = 0; q < 4; ++q) *(LAS unsigned short*)(slot + SC_YP + ((4 * g4 + q) * 64 + 16 * w4 + j16) * 2) = (unsigned short)(pk2(Yp[q], 0.f) & 0xffffu);
            }
        }
    }
    __syncthreads();
    flush_y(SCAN_L / 16 - 1);
    if (PH1) {
        if (c < 15) {
            float* Pg = (float*)(ws + WS_SCAN) + (size_t)(chain * 14 + c - 1) * 2 * 4096; float* Qg = Pg + 4096;
#pragma unroll
            for (int blk = 0; blk < 4; ++blk) { const int o = (16 * w4 + j16) * 64 + 16 * blk + 4 * g4; *(f32x4*)(Pg + o) = P[blk]; *(f32x4*)(Qg + o) = S[blk]; }
        }
    } else {
        float* st = lat ? (float*)(ws + WS_S1) + (size_t)chain * 4096 : a.out + OUT_STATE + (size_t)((((b * 2 + l) * 2 + d) * 4 + h)) * 4096;
#pragma unroll
        for (int blk = 0; blk < 4; ++blk) *(f32x4*)(st + (16 * w4 + j16) * 64 + 16 * blk + 4 * g4) = S[blk];
    }
}

__device__ __forceinline__ void phase_scan1(CArgs& a, int l, LAS unsigned char* lds, int vcu, int G, int tid, int wave, int lane, int mode) {
    const int hw = wave >> 2, w4 = wave & 3, jt = tid & 255;
    for (int p = vcu; p < 640; p += G) {
        const int jid = 2 * p + hw;
        if (jid < 1024) { const int chain = jid >> 4, c = jid & 15; scan_job(a, l, lds + hw * SCAN_SLOT, true, chain >> 3, (chain >> 2) & 1, chain & 3, c, jt, w4, lane, mode, hw); }
        else { const int chain = jid - 1024; scan_job(a, l, lds + hw * SCAN_SLOT, false, chain >> 3, (chain >> 2) & 1, chain & 3, 0, jt, w4, lane, mode, hw); }
        __syncthreads();
    }
}
__device__ __forceinline__ void phase_scan2(CArgs& a, int l, LAS unsigned char* lds, int vcu, int G, int tid) {
    for (int chain = vcu; chain < 64; chain += G) {
        LAS float* Sl = (LAS float*)lds;
        LAS float* Pl = (LAS float*)(lds + 20480);
        const int row = tid >> 3, jc = tid & 7;
        const float* s0 = (const float*)(a.ws + WS_S1) + (size_t)chain * 4096 + row * 64 + 8 * jc;
        __syncthreads();
#pragma unroll
        for (int q = 0; q < 8; ++q) Sl[row * 65 + 8 * jc + q] = s0[q];
        f32x4 p0, p1, o0, o1;
        { const float* Pg = (const float*)(a.ws + WS_SCAN) + (size_t)(chain * 14) * 2 * 4096; const float* Qg = Pg + 4096;
          p0 = *(const f32x4*)(Pg + tid * 8); p1 = *(const f32x4*)(Pg + tid * 8 + 4); o0 = *(const f32x4*)(Qg + row * 64 + 8 * jc); o1 = *(const f32x4*)(Qg + row * 64 + 8 * jc + 4); }
        for (int c = 0; c < 14; ++c) {
            float* Pg = (float*)(a.ws + WS_SCAN) + (size_t)(chain * 14 + c) * 2 * 4096; float* Qg = Pg + 4096;
            *(LAS f32x4*)(Pl + tid * 8) = p0; *(LAS f32x4*)(Pl + tid * 8 + 4) = p1;
            f32x4 a0 = o0, a1 = o1;
            if (c + 1 < 14) { const float* Pn = Pg + 2 * 4096; const float* Qn = Pn + 4096;
                p0 = *(const f32x4*)(Pn + tid * 8); p1 = *(const f32x4*)(Pn + tid * 8 + 4); o0 = *(const f32x4*)(Qn + row * 64 + 8 * jc); o1 = *(const f32x4*)(Qn + row * 64 + 8 * jc + 4); }
            __syncthreads();
#pragma unroll 8
            for (int k = 0; k < 64; ++k) { const float s = Sl[row * 65 + k]; a0 += *(LAS const f32x4*)(Pl + k * 64 + 8 * jc) * s; a1 += *(LAS const f32x4*)(Pl + k * 64 + 8 * jc + 4) * s; }
            __syncthreads();
#pragma unroll
            for (int q = 0; q < 4; ++q) { Sl[row * 65 + 8 * jc + q] = a0[q]; Sl[row * 65 + 8 * jc + 4 + q] = a1[q]; }
            *(f32x4*)(Qg + row * 64 + 8 * jc) = a0; *(f32x4*)(Qg + row * 64 + 8 * jc + 4) = a1;
        }
        __syncthreads();
    }
}
__device__ __forceinline__ void phase_scan3(CArgs& a, int l, LAS unsigned char* lds, int vcu, int G, int tid, int wave, int lane, int mode) {
    (void)mode; (void)l;
    const int hw = wave >> 2, w4 = wave & 3, jt = tid & 255, g4 = lane >> 4, j16 = lane & 15, tokl = jt >> 4, cg = jt & 15;
    unsigned char* ws = a.ws;
    LAS float* fYB = (LAS float*)(lds + hw * 16384);
    for (int p = vcu; p < 480; p += G) {
        const int jid = 2 * p + hw; const int chain = jid / 15, c = 1 + jid % 15;
        const int b = chain >> 3, d = (chain >> 2) & 1, h = chain & 3;
        const float* ss = c == 1 ? (const float*)(ws + WS_S1) + (size_t)chain * 4096 : (const float*)(ws + WS_SCAN) + ((size_t)(chain * 14 + c - 2) * 2 + 1) * 4096;
        f32x4 S[4];
#pragma unroll
        for (int blk = 0; blk < 4; ++blk) S[blk] = *(const f32x4*)(ss + (16 * w4 + j16) * 64 + 16 * blk + 4 * g4);
        const bf16x8 sb0 = cat8(pk4(S[0]), pk4(S[1])), sb1 = cat8(pk4(S[2]), pk4(S[3]));
        const unsigned char* yp = scan_yp(ws, jid);
        bf16* Y = (bf16*)(ws + WS_Y);
#pragma unroll 1
        for (int sg = 0; sg < SCAN_L / 64; ++sg) {
            bf16x8 ya[4][2];
#pragma unroll
            for (int u = 0; u < 4; ++u) { const unsigned char* yr = yp + (4 * sg + u) * 2048 + (j16 * 64 + 4 * g4) * 2;
                ya[u][0] = cat8(*(const u32x2*)yr, *(const u32x2*)(yr + 32)); ya[u][1] = cat8(*(const u32x2*)(yr + 64), *(const u32x2*)(yr + 96)); }
            f32x4 yl[4]; bf16* yptr[4];
#pragma unroll
            for (int u = 0; u < 4; ++u) { const int tau = c * SCAN_L + (4 * sg + u) * 16 + tokl; const int t = d ? TL - 1 - tau : tau; const size_t tok = (size_t)NTC + b * TL + t;
                yptr[u] = Y + tok * 512 + d * 256 + h * 64 + 4 * cg; yl[u] = ldbf4(yptr[u]); }
#pragma unroll
            for (int u = 0; u < 4; ++u) { f32x4 C = mfma16(ya[u][0], sb0, (f32x4){0.f, 0.f, 0.f, 0.f}); C = mfma16(ya[u][1], sb1, C);
#pragma unroll
                for (int q = 0; q < 4; ++q) fYB[u * 1024 + (4 * g4 + q) * 64 + 16 * w4 + j16] = C[q]; }
            __syncthreads();
#pragma unroll
            for (int u = 0; u < 4; ++u) { const f32x4 y4 = yl[u] + *(LAS const f32x4*)(fYB + u * 1024 + tokl * 64 + 4 * cg); st4bf(yptr[u], y4[0], y4[1], y4[2], y4[3]); }
            __syncthreads();
        }
    }
}
__device__ __forceinline__ void phase_finish(CArgs& a, int l, int vcu, int G, int wave, int lane, bool dry) {
    const int gw = vcu * 8 + wave, NGW = G * 8;
    bf16* PA = (bf16*)(a.ws + WS_PA);
    const bf16* Y = (const bf16*)(a.ws + WS_Y); const float* CC = (const float*)(a.ws + WS_CC);
    const f32x4 lnw = *(const f32x4*)(a.in[22] + l * 256 + 4 * lane), lnb = *(const f32x4*)(a.in[23] + l * 256 + 4 * lane);
    const float* cw = a.in[14] + (size_t)l * 3 * 768 + 512 + 4 * lane;
    const f32x4 c0 = *(const f32x4*)cw, c1 = *(const f32x4*)(cw + 768), c2 = *(const f32x4*)(cw + 1536);
    const int head = lane >> 4;
    for (int tok0 = gw; tok0 < NTOK; tok0 += 2 * NGW) {
        f32x4 vp[2], vc[2], vn[2], yf[2], yb[2], gg[2]; float cfa[2], cfb[2]; bf16* rowp[2]; bool ok[2];
#pragma unroll
        for (int u = 0; u < 2; ++u) {
            const int tok = tok0 + u * NGW; ok[u] = tok < NTOK; const int tk = ok[u] ? tok : tok0;
            int t, T; if (tk < NTC) { t = tk & 255; T = TC; } else { t = (tk - NTC) & 4095; T = TL; }
            bf16* row = PA + (size_t)tk * LDA; rowp[u] = row;
            const f32x4 z = (f32x4){0.f, 0.f, 0.f, 0.f};
            vp[u] = t > 0 ? ldbf4(row - LDA + CA_V + 4 * lane) : z; vc[u] = ldbf4(row + CA_V + 4 * lane); vn[u] = t + 1 < T ? ldbf4(row + LDA + CA_V + 4 * lane) : z;
            yf[u] = ldbf4(Y + (size_t)tk * 512 + 4 * lane); yb[u] = ldbf4(Y + (size_t)tk * 512 + 256 + 4 * lane);
            cfa[u] = CC[((size_t)tk * 2 + 0) * 4 + head]; cfb[u] = CC[((size_t)tk * 2 + 1) * 4 + head];
            gg[u] = ldbf4(row + CA_GR + 4 * lane);
        }
#pragma unroll
        for (int u = 0; u < 2; ++u) {
            const f32x4 v_c = vp[u] * c0 + vc[u] * c1 + vn[u] * c2;
            const f32x4 o = yf[u] + yb[u];
            const float mu = row16_sum((o[0] + o[1]) + (o[2] + o[3])) * (1.f / 64.f);
            const f32x4 dlt = o - mu;
            const float var = row16_sum(dot4(dlt, dlt)) * (1.f / 64.f);
            const float rs = __builtin_amdgcn_rsqf(var + GN_EPS);
            const f32x4 on = dlt * rs * lnw + lnb + v_c * (cfa[u] + cfb[u]);
            const f32x4 g = gg[u];
            if (dry) { asm volatile("" :: "v"(on), "v"(g)); continue; }
            if (ok[u]) st4bf(rowp[u] + CA_GR + 4 * lane, on[0] * silu_f(g[0]), on[1] * silu_f(g[1]), on[2] * silu_f(g[2]), on[3] * silu_f(g[3]));
        }
    }
}

constexpr int NWAVES = 8;
#ifndef OUT_STAGGER_TICKS
#define OUT_STAGGER_TICKS 0
#endif
constexpr int RING_BYTES = 131072, LDSCTL_OFF = RING_BYTES, LDS_BYTES = 147456;
constexpr int N_PHASES = 2 + 8 * 2 - 1;

__global__ void __launch_bounds__(NWAVES * 64, 2) mk_fwd(Args args_) {
    extern __shared__ __attribute__((aligned(16))) unsigned char lds_raw[];
    LAS unsigned char* lds = (LAS unsigned char*)lds_raw;
    const int tid0 = threadIdx.x;
    const int G = gridDim.x; const int bx0 = blockIdx.x;
    const int vcu0 = (G % 8 == 0) ? (bx0 % 8) * (G / 8) + bx0 / 8 : bx0;
#define PHASE_IDS CArgs* ap_ = (CArgs*)__builtin_amdgcn_kernarg_segment_ptr(); asm volatile("" : "+s"(ap_)); CArgs& args = *ap_; int tid = tid0; asm volatile("" : "+v"(tid)); int vcu = vcu0, bx = bx0; asm volatile("" : "+s"(vcu), "+s"(bx)); (void)bx; const int lane = tid & 63; const int wave = __builtin_amdgcn_readfirstlane(tid >> 6); (void)lane; (void)wave;
    volatile LAS unsigned* MISC = (volatile LAS unsigned*)(lds + LDSCTL_OFF);
    for (int u = tid0; u < (LDS_BYTES - LDSCTL_OFF) / 4; u += NWAVES * 64) ((LAS unsigned*)(lds + LDSCTL_OFF))[u] = 0u;
    __syncthreads();
    XcdBarrier bar; bar.bar = (unsigned*)(args_.ws + WS_CTL) + 4096; bar.x = 0; bar.st = nullptr;
    const bool multi = (args_.ph_hi - args_.ph_lo) > 1;
    if (multi) bar = xcd_barrier_post((unsigned*)(args_.ws + WS_CTL) + 4096, MISC + 8);
    const int lo = args_.ph_lo, hi = args_.ph_hi;
#ifndef PH_MASK
#define PH_MASK 0x3ff
#endif
#define PHB(k) ((k) < 2 ? (k) : 2 + (((k) - 2) & 7))
#define IN(k) (((PH_MASK >> PHB(k)) & 1) && lo <= (k) && (k) < hi)
#define SEAM(k) do { if (IN(k) && IN((k) + 1)) { XcdBarrier b2_ = bar; asm volatile("" : "+s"(b2_.bar)); xcd_barrier(b2_); if (PROBE_DUP == 16) { xcd_barrier(b2_); xcd_barrier(b2_); } } } while (0)

    const int ATT_MOVED_LO = 768, ATT_MOVED_HI = (G == 256) ? 768 + 384 + 256 : 768;
#define REPS(id) int reps_ = 1 + (PROBE_DUP == (id) ? 1 : 0); asm volatile("" : "+s"(reps_));
    if (IN(0)) { PHASE_IDS phase_p0a(args, lds, vcu, G, tid, wave, lane); } SEAM(0);
    if (IN(1)) { PHASE_IDS phase_l1_tables(args, vcu, G, tid, wave, lane); REPS(7) for (int rep = 0; rep < reps_; ++rep) phase_norm(args, 0, vcu, G, wave, lane); } SEAM(1);
#pragma unroll 1
    for (int L = 0; L < 2; ++L) {
        const int pb = 2 + 8 * L;
        if (IN(pb + 0)) { PHASE_IDS
            pg8::Gemm g{(const pg8::bf16_t*)(args.ws + WS_H), (const pg8::bf16_t*)(args.ws + WS_WIN) + (size_t)L * NPROJ * DM, NTOK, NPROJ, DM, DM};
            pg8::StaticOrder S; S.init(NTOK, NPROJ, G, bx);
            if (L == 0 || G != 256) {
                pg8::EpiProjT<false> E{ap_, nullptr, L};
                REPS(1) for (int rep = 0; rep < reps_; ++rep) pg8::gemm_phase<pg8::EpiProjT<false>, pg8::StaticOrder, true, true>(lds, g, S, E);
            } else {
                LAS float* T = (LAS float*)(lds + LDSCTL_OFF + 8192);
                pg8::Unit u0; (void)S.next(0, u0);
                const float* part = (const float*)(args.ws + WS_PART);
#pragma unroll 1
                for (int j = 0; j < 4; ++j) { const int pm = u0.pm + 8 * j;
                    if (tid == 0) ((LAS int*)T)[j] = pm < NTOK / 256 ? pm : -1;
                    if (pm < NTOK / 256 && tid < 256) { float s = 0.f;
#pragma unroll 8
                        for (int q = 0; q < 32; ++q) s += part[(size_t)q * NTOK + pm * 256 + tid];
                        T[64 + 256 * j + tid] = __builtin_amdgcn_rsqf(s * (1.f / 1024.f) + EPS); } }
                __syncthreads();
                pg8::EpiProjT<true> E{ap_, T, L};
                pg8::gemm_phase<pg8::EpiProjT<true>, pg8::StaticOrder, true, true>(lds, g, S, E);
            }
        } SEAM(pb + 0);
        if (IN(pb + 1)) { PHASE_IDS REPS(2) for (int rep = 0; rep < reps_; ++rep) phase_p2(args, L, lds, vcu, G, tid, wave, lane, rep + 1 < reps_); } SEAM(pb + 1);
        if (IN(pb + 2)) { PHASE_IDS
            { REPS(3) for (int rep = 0; rep < reps_; ++rep) phase_scan1(args, L, lds, vcu, G, tid, wave, lane, 0); }
            if (G == 256 && vcu >= 128) { for (int k = 0; k < 2; ++k) attn_dispatch(args, L, ATT_MOVED_LO + 384 + 2 * (vcu - 128) + k, lds, tid, 0); }
        } SEAM(pb + 2);
        if (IN(pb + 3)) { PHASE_IDS phase_scan2(args, L, lds, vcu, G, tid);
            if (G == 256 && vcu >= 64) { for (int k = 0; k < 2; ++k) attn_dispatch(args, L, ATT_MOVED_LO + 2 * (vcu - 64) + k, lds, tid, 0); } } SEAM(pb + 3);
        if (IN(pb + 4)) { PHASE_IDS
            { REPS(5) for (int rep = 0; rep < reps_; ++rep) phase_scan3(args, L, lds, vcu, G, tid, wave, lane, 0); }
            {
                unsigned* ctr = (unsigned*)(args.ws + WS_CTL) + 2048 + 64 * L; const int nrest = ATT_UNITS - ATT_MOVED_HI;
                for (int it = 0;; ++it) {
                    int u = vcu + it * G;
                    if (u >= 768) {
                        if (tid == 0) MISC[16] = __hip_atomic_fetch_add(ctr, 1u, __ATOMIC_RELAXED, __HIP_MEMORY_SCOPE_AGENT);
                        __syncthreads(); const int idx = (int)MISC[16]; __syncthreads();
                        if (idx >= nrest) break;
                        u = ATT_MOVED_HI + idx;
                    }
                    attn_dispatch(args, L, u, lds, tid, 0);
                } }
        } SEAM(pb + 4);
        if (IN(pb + 5)) { PHASE_IDS REPS(8) for (int rep = 0; rep < reps_; ++rep) phase_finish(args, L, vcu, G, wave, lane, rep + 1 < reps_); } SEAM(pb + 5);
        if (IN(pb + 6)) { PHASE_IDS (void)tid;
            pg8::Gemm g{(const pg8::bf16_t*)(args.ws + WS_PA), (const pg8::bf16_t*)(args.ws + WS_WOUT) + (size_t)L * DM * DM, NTOK, DM, DM, LDA};
            pg8::StaticOrder S; S.init(NTOK, DM, G, bx);
            if (G == 256) {
                pg8::HalfOrder S2{bx};
                if (L == 0) {
                    pg8::EpiOut0 E{args.in[0], args.in[1], args.out + OUT_Y, (const float*)(args.ws + WS_MOD), (const float*)(args.ws + WS_S1T), (pg8::bf16_t*)(args.ws + WS_H), (float*)(args.ws + WS_PART)};
                    pg8::gemm_phase<pg8::EpiOut0, pg8::HalfOrder, true, true>(lds, g, S2, E);
                } else {
                    pg8::EpiOut E{args.out + OUT_Y, args.out + OUT_Y + (size_t)NTC * DM, args.out + OUT_Y, (const float*)(args.ws + WS_MOD) + (size_t)9 * 3072};
                    pg8::gemm_phase<pg8::EpiOut, pg8::HalfOrder, true, true>(lds, g, S2, E);
                }
            } else {
                const float* x0 = L == 0 ? args.in[0] : args.out + OUT_Y; const float* x1 = L == 0 ? args.in[1] : args.out + OUT_Y + (size_t)NTC * DM;
                pg8::EpiOut E{x0, x1, args.out + OUT_Y, (const float*)(args.ws + WS_MOD) + (size_t)L * 9 * 3072};
                pg8::gemm_phase<pg8::EpiOut, pg8::StaticOrder, true, true>(lds, g, S, E);
            }
        } SEAM(pb + 6);
        if (L == 0 && G != 256) { if (IN(pb + 7)) { PHASE_IDS phase_norm(args, 1, vcu, G, wave, lane); } SEAM(pb + 7); }
    }
#undef IN
#undef SEAM
}

extern "C" void kernel_launch(void* const* d_in, const int* in_sizes, int n_in, void* d_out, int out_size, void* d_ws, size_t ws_size, hipStream_t stream) {
    static int grid = 0;
    if (grid == 0) {
        if (n_in != 34 || ws_size < WS_END) { fprintf(stderr, "kernel_launch: expected 34 inputs and >= %zu bytes of workspace (got %d, %zu)\n", (size_t)WS_END, n_in, ws_size); grid = -1; return; }
        int dev = 0, cus = 0;
        if (hipGetDevice(&dev) != hipSuccess || hipDeviceGetAttribute(&cus, hipDeviceAttributeMultiprocessorCount, dev) != hipSuccess) { grid = -1; return; }
        if (hipFuncSetAttribute((const void*)mk_fwd, hipFuncAttributeMaxDynamicSharedMemorySize, LDS_BYTES) != hipSuccess) { fprintf(stderr, "kernel_launch: hipFuncSetAttribute failed\n"); grid = -1; return; }
        int per_cu = 0;
        if (hipOccupancyMaxActiveBlocksPerMultiprocessor(&per_cu, (const void*)mk_fwd, NWAVES * 64, LDS_BYTES) != hipSuccess || per_cu < 1) fprintf(stderr, "kernel_launch: occupancy query reports %d\n", per_cu);
        (void)hipGetLastError();
        grid = cus;
    }
    if (grid < 0) return;
    (void)hipMemsetAsync((char*)d_ws + WS_CTL, 0, CTL_ZERO_BYTES, stream);
    Args a{};
    for (int i = 0; i < 34; ++i) a.in[i] = (const float*)d_in[i];
    a.out = (float*)d_out; a.ws = (unsigned char*)d_ws;
#if MK_ONE_LAUNCH
    a.ph_lo = 0; a.ph_hi = N_PHASES;
    hipLaunchKernelGGL(mk_fwd, dim3(grid), dim3(NWAVES * 64), LDS_BYTES, stream, a);
#else
    for (int p = 0; p < N_PHASES; ++p) { a.ph_lo = p; a.ph_hi = p + 1; hipLaunchKernelGGL(mk_fwd, dim3(grid), dim3(NWAVES * 64), LDS_BYTES, stream, a); }
#endif
}
```
